# Optimizing an MI355X kernel written in HIP

```python
import math
import jax
import jax.numpy as jnp
from jax import lax

D_MODEL = 1024
BATCH = 16
SEQ = 4096
DEPTH = 4

CTX_LEN = 256
GRID_W = 64
HEAD_DIM = 128
N_HEADS_MIX = 4
MIX_W = N_HEADS_MIX * HEAD_DIM
N_BRANCH = 3
CHUNK = 64
CONV_K = 3
FFN_DIM = 3584
N_EXPERTS = 8
TOP_K = 2
LN_EPS = 1e-5
RMS_EPS = 1e-6
L2_EPS = 1e-6
MASK_NEG = -1e30
DEEPNORM_ALPHA = (2 * DEPTH) ** 0.25
DEEPNORM_BETA = (8 * DEPTH) ** -0.25
IN_SIZES = (MIX_W,) * 5 + (MIX_W,) * 4 + (4 * N_HEADS_MIX, 3 * MIX_W, MIX_W, 4 * N_HEADS_MIX, N_BRANCH * D_MODEL)
N_IN = sum(IN_SIZES)
N_DENSE = (DEPTH + 1) // 2
N_MOE = DEPTH // 2

kernel_name = 'hybrid_hgrn2_mlstm_gdn_moe_dit_trunk'


def _ln_plain(x):
    xf = x.astype(jnp.float32)
    mu = jnp.mean(xf, -1, keepdims=True)
    var = jnp.mean(jnp.square(xf - mu), -1, keepdims=True)
    return ((xf - mu) * lax.rsqrt(var + LN_EPS)).astype(x.dtype)


def _post_ln(x, g, b):
    xf = x.astype(jnp.float32)
    mu = jnp.mean(xf, -1, keepdims=True)
    var = jnp.mean(jnp.square(xf - mu), -1, keepdims=True)
    y = (xf - mu) * lax.rsqrt(var + LN_EPS) * g.astype(jnp.float32) + b.astype(jnp.float32)
    return y.astype(x.dtype)


def _modulate(x, shift, scale):
    return _ln_plain(x) * (1.0 + scale) + shift


def _split_cols(p):
    out, start = [], 0
    for s in IN_SIZES:
        out.append(p[..., start:start + s])
        start += s
    return out


def _heads(t, h):
    b, l, _ = t.shape
    return t.reshape(b, l, h, -1).transpose(0, 2, 1, 3)


def _unheads(t):
    b, h, l, d = t.shape
    return t.transpose(0, 2, 1, 3).reshape(b, l, h * d)


def _head_scalars(t, h):
    b, l, _ = t.shape
    return t.reshape(b, l, 4, h).transpose(2, 0, 3, 1)


def _l2n(t):
    return t * lax.rsqrt(jnp.sum(jnp.square(t), -1, keepdims=True) + L2_EPS)


def _centred_conv(x, w):
    k = w.shape[0]
    p = k // 2
    l = x.shape[1]
    xp = jnp.pad(x, ((0, 0), (p, p), (0, 0)))
    return sum(xp[:, j:j + l] * w[j] for j in range(k))


def _to_chunks(t):
    b, h, l = t.shape[:3]
    t = t.reshape((b, h, l // CHUNK, CHUNK) + t.shape[3:])
    return jnp.moveaxis(t, 2, 0)


def _from_chunks(t):
    t = jnp.moveaxis(t, 0, 2)
    return t.reshape(t.shape[:2] + (-1,) + t.shape[4:])


def _raster_to_colmajor(t):
    b, h, l = t.shape[:3]
    rows = l // GRID_W
    rest = t.shape[3:]
    t = t.reshape((b, h, rows, GRID_W) + rest)
    return jnp.swapaxes(t, 2, 3).reshape((b, h, l) + rest)


def _colmajor_to_raster(t):
    b, h, l = t.shape[:3]
    rows = l // GRID_W
    rest = t.shape[3:]
    t = t.reshape((b, h, GRID_W, rows) + rest)
    return jnp.swapaxes(t, 2, 3).reshape((b, h, l) + rest)


def _map_dirs(fn, dirs):
    return tuple(tuple(fn(t) for t in d) for d in dirs)


def _masked_exp(tri, diff):
    return jnp.where(tri, jnp.exp(jnp.where(tri, diff, 0.0)), 0.0)


def _gla_scan(q, k, v, log_f, state=None):
    b, h, _, dk = q.shape
    dv = v.shape[-1]
    if state is None:
        state = jnp.zeros((b, h, dk, dv), jnp.float32)
    tri = jnp.tril(jnp.ones((CHUNK, CHUNK), bool))[:, :, None]

    def step(s, inp):
        qc, kc, vc, gc = inp
        g = jnp.cumsum(gc, axis=-2)
        dec = _masked_exp(tri, g[..., :, None, :] - g[..., None, :, :])
        a = jnp.einsum('bhtk,bhsk,bhtsk->bhts', qc, kc, dec)
        o = jnp.einsum('bhts,bhsv->bhtv', a, vc) + jnp.einsum('bhtk,bhkv->bhtv', qc * jnp.exp(g), s)
        g_last = g[..., -1:, :]
        s = jnp.exp(g_last[..., 0, :])[..., None] * s + jnp.einsum('bhsk,bhsv->bhkv', kc * jnp.exp(g_last - g), vc)
        return s, o

    state, o = lax.scan(step, state, tuple(_to_chunks(t) for t in (q, k, v, log_f)))
    return _from_chunks(o), state


def _mlstm_scan(q, k, v, ig, lf, state=None):
    b, h, _, dk = q.shape
    dv = v.shape[-1]
    if state is None:
        state = (jnp.zeros((b, h, dk, dv), jnp.float32), jnp.zeros((b, h, dk), jnp.float32), jnp.zeros((b, h), jnp.float32))
    tri = jnp.tril(jnp.ones((CHUNK, CHUNK), bool))

    def step(carry, inp):
        cm, n, m = carry
        qc, kc, vc, ic, fc = inp
        bb = jnp.cumsum(fc, axis=-1)
        log_d = jnp.where(tri, bb[..., :, None] - bb[..., None, :] + ic[..., None, :], MASK_NEG)
        log_inter = bb + m[..., None]
        m_t = jnp.maximum(jnp.max(log_d, -1), log_inter)
        d = jnp.where(tri, jnp.exp(log_d - m_t[..., None]), 0.0)
        inter = jnp.exp(log_inter - m_t)
        s = jnp.einsum('bhtd,bhsd->bhts', qc, kc) * d
        num = jnp.einsum('bhts,bhsv->bhtv', s, vc) + inter[..., None] * jnp.einsum('bhtd,bhdv->bhtv', qc, cm)
        den = jnp.sum(s, -1) + inter * jnp.einsum('bhtd,bhd->bht', qc, n)
        hh = num / jnp.maximum(jnp.abs(den), jnp.exp(-m_t))[..., None]
        m_new = m_t[..., -1]
        w = jnp.exp(bb[..., -1:] - bb + ic - m_new[..., None])
        decay = jnp.exp(bb[..., -1] + m - m_new)
        cm = decay[..., None, None] * cm + jnp.einsum('bhs,bhsk,bhsv->bhkv', w, kc, vc)
        n = decay[..., None] * n + jnp.einsum('bhs,bhsk->bhk', w, kc)
        return (cm, n, m_new), hh

    state, hh = lax.scan(step, state, tuple(_to_chunks(t) for t in (q, k, v, ig, lf)))
    return _from_chunks(hh), state


def _gdn_scan(q, k, v, g, beta, state=None):
    b, h, _, dk = q.shape
    dv = v.shape[-1]
    if state is None:
        state = jnp.zeros((b, h, dk, dv), jnp.float32)
    qc, kc, vc, gc, bc = (_to_chunks(t) for t in (q, k, v, g, beta))
    tri = jnp.tril(jnp.ones((CHUNK, CHUNK), bool))
    strict = jnp.tril(jnp.ones((CHUNK, CHUNK), bool), -1)
    gam = jnp.cumsum(gc, axis=-1)
    ldec = _masked_exp(tri, gam[..., :, None] - gam[..., None, :])
    kb = kc * bc[..., None]
    a = jnp.where(strict, jnp.einsum('nbhtd,nbhsd->nbhts', kb, kc) * ldec, 0.0)
    rhs = jnp.concatenate([vc * bc[..., None], kb * jnp.exp(gam)[..., None]], axis=-1)
    sol = lax.linalg.triangular_solve(a + jnp.eye(CHUNK, dtype=a.dtype), rhs, left_side=True, lower=True, unit_diagonal=True)
    u, w = sol[..., :dv], sol[..., dv:]
    qk = jnp.einsum('nbhtd,nbhsd->nbhts', qc, kc) * ldec
    qg = qc * jnp.exp(gam)[..., None]
    kg = kc * jnp.exp(gam[..., -1:] - gam)[..., None]
    g_last = jnp.exp(gam[..., -1])

    def step(s, inp):
        uc, wc, qkc, qgc, kgc, glc = inp
        v_new = uc - jnp.einsum('bhtk,bhkv->bhtv', wc, s)
        o = jnp.einsum('bhtk,bhkv->bhtv', qgc, s) + jnp.einsum('bhts,bhsv->bhtv', qkc, v_new)
        s = glc[..., None, None] * s + jnp.einsum('bhsk,bhsv->bhkv', kgc, v_new)
        return s, o

    state, o = lax.scan(step, state, (u, w, qk, qg, kg, g_last))
    return _from_chunks(o), state


def _bidir_scan(scan, ctx_dirs, lat_dirs):
    o_ctx, o_lat = [], []
    for d in range(2):
        ca, la = ctx_dirs[d], lat_dirs[d]
        if d == 1:
            ca = tuple(jnp.flip(t, 2) for t in ca)
            la = tuple(jnp.flip(t, 2) for t in la)
        oc, st = scan(*ca)
        ol, _ = scan(*la, st)
        if d == 1:
            oc, ol = jnp.flip(oc, 2), jnp.flip(ol, 2)
        o_ctx.append(oc)
        o_lat.append(ol)
    return o_ctx[0] + o_ctx[1], o_lat[0] + o_lat[1]


def _mixer_inputs(h, w_in, conv_w, lb, m_bias, a_log, dt_bias):
    f32 = jnp.float32
    hh = N_HEADS_MIX
    (a_q, a_ff, a_fb, a_i, a_g, b_q, b_k, b_v, b_o, b_gt, c_qkv, c_z, c_gt, merge) = _split_cols(h @ w_in)

    def hd(t):
        return _heads(t, hh).astype(f32)

    lbh = lb.astype(f32).reshape(hh, 1, HEAD_DIM)

    def hgrn_gates(f_pre):
        f_pre = hd(f_pre)
        log_f = jnp.log(lbh + (1.0 - lbh) * jax.nn.sigmoid(f_pre))
        return (1.0 - lbh) * jax.nn.sigmoid(-f_pre), log_f

    aq, ai = hd(a_q), hd(a_i)
    k_f, lf_f = hgrn_gates(a_ff)
    k_b, lf_b = hgrn_gates(a_fb)
    a_dirs = ((aq, k_f, ai, lf_f), (aq, k_b, ai, lf_b))
    bq, bk, bv = hd(b_q), hd(b_k) * HEAD_DIM ** -0.5, hd(b_v)
    bg = _head_scalars(b_gt, hh).astype(f32) + m_bias.astype(f32)[:, None, :, None]
    b_dirs = ((bq, bk, bv, bg[0], jax.nn.log_sigmoid(bg[2])), (bq, bk, bv, bg[1], jax.nn.log_sigmoid(bg[3])))
    qkv = jax.nn.silu(_centred_conv(c_qkv, conv_w))
    cq, ck, cv = (hd(t) for t in jnp.split(qkv, 3, axis=-1))
    cq = _l2n(cq) * HEAD_DIM ** -0.5
    ck = _l2n(ck)
    cg = _head_scalars(c_gt, hh).astype(f32)
    decay = -jnp.exp(a_log.astype(f32))[:, None, :, None] * jax.nn.softplus(cg[:2] + dt_bias.astype(f32)[:, None, :, None])
    beta = jax.nn.sigmoid(cg[2:])
    c_dirs = ((cq, ck, cv, decay[0], beta[0]), (cq, ck, cv, decay[1], beta[1]))
    return a_dirs, b_dirs, c_dirs, (a_g, b_o, c_z, merge)


def _gated_head_norm(o, gain, gate, act):
    h, d = o.shape[1], o.shape[3]
    y = o * lax.rsqrt(jnp.mean(jnp.square(o), -1, keepdims=True) + RMS_EPS) * gain.astype(jnp.float32).reshape(h, 1, d)
    return _unheads(y * act(_heads(gate, h).astype(jnp.float32)))


def _merge_branches(outs, gates, mix_norm, w_branch, w_out):
    a_g, b_o, c_z, merge = gates
    dt = merge.dtype
    ys = (_gated_head_norm(outs[0], mix_norm[0], a_g, jax.nn.silu),
          _gated_head_norm(outs[1], mix_norm[1], b_o, jax.nn.sigmoid),
          _gated_head_norm(outs[2], mix_norm[2], c_z, jax.nn.silu))
    b, l, _ = merge.shape
    g = jax.nn.sigmoid(merge.reshape(b, l, N_BRANCH, D_MODEL))
    mixed = g[:, :, 0] * (ys[0].astype(dt) @ w_branch[0])
    for n in range(1, N_BRANCH):
        mixed = mixed + g[:, :, n] * (ys[n].astype(dt) @ w_branch[n])
    return mixed @ w_out


def _swiglu(h, w_gate, w_up, w_down):
    return (jax.nn.silu(h @ w_gate) * (h @ w_up)) @ w_down


def _moe(h, w_router, w_gate, w_up, w_down):
    logits = (h @ w_router).astype(jnp.float32)
    top_v, top_i = lax.top_k(logits, TOP_K)
    probs = jax.nn.softmax(top_v, axis=-1)
    combine = jnp.sum(jax.nn.one_hot(top_i, N_EXPERTS, dtype=jnp.float32) * probs[..., None], axis=-2).astype(h.dtype)
    out = combine[..., 0:1] * _swiglu(h, w_gate[0], w_up[0], w_down[0])
    for e in range(1, N_EXPERTS):
        out = out + combine[..., e:e + 1] * _swiglu(h, w_gate[e], w_up[e], w_down[e])
    return out


def _channel_mixer(h, l, ffn_w_gate, ffn_w_up, ffn_w_down, moe_router, moe_w_gate, moe_w_up, moe_w_down):
    i = l // 2
    if l % 2 == 0:
        return _swiglu(h, ffn_w_gate[i], ffn_w_up[i], ffn_w_down[i])
    return _moe(h, moe_router[i], moe_w_gate[i], moe_w_up[i], moe_w_down[i])


def setup_inputs(seed: int = 0) -> dict:
    key = jax.random.key(seed)
    ks = jax.random.split(key, 32)
    f32 = jnp.float32
    hh = N_HEADS_MIX

    def nrm(i, shape, scale):
        return jax.random.normal(ks[i], shape, f32) * scale

    i_bias = nrm(9, (DEPTH, 2, hh), 0.1)
    f_bias = 3.0 + 3.0 * jax.random.uniform(ks[10], (DEPTH, 2, hh), f32)
    dt = jnp.exp(jax.random.uniform(ks[12], (DEPTH, 2, hh), f32, math.log(1e-3), math.log(1e-1)))
    return {
        'x': nrm(0, (BATCH, SEQ, D_MODEL), 1.0),
        'c': nrm(1, (BATCH, D_MODEL), 1.0),
        'ctx': nrm(2, (BATCH, CTX_LEN, D_MODEL), 1.0),
        'c_ctx': nrm(3, (D_MODEL,), 1.0),
        'w_ada': nrm(4, (DEPTH, D_MODEL, 6 * D_MODEL), 0.5 * D_MODEL ** -0.5),
        'b_ada': nrm(5, (DEPTH, 6 * D_MODEL), 0.02),
        'w_in': nrm(6, (DEPTH, D_MODEL, N_IN), D_MODEL ** -0.5),
        'conv_w': nrm(7, (DEPTH, CONV_K, 3 * MIX_W), CONV_K ** -0.5),
        'lb_raw': nrm(8, (DEPTH, MIX_W), 0.5),
        'm_gate_bias': jnp.concatenate([i_bias, f_bias], axis=1),
        'gdn_a_log': jnp.log(jax.random.uniform(ks[11], (DEPTH, 2, hh), f32, 1.0, 16.0)),
        'gdn_dt_bias': dt + jnp.log(-jnp.expm1(-dt)),
        'mix_norm': 1.0 + nrm(13, (DEPTH, N_BRANCH, MIX_W), 0.02),
        'w_branch': nrm(14, (DEPTH, N_BRANCH, MIX_W, D_MODEL), DEEPNORM_BETA * MIX_W ** -0.5),
        'w_out': nrm(15, (DEPTH, D_MODEL, D_MODEL), DEEPNORM_BETA * D_MODEL ** -0.5),
        'ln_g': 1.0 + nrm(16, (DEPTH, 2, D_MODEL), 0.02),
        'ln_b': nrm(17, (DEPTH, 2, D_MODEL), 0.02),
        'ffn_w_gate': nrm(18, (N_DENSE, D_MODEL, FFN_DIM), D_MODEL ** -0.5),
        'ffn_w_up': nrm(19, (N_DENSE, D_MODEL, FFN_DIM), DEEPNORM_BETA * D_MODEL ** -0.5),
        'ffn_w_down': nrm(20, (N_DENSE, FFN_DIM, D_MODEL), DEEPNORM_BETA * FFN_DIM ** -0.5),
        'moe_router': nrm(21, (N_MOE, D_MODEL, N_EXPERTS), D_MODEL ** -0.5),
        'moe_w_gate': nrm(22, (N_MOE, N_EXPERTS, D_MODEL, FFN_DIM), D_MODEL ** -0.5),
        'moe_w_up': nrm(23, (N_MOE, N_EXPERTS, D_MODEL, FFN_DIM), DEEPNORM_BETA * D_MODEL ** -0.5),
        'moe_w_down': nrm(24, (N_MOE, N_EXPERTS, FFN_DIM, D_MODEL), DEEPNORM_BETA * FFN_DIM ** -0.5),
    }


def reference(x, c, ctx, c_ctx, w_ada, b_ada, w_in, conv_w, lb_raw, m_gate_bias, gdn_a_log, gdn_dt_bias, mix_norm, w_branch, w_out, ln_g, ln_b, ffn_w_gate, ffn_w_up, ffn_w_down, moe_router, moe_w_gate, moe_w_up, moe_w_down):
    p = jax.nn.softmax(lb_raw.astype(jnp.float32), axis=0)
    lower_bounds = jnp.cumsum(p, axis=0) - p[0]
    s_lat = jax.nn.silu(c)[:, None, :]
    s_ctx = jax.nn.silu(c_ctx)[None, None, :]
    ffn_w = (ffn_w_gate, ffn_w_up, ffn_w_down, moe_router, moe_w_gate, moe_w_up, moe_w_down)
    for l in range(DEPTH):
        mod_l = jnp.split(s_lat @ w_ada[l] + b_ada[l], 6, axis=-1)
        mod_c = jnp.split(s_ctx @ w_ada[l] + b_ada[l], 6, axis=-1)
        mix_p = (w_in[l], conv_w[l], lower_bounds[l], m_gate_bias[l], gdn_a_log[l], gdn_dt_bias[l])
        a_c, b_c, d_c, gates_c = _mixer_inputs(_modulate(ctx, mod_c[0], mod_c[1]), *mix_p)
        a_l, b_l, d_l, gates_l = _mixer_inputs(_modulate(x, mod_l[0], mod_l[1]), *mix_p)
        oa_c, oa_l = _bidir_scan(_gla_scan, a_c, a_l)
        ob_c, ob_l = _bidir_scan(_mlstm_scan, b_c, _map_dirs(_raster_to_colmajor, b_l))
        ob_l = _colmajor_to_raster(ob_l)
        od_c, od_l = _bidir_scan(_gdn_scan, d_c, d_l)
        out_p = (mix_norm[l], w_branch[l], w_out[l])
        x = _post_ln(DEEPNORM_ALPHA * x + mod_l[2] * _merge_branches((oa_l, ob_l, od_l), gates_l, *out_p), ln_g[l, 0], ln_b[l, 0])
        x = _post_ln(DEEPNORM_ALPHA * x + mod_l[5] * _channel_mixer(_modulate(x, mod_l[3], mod_l[4]), l, *ffn_w), ln_g[l, 1], ln_b[l, 1])
        if l < DEPTH - 1:
            ctx = _post_ln(DEEPNORM_ALPHA * ctx + mod_c[2] * _merge_branches((oa_c, ob_c, od_c), gates_c, *out_p), ln_g[l, 0], ln_b[l, 0])
            ctx = _post_ln(DEEPNORM_ALPHA * ctx + mod_c[5] * _channel_mixer(_modulate(ctx, mod_c[3], mod_c[4]), l, *ffn_w), ln_g[l, 1], ln_b[l, 1])
    return x
```

```cpp
#include <hip/hip_runtime.h>
#include <cstdio>
#include <cstdint>
namespace pg8 {
#define PG8_LAS __attribute__((address_space(3)))
typedef unsigned short bf16_t;
typedef short bf16x8 __attribute__((ext_vector_type(8)));
typedef float f32x4 __attribute__((ext_vector_type(4)));
typedef unsigned u32x4 __attribute__((ext_vector_type(4)));
constexpr int BM = 256, BK = 64, HALF = 128, HTB = HALF * BK * 2  , STAGE_BYTES = 8 * HTB, NXCD = 8, WGM = 8;

__host__ __device__ __forceinline__ int lds_byte(int r, int c) { const int st = (r >> 4) * 2 + (c >> 5), rr = r & 15, cc = c & 31, ob = rr * 64 + cc * 2; return st * 1024 + (ob ^ (((ob >> 9) & 1) << 5)); }
__host__ __device__ __forceinline__ void stage_rc(int b, int& R, int& C) { const int st = b / 1024, sb = b % 1024, swz = sb ^ (((sb >> 9) & 1) << 5); R = (st >> 1) * 16 + swz / 64; C = (st & 1) * 32 + (swz % 64) / 2; }
__host__ __device__ __forceinline__ int perm32(int rho) { const int n = rho >> 4, i = rho & 15; return 8 * (i >> 2) + 4 * n + (i & 3); }

struct Unit { int pm, pn; };
struct Gemm { const bf16_t* A; const bf16_t* Bt; int lda, K; };

struct StaticOrder {
    int nM, nN, nwg, G, c;
    __host__ __device__ void init(int M, int N, int G_, int c_) { nM = M / BM; nN = N / BM; nwg = nM * nN; G = G_; c = c_; }
    __host__ __device__ bool next(int i, Unit& u) const {
        const long L = (long)i * G + c; if (L >= nwg) return false;
        int wgid = (int)L; { const int q = nwg / NXCD, r = nwg % NXCD, xcd = wgid % NXCD, off = wgid / NXCD; wgid = (xcd < r ? xcd * (q + 1) : r * (q + 1) + (xcd - r) * q) + off; }
        const int nig = WGM * nN, gid = wgid / nig, fm = gid * WGM, gsz = (nM - fm) < WGM ? (nM - fm) : WGM;
        u.pm = fm + ((wgid % nig) % gsz); u.pn = (wgid % nig) / gsz; return true;
    }
    __device__ __forceinline__ void a_ready(const Unit&) const {}
    __device__ __forceinline__ void done(const Unit&) const {}
    __device__ __forceinline__ size_t a_off(const Unit& u, int lda) const { return (size_t)u.pm * BM * lda * 2; }
    __device__ __forceinline__ size_t b_off(const Unit& u, int K) const { return (size_t)u.pn * BM * K * 2; }
};

__device__ __forceinline__ unsigned cvt_pk_bf16(float lo, float hi) { unsigned r; asm volatile("v_cvt_pk_bf16_f32 %0, %1, %2" : "=v"(r) : "v"(lo), "v"(hi)); return r; }
typedef float f32x2 __attribute__((ext_vector_type(2)));
__device__ __forceinline__ float bf2f(unsigned short b) { return __uint_as_float(((unsigned)b) << 16); }
__device__ __forceinline__ float sigm(float x) { return 1.0f / (1.0f + __expf(-x)); }
__device__ __forceinline__ int mi_of_pm(int pm) { const int b = pm / 17, j = pm - b * 17; return j == 0 ? 16 : b; }

struct EpiP {
    static constexpr bool PERM = true, AFTER_DRAIN = false;
    bf16_t* O; int ldc; float* SC; int sc_pn; int act;
    __device__ __forceinline__ void operator()(const f32x4 (&acc)[2][2][4][2], const Unit& u, int wr, int wc, int fr, int fq) const {
        const int row0 = u.pm * BM + wr * 64 + fr;
        if (u.pn == sc_pn) {
            if (wc == 0) {
#pragma unroll
                for (int ai = 0; ai < 2; ++ai)
#pragma unroll
                    for (int m = 0; m < 4; ++m) { float* rp = SC + (size_t)(row0 + ai * HALF + m * 16) * 32 + 8 * fq;
#pragma unroll
                        for (int n = 0; n < 2; ++n) *(f32x4*)(rp + 4 * n) = acc[ai][0][m][n]; }
            }
            return;
        }
        const int col0 = u.pn * BM + wc * 32 + 8 * fq;
#pragma unroll
        for (int ai = 0; ai < 2; ++ai)
#pragma unroll
            for (int m = 0; m < 4; ++m) { bf16_t* rowp = O + (size_t)(row0 + ai * HALF + m * 16) * ldc + col0;
#pragma unroll
                for (int bj = 0; bj < 2; ++bj) { f32x4 v0 = acc[ai][bj][m][0], v1 = acc[ai][bj][m][1];
                    if (act) {
#pragma unroll
                        for (int j = 0; j < 4; ++j) { v0[j] = sigm(v0[j]); v1[j] = sigm(v1[j]); } }
                    u32x4 w; w.x = cvt_pk_bf16(v0[0], v0[1]); w.y = cvt_pk_bf16(v0[2], v0[3]); w.z = cvt_pk_bf16(v1[0], v1[1]); w.w = cvt_pk_bf16(v1[2], v1[3]);
                    *(u32x4*)(rowp + bj * HALF) = w; } }
    }
};
struct EpiMul {
    static constexpr bool PERM = true, AFTER_DRAIN = false;
    bf16_t* O; int ldc;
    __device__ __forceinline__ void operator()(const f32x4 (&acc)[2][2][4][2], const Unit& u, int wr, int wc, int fr, int fq) const {
        const int row0 = u.pm * BM + wr * 64 + fr, col0 = u.pn * BM + wc * 32 + 8 * fq;
#pragma unroll
        for (int ai = 0; ai < 2; ++ai)
#pragma unroll
            for (int m = 0; m < 4; ++m) { bf16_t* rowp = O + (size_t)(row0 + ai * HALF + m * 16) * ldc + col0;
#pragma unroll
                for (int bj = 0; bj < 2; ++bj) { const f32x4 v0 = acc[ai][bj][m][0], v1 = acc[ai][bj][m][1];
                    const u32x4 g = *(const u32x4*)(rowp + bj * HALF);
                    u32x4 w;
                    w.x = cvt_pk_bf16(v0[0] * __uint_as_float(g.x << 16), v0[1] * __uint_as_float(g.x & 0xffff0000u));
                    w.y = cvt_pk_bf16(v0[2] * __uint_as_float(g.y << 16), v0[3] * __uint_as_float(g.y & 0xffff0000u));
                    w.z = cvt_pk_bf16(v1[0] * __uint_as_float(g.z << 16), v1[1] * __uint_as_float(g.z & 0xffff0000u));
                    w.w = cvt_pk_bf16(v1[2] * __uint_as_float(g.w << 16), v1[3] * __uint_as_float(g.w & 0xffff0000u));
                    *(u32x4*)(rowp + bj * HALF) = w; } }
    }
};
struct EpiSwiglu {
    static constexpr bool PERM = true, AFTER_DRAIN = false;
    bf16_t* O; int ldc;
    __device__ __forceinline__ void operator()(const f32x4 (&acc)[2][2][4][2], const Unit& u, int wr, int wc, int fr, int fq) const {
        const int row0 = u.pm * BM + wr * 64 + fr, col0 = u.pn * HALF + wc * 32 + 8 * fq;
#pragma unroll
        for (int ai = 0; ai < 2; ++ai)
#pragma unroll
            for (int m = 0; m < 4; ++m) { bf16_t* rowp = O + (size_t)(row0 + ai * HALF + m * 16) * ldc + col0;
                f32x4 v0, v1;
#pragma unroll
                for (int j = 0; j < 4; ++j) { const float g0 = acc[ai][0][m][0][j], g1 = acc[ai][0][m][1][j];
                    v0[j] = g0 * sigm(g0) * acc[ai][1][m][0][j]; v1[j] = g1 * sigm(g1) * acc[ai][1][m][1][j]; }
                u32x4 w; w.x = cvt_pk_bf16(v0[0], v0[1]); w.y = cvt_pk_bf16(v0[2], v0[3]); w.z = cvt_pk_bf16(v1[0], v1[1]); w.w = cvt_pk_bf16(v1[2], v1[3]);
                *(u32x4*)rowp = w; }
    }
};
struct EpiRes {
    static constexpr bool PERM = false, AFTER_DRAIN = false;
    float* X; const float* mod; const float* rowscale; float alpha;
    __device__ __forceinline__ void operator()(const f32x4 (&acc)[2][2][4][2], const Unit& u, int wr, int wc, int fr, int fq) const {
        const int row0 = u.pm * BM + wr * 64 + fr, col0 = u.pn * BM + wc * 32 + 4 * fq;
        const float* mp = mod + (size_t)mi_of_pm(u.pm) * 6144 + col0;
        f32x4 gv[2][2];
#pragma unroll
        for (int bj = 0; bj < 2; ++bj)
#pragma unroll
            for (int n = 0; n < 2; ++n) gv[bj][n] = *(const f32x4*)(mp + bj * HALF + n * 16);
#pragma unroll
        for (int ai = 0; ai < 2; ++ai)
#pragma unroll
            for (int m = 0; m < 4; ++m) { const int row = row0 + ai * HALF + m * 16; float* rowp = X + (size_t)row * 1024 + col0;
                const float rs = rowscale ? rowscale[(size_t)row * 8] : 1.0f;
#pragma unroll
                for (int bj = 0; bj < 2; ++bj)
#pragma unroll
                    for (int n = 0; n < 2; ++n) { const f32x4 x = *(const f32x4*)(rowp + bj * HALF + n * 16);
                        *(f32x4*)(rowp + bj * HALF + n * 16) = x * alpha + (gv[bj][n] * rs) * acc[ai][bj][m][n]; } }
    }
};
struct BranchOrder : StaticOrder {
    __device__ __forceinline__ size_t a_off(const Unit& u, int lda) const { return (size_t)u.pm * BM * lda * 2 + (size_t)(u.pn >> 2) * 512 * 2; }
};

template <class Epi, class Sched, bool ALIGN_EPI = false, bool SP2 = false>
__device__ __forceinline__ void gemm_phase(PG8_LAS unsigned char* lds, const Gemm g, const Sched& S, const Epi& E) {
    int tid_ = threadIdx.x; asm volatile("" : "+v"(tid_));
    const int tid = tid_, wid = __builtin_amdgcn_readfirstlane(tid >> 6), lane = tid & 63, wr = wid >> 2, wc = wid & 3, fr = lane & 15, fq = lane >> 4;
    const int K = g.K, nt = K / BK;
    unsigned voffA[2], voffB[2];
#pragma unroll
    for (int i = 0; i < 2; ++i) { int R, C; stage_rc(tid * 16 + i * 8192, R, C); const int Rb = Epi::PERM ? ((R & ~31) + perm32(R & 31)) : R;
        voffA[i] = (unsigned)(R * g.lda + C) * 2u; voffB[i] = (unsigned)(Rb * K + C) * 2u; }
    const size_t kstep = (size_t)(BK * 2);
    const size_t hstepA = (size_t)HALF * g.lda * 2, hstepB = (size_t)HALF * K * 2;
    const unsigned ldsw = (unsigned)wid * 1024u;
    const int aoff = lds_byte(wr * 64 + fr, fq * 8), boff = lds_byte(wc * 32 + fr, fq * 8);
#define PG8_SA(b, h) (((b) * 2 + (h)) * HTB)
#define PG8_SB(b, h) ((4 + (b) * 2 + (h)) * HTB)
#define PG8_STAGE(bufoff, gbase, voff) do { _Pragma("unroll") for (int _i = 0; _i < 2; ++_i) \
        __builtin_amdgcn_global_load_lds((const unsigned*)((const char*)(gbase) + (voff)[_i]), (PG8_LAS unsigned*)(lds + (bufoff) + ldsw + _i * 8192), 16, 0, 0); } while (0)
#define PG8_LDA(dst, b, h) do { _Pragma("unroll") for (int m = 0; m < 4; ++m) _Pragma("unroll") for (int k = 0; k < 2; ++k) dst[m][k] = *(const PG8_LAS bf16x8*)(lds + PG8_SA(b, h) + aoff + m * 2048 + k * 1024); } while (0)
#define PG8_LDB(dst, b, h) do { _Pragma("unroll") for (int n = 0; n < 2; ++n) _Pragma("unroll") for (int k = 0; k < 2; ++k) dst[n][k] = *(const PG8_LAS bf16x8*)(lds + PG8_SB(b, h) + boff + n * 2048 + k * 1024); } while (0)
#define PG8_MMA(ai, bj, At, Bt) do { __builtin_amdgcn_s_setprio(1); _Pragma("unroll") for (int m = 0; m < 4; ++m) _Pragma("unroll") for (int n = 0; n < 2; ++n) _Pragma("unroll") for (int k = 0; k < 2; ++k) \
        acc[ai][bj][m][n] = __builtin_amdgcn_mfma_f32_16x16x32_bf16(Bt[n][k], At[m][k], acc[ai][bj][m][n], 0, 0, 0); __builtin_amdgcn_s_setprio(0); } while (0)
#define PG8_WAIT_V(n) asm volatile("s_waitcnt vmcnt(" #n ")" ::: "memory")
#define PG8_WAIT_L(n) asm volatile("s_waitcnt lgkmcnt(" #n ")" ::: "memory")
#define PG8_BAR __builtin_amdgcn_s_barrier()
#define PG8_SCHED __builtin_amdgcn_sched_barrier(0)
    Unit cur, nxt; int ui = 0;
    if (!S.next(0, cur)) return;
    f32x4 acc[2][2][4][2];
#pragma unroll
    for (int a = 0; a < 2; ++a)
#pragma unroll
        for (int b = 0; b < 2; ++b)
#pragma unroll
            for (int m = 0; m < 4; ++m)
#pragma unroll
                for (int n = 0; n < 2; ++n) acc[a][b][m][n] = (f32x4){0.f, 0.f, 0.f, 0.f};
    bf16x8 At[4][2], B0[2][2], B1[2][2];
    const char* cA = (const char*)g.A + S.a_off(cur, g.lda); const char* cB = (const char*)g.Bt + S.b_off(cur, K);
    S.a_ready(cur);
    if constexpr (SP2) {
        PG8_STAGE(PG8_SB(0, 0), cB, voffB); PG8_STAGE(PG8_SB(0, 1), cB + hstepB, voffB); PG8_STAGE(PG8_SA(0, 0), cA, voffA); PG8_STAGE(PG8_SA(0, 1), cA + hstepA, voffA);
        if (wr == 1) PG8_BAR;
        PG8_WAIT_V(2); PG8_BAR;
        PG8_STAGE(PG8_SB(1, 0), cB + kstep, voffB); PG8_STAGE(PG8_SA(1, 0), cA + kstep, voffA); PG8_STAGE(PG8_SB(1, 1), cB + hstepB + kstep, voffB);
        PG8_WAIT_V(6); PG8_BAR;
    } else {
        PG8_STAGE(PG8_SB(0, 0), cB, voffB); PG8_STAGE(PG8_SA(0, 0), cA, voffA); PG8_STAGE(PG8_SB(0, 1), cB + hstepB, voffB); PG8_STAGE(PG8_SA(0, 1), cA + hstepA, voffA);
        if (wr == 1) PG8_BAR;
        PG8_WAIT_V(4); PG8_BAR;
        PG8_STAGE(PG8_SB(1, 0), cB + kstep, voffB); PG8_STAGE(PG8_SA(1, 0), cA + kstep, voffA); PG8_STAGE(PG8_SB(1, 1), cB + hstepB + kstep, voffB);
        PG8_WAIT_V(6); PG8_BAR;
    }
    for (;;) {
        const bool has_next = S.next(ui + 1, nxt);
        const char* nA = has_next ? (const char*)g.A + S.a_off(nxt, g.lda) : cA; const char* nB = has_next ? (const char*)g.Bt + S.b_off(nxt, K) : cB;
        for (int t = 0; t < nt; t += 2) {
            const bool last = (t == nt - 2);
            const char* a1 = cA + (size_t)(t + 1) * kstep;
            const char* a2 = last ? nA : cA + (size_t)(t + 2) * kstep; const char* b2 = last ? nB : cB + (size_t)(t + 2) * kstep;
            const char* a3 = a2 + kstep; const char* b3 = b2 + kstep;
            if (last && has_next) S.a_ready(nxt);
            if constexpr (SP2) {
            PG8_LDB(B0, 0, 0); PG8_LDB(B1, 0, 1); PG8_SCHED; PG8_LDA(At, 0, 0); PG8_STAGE(PG8_SA(1, 1), a1 + hstepA, voffA);
            PG8_WAIT_V(8); PG8_WAIT_L(0); PG8_BAR; PG8_MMA(0, 0, At, B0); PG8_MMA(0, 1, At, B1); PG8_BAR; PG8_SCHED;
            PG8_LDA(At, 0, 1); PG8_STAGE(PG8_SB(0, 0), b2, voffB); PG8_STAGE(PG8_SB(0, 1), b2 + hstepB, voffB); PG8_STAGE(PG8_SA(0, 0), a2, voffA);
            PG8_WAIT_V(8); PG8_WAIT_L(0); PG8_BAR; PG8_MMA(1, 0, At, B0); PG8_MMA(1, 1, At, B1); PG8_BAR; PG8_SCHED;
            PG8_LDB(B0, 1, 0); PG8_LDB(B1, 1, 1); PG8_SCHED; PG8_LDA(At, 1, 0); PG8_STAGE(PG8_SA(0, 1), a2 + hstepA, voffA);
            PG8_WAIT_V(8); PG8_WAIT_L(0); PG8_BAR; PG8_MMA(0, 0, At, B0); PG8_MMA(0, 1, At, B1); PG8_BAR; PG8_SCHED;
            PG8_LDA(At, 1, 1); PG8_STAGE(PG8_SB(1, 0), b3, voffB); PG8_STAGE(PG8_SB(1, 1), b3 + hstepB, voffB); PG8_STAGE(PG8_SA(1, 0), a3, voffA);
            PG8_WAIT_V(8); PG8_WAIT_L(0); PG8_BAR; PG8_MMA(1, 0, At, B0); PG8_MMA(1, 1, At, B1); PG8_BAR; PG8_SCHED;
            } else {
            PG8_LDB(B0, 0, 0); PG8_SCHED; PG8_LDA(At, 0, 0); PG8_STAGE(PG8_SA(1, 1), a1 + hstepA, voffA);
            PG8_WAIT_L(8); PG8_BAR; PG8_WAIT_L(0); PG8_MMA(0, 0, At, B0); PG8_BAR; PG8_SCHED;
            PG8_LDB(B1, 0, 1); PG8_STAGE(PG8_SB(0, 0), b2, voffB);
            PG8_BAR; PG8_WAIT_L(0); PG8_MMA(0, 1, At, B1); PG8_BAR;
            PG8_LDA(At, 0, 1); PG8_STAGE(PG8_SA(0, 0), a2, voffA);
            PG8_BAR; PG8_WAIT_L(0); PG8_MMA(1, 0, At, B0); PG8_BAR; PG8_SCHED;
            PG8_STAGE(PG8_SB(0, 1), b2 + hstepB, voffB);
            PG8_WAIT_V(6); PG8_BAR; PG8_MMA(1, 1, At, B1); PG8_BAR;
            PG8_LDB(B0, 1, 0); PG8_SCHED; PG8_LDA(At, 1, 0); PG8_STAGE(PG8_SA(0, 1), a2 + hstepA, voffA);
            PG8_WAIT_L(8); PG8_BAR; PG8_WAIT_L(0); PG8_MMA(0, 0, At, B0); PG8_BAR; PG8_SCHED;
            PG8_LDB(B1, 1, 1); PG8_STAGE(PG8_SB(1, 0), b3, voffB);
            PG8_BAR; PG8_WAIT_L(0); PG8_MMA(0, 1, At, B1); PG8_BAR;
            PG8_LDA(At, 1, 1); PG8_STAGE(PG8_SA(1, 0), a3, voffA);
            PG8_BAR; PG8_WAIT_L(0); PG8_MMA(1, 0, At, B0); PG8_BAR; PG8_SCHED;
            PG8_STAGE(PG8_SB(1, 1), b3 + hstepB, voffB);
            PG8_WAIT_V(6); PG8_BAR; PG8_MMA(1, 1, At, B1); PG8_BAR;
            }
        }
        if constexpr (ALIGN_EPI) { if (wr == 0) PG8_BAR; }
        if constexpr (!Epi::AFTER_DRAIN) { E(acc, cur, wr, wc, fr, fq); S.done(cur); }
        if (!has_next) break;
#pragma unroll
        for (int a = 0; a < 2; ++a)
#pragma unroll
            for (int b = 0; b < 2; ++b)
#pragma unroll
                for (int m = 0; m < 4; ++m)
#pragma unroll
                    for (int n = 0; n < 2; ++n) acc[a][b][m][n] = (f32x4){0.f, 0.f, 0.f, 0.f};
        cur = nxt; cA = nA; cB = nB; ++ui;
        if constexpr (ALIGN_EPI) { if (wr == 1) PG8_BAR; }
    }
    PG8_WAIT_V(0);
    if constexpr (!ALIGN_EPI) { if (wr == 0) PG8_BAR; }
    PG8_BAR;
    if constexpr (Epi::AFTER_DRAIN) { E.fused(acc, cur, wr, wc, fr, fq, lds, wid, lane); S.done(cur); }
#undef PG8_SA
#undef PG8_SB
#undef PG8_STAGE
#undef PG8_LDA
#undef PG8_LDB
#undef PG8_MMA
#undef PG8_WAIT_V
#undef PG8_WAIT_L
#undef PG8_BAR
#undef PG8_SCHED
}
}
namespace mk {
#define GAS __attribute__((address_space(1)))
#define LAS __attribute__((address_space(3)))
typedef unsigned short bf16;
typedef unsigned v4u __attribute__((ext_vector_type(4)));
typedef GAS unsigned gu32;
typedef GAS unsigned long long gu64;
#define RLX_AGENT __ATOMIC_RELAXED, __HIP_MEMORY_SCOPE_AGENT
#define LDS_WAIT() asm volatile("s_waitcnt lgkmcnt(0)" ::: "memory")
#define VM_WAIT() asm volatile("s_waitcnt vmcnt(0)" ::: "memory")
__device__ __forceinline__ unsigned long long rt() { return __builtin_amdgcn_s_memrealtime(); }
__device__ __forceinline__ unsigned f2bf(float f) { unsigned u = __builtin_bit_cast(unsigned, f); return (u + 0x7fffu + ((u >> 16) & 1u)) >> 16; }
__device__ __forceinline__ unsigned pk2(float lo, float hi) { return f2bf(lo) | (f2bf(hi) << 16); }

#define XB_TMO      128
#define XB_XCNT(j)  (256  + 64 * (j))
#define XB_XSUB(j)  (1280 + 64 * (j))
#define XB_XGEN(j)  (2304 + 64 * (j))
#define XB_TOP      3328
#define XB_TOPGEN   3392
#define XCD_BAR_WORDS 3456
#define XB_SPIN_CAP (1u << 20)

__device__ __forceinline__ unsigned xb_ld(unsigned* p)              { return __hip_atomic_load(p, __ATOMIC_RELAXED, __HIP_MEMORY_SCOPE_AGENT); }
__device__ __forceinline__ unsigned xb_add(unsigned* p, unsigned v) { return __hip_atomic_fetch_add(p, v, __ATOMIC_RELAXED, __HIP_MEMORY_SCOPE_AGENT); }
__device__ __forceinline__ unsigned xb_xcc_id() { return (unsigned)__builtin_amdgcn_s_getreg((3 << 11) | 20) & 0xFu; }
#define XB_SPIN(cond, bar) do { unsigned _sp = 0; while (cond) { __builtin_amdgcn_s_sleep(1); \
    if ((++_sp & 255u) == 0u) { if (xb_ld(&(bar)[XB_TMO])) break; if (_sp > XB_SPIN_CAP) { atomicAdd(&(bar)[XB_TMO], 1u); break; } } } } while (0)

struct XcdBarrier {
    unsigned* bar; unsigned x;
    volatile LAS unsigned* st;
};

__device__ __forceinline__ XcdBarrier xcd_barrier_post(unsigned* bar, volatile LAS unsigned* st) {
    XcdBarrier b; b.bar = bar; b.x = xb_xcc_id(); b.st = st;
    if (threadIdx.x == 0) (void)xb_add(&bar[XB_XCNT(b.x)], 1u);
    return b;
}
__device__ __forceinline__ void xcd_barrier_complete(unsigned* bar, unsigned x, unsigned& nloc, unsigned& nx) {
    const unsigned G = gridDim.x * gridDim.y * gridDim.z;
    unsigned sum, cnt, mine, sp = 0u;
    for (;;) {
        sum = 0u; cnt = 0u; mine = 0u;
#pragma unroll
        for (unsigned j = 0; j < 16; ++j) { const unsigned c = xb_ld(&bar[XB_XCNT(j)]); sum += c; cnt += (c > 0u) ? 1u : 0u; mine = (j == x) ? c : mine; }
        if (sum == G) break;
        __builtin_amdgcn_s_sleep(1);
        if ((++sp & 255u) == 0u) { if (xb_ld(&bar[XB_TMO])) break; if (sp > XB_SPIN_CAP) { atomicAdd(&bar[XB_TMO], 1u); break; } }
    }
    nloc = mine > 0u ? mine : 1u; nx = cnt > 0u ? cnt : 1u;
}

__device__ __forceinline__ void xcd_barrier(const XcdBarrier& b) {
    asm volatile("s_waitcnt vmcnt(0)" ::: "memory");
    __syncthreads();
    if (threadIdx.x == 0) {
        unsigned* bar = b.bar;
        __builtin_amdgcn_s_waitcnt(0);
        unsigned nloc = b.st[0], nx = b.st[1];
        if (nloc == 0u) { xcd_barrier_complete(bar, b.x, nloc, nx); b.st[0] = nloc; b.st[1] = nx; }
        const unsigned old = xb_add(&bar[XB_XSUB(b.x)], 1u);
        const unsigned gen = old / nloc;
        if (old + 1u == (gen + 1u) * nloc) {
            __builtin_amdgcn_fence(__ATOMIC_RELEASE, "agent");
            asm volatile("s_waitcnt vmcnt(0)" ::: "memory");
            const unsigned og = xb_add(&bar[XB_TOP], 1u);
            const unsigned tg = og / nx;
            if (og + 1u == (tg + 1u) * nx) xb_add(&bar[XB_TOPGEN], 1u);
            else XB_SPIN(xb_ld(&bar[XB_TOPGEN]) == tg, bar);
            __builtin_amdgcn_fence(__ATOMIC_ACQUIRE, "agent");
            xb_add(&bar[XB_XGEN(b.x)], 1u);
            asm volatile("s_waitcnt vmcnt(0)" ::: "memory");
        } else {
            XB_SPIN(xb_ld(&bar[XB_XGEN(b.x)]) == gen, bar);
            __builtin_amdgcn_fence(__ATOMIC_ACQUIRE, "agent");
            asm volatile("s_waitcnt vmcnt(0)" ::: "memory");
        }
    }
    __syncthreads();
}

}
namespace mk {
using pg8::bf16_t; using pg8::f32x4; using pg8::u32x4; using pg8::bf2f; using pg8::sigm; using pg8::cvt_pk_bf16;
typedef unsigned u32x2 __attribute__((ext_vector_type(2)));
constexpr int NB = 16, SEQ = 4096, CTX = 256, D = 1024, DEPTH = 4, LPB = SEQ + CTX, T = NB * LPB, NTILE = T / 256;
constexpr int NIN = 9760, FFN = 3584, NEXP = 8;
constexpr int LDP = 2560, LDMG = 3072, LDYS = 1536;
constexpr float ALPHA = 1.681792830507429f;
constexpr float LN_EPS = 1e-5f, RMS_EPS = 1e-6f, L2_EPS = 1e-6f;
constexpr int NWAVES = 8, NTHR = 512;

constexpr size_t MiB = 1u << 20;
constexpr size_t WS_CTL = 0, CTL_ZERO_BYTES = 1 * MiB;
constexpr size_t WS_MOD = 1 * MiB;
constexpr size_t WS_COMB = 4 * MiB;
constexpr size_t WS_SC = 7 * MiB;
constexpr size_t WS_W = 16 * MiB;
constexpr size_t LW_BYTES = 29 * MiB, LW_WB = 20 * MiB, LW_WO = 23 * MiB;
constexpr size_t WS_WFFN = WS_W + 4 * LW_BYTES;
constexpr size_t FFNW_BYTES = 21 * MiB, FFNW_WD = 14 * MiB;
constexpr size_t WS_XS = WS_WFFN + 2 * FFNW_BYTES;
constexpr size_t WS_H = WS_XS + 272 * MiB;
constexpr size_t WS_YS = WS_H + 136 * MiB;
constexpr size_t WS_BIG = WS_YS + 204 * MiB;
constexpr size_t WS_O = WS_BIG + 340 * MiB;
constexpr size_t WS_END = WS_BIG + 476 * MiB;
static_assert(WS_XS == 174 * MiB && (size_t)T * 2560 * 2 == 340 * MiB && (size_t)T * 3584 * 2 == 476 * MiB && (size_t)T * 1024 * 4 == 272 * MiB, "ws map");
constexpr int CW_BAR = 4096;

constexpr int RING_BYTES = 131072, LDSCTL_OFF = RING_BYTES, LDS_BYTES = 147456;


struct Args { const float* in[24]; float* out; unsigned char* ws; int ph_lo, ph_hi; };
enum { I_X = 0, I_C, I_CTX, I_CCTX, I_WADA, I_BADA, I_WIN, I_CONVW, I_LBRAW, I_MGB, I_ALOG, I_DTB, I_MIXN, I_WBR, I_WOUT, I_LNG, I_LNB, I_FG, I_FU, I_FD, I_ROUTER, I_MG, I_MU, I_MD };

__device__ __forceinline__ int opaque_tid() { int t = threadIdx.x; asm volatile("" : "+v"(t)); return t; }
__device__ __forceinline__ float wave_sum(float v) {
#pragma unroll
    for (int o = 1; o < 64; o <<= 1) v += __shfl_xor(v, o);
    return v;
}
__device__ __forceinline__ float silu_f(float x) { return x * sigm(x); }

__device__ __forceinline__ void tr_item(const float* colp, size_t ldw, bf16_t* dst, size_t ldd, int nrep, size_t repstride, LAS float* scr, int lane) {
#pragma unroll 8
    for (int i = 0; i < 32; ++i) { const int kk = 2 * i + (lane >> 5); scr[kk * 33 + (lane & 31)] = colp ? colp[(size_t)kk * ldw] : 0.f; }
    LDS_WAIT(); asm volatile("" ::: "memory");
    const int c = lane & 7;
#pragma unroll
    for (int j = 0; j < 4; ++j) { const int n = (lane >> 3) + 8 * j; const LAS float* s = scr + (8 * c) * 33 + n;
        v4u o; o.x = pk2(s[0 * 33], s[1 * 33]); o.y = pk2(s[2 * 33], s[3 * 33]); o.z = pk2(s[4 * 33], s[5 * 33]); o.w = pk2(s[6 * 33], s[7 * 33]);
        for (int r = 0; r < nrep; ++r) *(v4u*)(dst + (size_t)n * ldd + 8 * c + r * repstride) = o; }
    LDS_WAIT(); asm volatile("" ::: "memory");
}
__device__ __forceinline__ int win_col(int r) {
    if (r < 4608) return r;
    if (r < 4864) { const int rr = r - 4608; return rr < 16 ? 4608 + rr : (rr < 32 ? 6672 + (rr - 16) : -1); }
    if (r < 6912) return 4624 + (r - 4864);
    return 6688 + (r - 6912);
}
constexpr int IT_WIN = 16 * 312, IT_WB = 3 * 8 * 32, IT_WO = 16 * 32, IT_LAYER = IT_WIN + IT_WB + IT_WO;
constexpr int IT_GU = 16 * 224, IT_DN = 56 * 32, IT_FFN = IT_GU + IT_DN;
__device__ __forceinline__ void conv_ffn_item(const float* wg, const float* wu, const float* wd, bf16_t* gu_t, bf16_t* dn_t, int r, LAS float* scr, int lane) {
    const int ln = lane & 31;
    if (r < IT_GU) { const int kb = r / 224, nb = r % 224, k0 = 64 * kb, r0 = 32 * nb, tile = r0 >> 8, within = r0 & 255;
        const float* src = (within < 128) ? wg + (size_t)k0 * FFN + tile * 128 + within + ln : wu + (size_t)k0 * FFN + tile * 128 + (within - 128) + ln;
        tr_item(src, FFN, gu_t + (size_t)r0 * D + k0, D, 1, 0, scr, lane); return; }
    r -= IT_GU;
    { const int kb = r / 32, nb = r % 32, k0 = 64 * kb, n0 = 32 * nb;
        tr_item(wd + (size_t)k0 * D + n0 + ln, D, dn_t + (size_t)n0 * FFN + k0, FFN, 1, 0, scr, lane); }
}
__device__ __forceinline__ void conv_layer_item(const Args& a, int l, int r, LAS float* scr, int lane) {
    unsigned char* lw = a.ws + WS_W + (size_t)l * LW_BYTES; const int ln = lane & 31;
    if (r < IT_WIN) { const int kb = r / 312, nb = r % 312, k0 = 64 * kb, col = win_col(32 * nb + ln);
        const float* src = col >= 0 ? a.in[I_WIN] + ((size_t)l * D + k0) * NIN + col : nullptr;
        tr_item(src, NIN, (bf16_t*)lw + (size_t)(32 * nb) * D + k0, D, 1, 0, scr, lane); return; }
    r -= IT_WIN;
    if (r < IT_WB) { const int n = r / 256, rem = r % 256, kb = rem / 32, nb = rem % 32, k0 = 64 * kb, n0 = 32 * nb;
        tr_item(a.in[I_WBR] + ((size_t)(l * 3 + n) * 512 + k0) * D + n0 + ln, D, (bf16_t*)(lw + LW_WB) + (size_t)(n * 1024 + n0) * 512 + k0, 512, 1, 0, scr, lane); return; }
    r -= IT_WB;
    { const int kb = r / 32, nb = r % 32, k0 = 64 * kb, n0 = 32 * nb;
        tr_item(a.in[I_WOUT] + ((size_t)l * D + k0) * D + n0 + ln, D, (bf16_t*)(lw + LW_WO) + (size_t)n0 * 3072 + k0, 3072, 3, 1024, scr, lane); }
}

__device__ __forceinline__ void pro_a(const Args& a, LAS unsigned char* lds) {
    const int tid = opaque_tid(), lane = tid & 63, wave = __builtin_amdgcn_readfirstlane(tid >> 6), G = gridDim.x;
    LAS float* s_lds = (LAS float*)lds;
    LAS float* red = s_lds + 17 * 1024;
    for (int i = tid; i < 17 * 1024; i += NTHR) { const int mi = i >> 10, k = i & 1023; const float c = mi < 16 ? a.in[I_C][mi * 1024 + k] : a.in[I_CCTX][k]; s_lds[i] = silu_f(c); }
    __syncthreads();
    float* MOD = (float*)(a.ws + WS_MOD);
    for (int it = blockIdx.x; it < DEPTH * 96; it += G) {
        const int l = it / 96, jg = it % 96;
        const float* wp = a.in[I_WADA] + ((size_t)l * D + wave * 128) * 6144 + jg * 64 + lane;
        float acc[17];
#pragma unroll
        for (int mi = 0; mi < 17; ++mi) acc[mi] = 0.f;
        for (int k = 0; k < 128; k += 4) {
            const float w0 = wp[(size_t)(k + 0) * 6144], w1 = wp[(size_t)(k + 1) * 6144], w2 = wp[(size_t)(k + 2) * 6144], w3 = wp[(size_t)(k + 3) * 6144];
#pragma unroll
            for (int mi = 0; mi < 17; ++mi) { const f32x4 sv = *(const LAS f32x4*)(s_lds + mi * 1024 + wave * 128 + k); acc[mi] += sv[0] * w0 + sv[1] * w1 + sv[2] * w2 + sv[3] * w3; }
        }
#pragma unroll
        for (int mi = 0; mi < 17; ++mi) red[(wave * 17 + mi) * 64 + lane] = acc[mi];
        __syncthreads();
        for (int i = tid; i < 17 * 64; i += NTHR) { const int mi = i >> 6, ln = i & 63; float s = a.in[I_BADA][l * 6144 + jg * 64 + ln];
#pragma unroll
            for (int w = 0; w < 8; ++w) s += red[(w * 17 + mi) * 64 + ln];
            MOD[(size_t)(l * 17 + mi) * 6144 + jg * 64 + ln] = s; }
        __syncthreads();
    }
    __syncthreads();
    LAS float* scr = (LAS float*)(lds + wave * 16384);
    const int gw = blockIdx.x * NWAVES + wave, NGW = G * NWAVES;
    constexpr int NITEMS = DEPTH * IT_LAYER + 2 * IT_FFN;
    for (int it = gw; it < NITEMS; it += NGW) {
        if (it < DEPTH * IT_LAYER) { conv_layer_item(a, it / IT_LAYER, it % IT_LAYER, scr, lane); continue; }
        const int r = it - DEPTH * IT_LAYER, i = r / IT_FFN;
        unsigned char* fw = a.ws + WS_WFFN + (size_t)i * FFNW_BYTES;
        conv_ffn_item(a.in[I_FG] + (size_t)i * D * FFN, a.in[I_FU] + (size_t)i * D * FFN, a.in[I_FD] + (size_t)i * FFN * D, (bf16_t*)fw, (bf16_t*)(fw + FFNW_WD), r % IT_FFN, scr, lane);
    }
}
__device__ __forceinline__ void conv_moe(const Args& a, int i, LAS unsigned char* lds) {
    const int tid = opaque_tid(), lane = tid & 63, wave = __builtin_amdgcn_readfirstlane(tid >> 6), G = gridDim.x;
    LAS float* scr = (LAS float*)(lds + wave * 16384);
    const int gw = blockIdx.x * NWAVES + wave, NGW = G * NWAVES;
    for (int it = gw; it < NEXP * IT_FFN; it += NGW) {
        const int e = it / IT_FFN; const size_t eo = (size_t)(i * NEXP + e) * D * FFN;
        unsigned char* fw = a.ws + WS_YS + (size_t)e * FFNW_BYTES;
        conv_ffn_item(a.in[I_MG] + eo, a.in[I_MU] + eo, a.in[I_MD] + eo, (bf16_t*)fw, (bf16_t*)(fw + FFNW_WD), it % IT_FFN, scr, lane);
    }
}

template <int MODE> __device__ __forceinline__ void rowpass(const Args& a, int l, LAS unsigned char* lds) {
    const int tid = opaque_tid(), lane = tid & 63, wave = __builtin_amdgcn_readfirstlane(tid >> 6), G = gridDim.x;
    const float* MOD = (const float*)(a.ws + WS_MOD);
    float* XS = (float*)(a.ws + WS_XS); bf16_t* H = (bf16_t*)(a.ws + WS_H); float* COMB = (float*)(a.ws + WS_COMB);
    LAS float* wr = (LAS float*)lds;
    const bool moe = (MODE == 1) && (l & 1);
    if (moe) { const float* r = a.in[I_ROUTER] + (size_t)(l >> 1) * D * NEXP;
        for (int i = tid; i < D * NEXP; i += NTHR) { const int k = i >> 3, e = i & 7; wr[e * 1024 + k] = r[i]; }
        __syncthreads(); }
    const int gw = blockIdx.x * NWAVES + wave, NGW = G * NWAVES;
    const int lh = (MODE == 2) ? l + 1 : l, si = (MODE == 1) ? 3 : 0;
    for (int row = gw; row < T; row += NGW) {
        const int b = row / LPB, p = row - b * LPB; const bool isctx = p < CTX; const int mi = isctx ? 16 : b;
        const float* src = (MODE == 0) ? (isctx ? a.in[I_CTX] + ((size_t)b * CTX + p) * D : a.in[I_X] + ((size_t)b * SEQ + (p - CTX)) * D) : XS + (size_t)row * D;
        f32x4 v[4];
#pragma unroll
        for (int j = 0; j < 4; ++j) v[j] = ((const f32x4*)src)[lane + 64 * j];
        if (MODE != 0) {
            float s = 0.f;
#pragma unroll
            for (int j = 0; j < 4; ++j) s += (v[j][0] + v[j][1]) + (v[j][2] + v[j][3]);
            const float mean = wave_sum(s) * (1.f / D); float s2 = 0.f;
#pragma unroll
            for (int j = 0; j < 4; ++j) { v[j] = v[j] - mean; s2 += (v[j][0] * v[j][0] + v[j][1] * v[j][1]) + (v[j][2] * v[j][2] + v[j][3] * v[j][3]); }
            const float rstd = 1.0f / sqrtf(wave_sum(s2) * (1.f / D) + LN_EPS);
            const float* gp = a.in[I_LNG] + (size_t)(l * 2 + (MODE - 1)) * D; const float* bp = a.in[I_LNB] + (size_t)(l * 2 + (MODE - 1)) * D;
#pragma unroll
            for (int j = 0; j < 4; ++j) v[j] = v[j] * rstd * ((const f32x4*)gp)[lane + 64 * j] + ((const f32x4*)bp)[lane + 64 * j];
        }
        if (MODE == 2 && l == DEPTH - 1) {
            if (!isctx) { f32x4* o = (f32x4*)(a.out + ((size_t)b * SEQ + (p - CTX)) * D);
#pragma unroll
                for (int j = 0; j < 4; ++j) o[lane + 64 * j] = v[j]; }
            continue;
        }
#pragma unroll
        for (int j = 0; j < 4; ++j) ((f32x4*)(XS + (size_t)row * D))[lane + 64 * j] = v[j];
        float s = 0.f;
#pragma unroll
        for (int j = 0; j < 4; ++j) s += (v[j][0] + v[j][1]) + (v[j][2] + v[j][3]);
        const float mean = wave_sum(s) * (1.f / D); float s2 = 0.f;
#pragma unroll
        for (int j = 0; j < 4; ++j) { v[j] = v[j] - mean; s2 += (v[j][0] * v[j][0] + v[j][1] * v[j][1]) + (v[j][2] * v[j][2] + v[j][3] * v[j][3]); }
        const float rstd = 1.0f / sqrtf(wave_sum(s2) * (1.f / D) + LN_EPS);
        const float* shp = MOD + (size_t)(lh * 17 + mi) * 6144 + si * 1024; const float* scp = shp + 1024;
#pragma unroll
        for (int j = 0; j < 4; ++j) { const f32x4 sc = ((const f32x4*)scp)[lane + 64 * j], sh = ((const f32x4*)shp)[lane + 64 * j];
            v[j] = v[j] * rstd * (sc + 1.0f) + sh;
            u32x2 w; w.x = cvt_pk_bf16(v[j][0], v[j][1]); w.y = cvt_pk_bf16(v[j][2], v[j][3]);
            ((u32x2*)(H + (size_t)row * D))[lane + 64 * j] = w; }
        if (moe) {
            float lg[8];
#pragma unroll
            for (int e = 0; e < 8; ++e) { float t = 0.f;
#pragma unroll
                for (int j = 0; j < 4; ++j) { const f32x4 w4 = *(const LAS f32x4*)(wr + e * 1024 + 4 * (lane + 64 * j)); t += v[j][0] * w4[0] + v[j][1] * w4[1] + v[j][2] * w4[2] + v[j][3] * w4[3]; }
                lg[e] = wave_sum(t); }
            int i1 = 0; float v1 = lg[0];
#pragma unroll
            for (int e = 1; e < 8; ++e) if (lg[e] > v1) { v1 = lg[e]; i1 = e; }
            int i2 = -1; float v2 = -3.0e38f;
#pragma unroll
            for (int e = 0; e < 8; ++e) if (e != i1 && lg[e] > v2) { v2 = lg[e]; i2 = e; }
            const float p1 = 1.0f / (1.0f + __expf(v2 - v1)), p2 = 1.0f - p1;
            if (lane < 8) COMB[(size_t)row * 8 + lane] = (lane == i1) ? p1 : ((lane == i2) ? p2 : 0.f);
        }
    }
}

__device__ __forceinline__ int pos_of_step(int st, int dir, bool colmajor) {
    if (st < CTX) return dir ? (CTX - 1 - st) : st;
    int u = st - CTX; if (dir) u = SEQ - 1 - u;
    if (colmajor) u = (u & 63) * 64 + (u >> 6);
    return CTX + u;
}
__device__ __forceinline__ float red8(float v) { v += __shfl_xor(v, 1); v += __shfl_xor(v, 2); v += __shfl_xor(v, 4); return v; }
__device__ __forceinline__ f32x4 ld_bf16x4(const bf16_t* p) { const u32x2 w = *(const u32x2*)p; return (f32x4){__uint_as_float(w.x << 16), __uint_as_float(w.x & 0xffff0000u), __uint_as_float(w.y << 16), __uint_as_float(w.y & 0xffff0000u)}; }
constexpr int NSUB = LPB / 16;

#define SCAN_LDS() LAS float* qs = (LAS float*)lds; LAS float* ks = qs + 2048; LAS float* vs = ks + 2048; LAS float* os = vs + 1024; LAS float* sc0 = os + 1024; LAS float* sc1 = sc0 + 16; LAS float* misc = sc1 + 16
#define SCAN_WRITEOUT(scx, cm) do { const int _s = tid >> 5, _j = (tid & 31) * 2; const int _row = b * LPB + pos_of_step((scx) * 16 + _s, dir, cm); \
        *(unsigned*)(O + ((size_t)dir * T + _row) * 512 + h * 128 + vh * 64 + _j) = cvt_pk_bf16(os[_s * 64 + _j], os[_s * 64 + _j + 1]); } while (0)

__device__ __forceinline__ void scanA_phase(const Args& a, int l, LAS unsigned char* lds) {
    const int tid = opaque_tid(), k8 = tid & 7, jl = tid >> 3;
    const bf16_t* P = (const bf16_t*)(a.ws + WS_BIG); bf16_t* O = (bf16_t*)(a.ws + WS_O);
    SCAN_LDS();
    for (int it = blockIdx.x; it < 256; it += gridDim.x) {
        const int vh = it & 1, dir = (it >> 1) & 1, h = (it >> 2) & 3, b = it >> 4;
        __syncthreads();
        if (tid < 128) { const int c = h * 128 + tid; const float* lr = a.in[I_LBRAW];
            const float r0 = lr[c], r1 = lr[512 + c], r2 = lr[1024 + c], r3 = lr[1536 + c]; const float mx = fmaxf(fmaxf(r0, r1), fmaxf(r2, r3));
            const float e0 = __expf(r0 - mx), e1 = __expf(r1 - mx), e2 = __expf(r2 - mx), e3 = __expf(r3 - mx), inv = 1.0f / (e0 + e1 + e2 + e3);
            float cs = 0.f; if (l >= 1) cs += e1; if (l >= 2) cs += e2; if (l >= 3) cs += e3;
            misc[tid] = cs * inv; }
        float S[16];
#pragma unroll
        for (int i = 0; i < 16; ++i) S[i] = 0.f;
        for (int sc = 0; sc < NSUB; ++sc) {
            __syncthreads();
            if (sc > 0) SCAN_WRITEOUT(sc - 1, false);
            { const int s = tid >> 5, c4 = (tid & 31) * 4; const int row = b * LPB + pos_of_step(sc * 16 + s, dir, false);
                const bf16_t* pr = P + (size_t)row * LDP + h * 128;
                const f32x4 q = ld_bf16x4(pr + c4), fp = ld_bf16x4(pr + (1 + dir) * 512 + c4); f32x4 f;
#pragma unroll
                for (int j = 0; j < 4; ++j) { const float lb = misc[c4 + j]; f[j] = lb + (1.0f - lb) * sigm(fp[j]); }
                *(LAS f32x4*)(qs + s * 128 + c4) = q; *(LAS f32x4*)(ks + s * 128 + c4) = f;
                const int j2 = (tid & 31) * 2; const unsigned vv = *(const unsigned*)(pr + 1536 + vh * 64 + j2);
                vs[s * 64 + j2] = __uint_as_float(vv << 16); vs[s * 64 + j2 + 1] = __uint_as_float(vv & 0xffff0000u); }
            __syncthreads();
#pragma unroll 2
            for (int s = 0; s < 16; ++s) {
                const float v = vs[s * 64 + jl]; float o = 0.f;
#pragma unroll
                for (int i = 0; i < 4; ++i) { const f32x4 q = *(const LAS f32x4*)(qs + s * 128 + k8 * 16 + 4 * i), f = *(const LAS f32x4*)(ks + s * 128 + k8 * 16 + 4 * i);
#pragma unroll
                    for (int e = 0; e < 4; ++e) { S[4 * i + e] = v + f[e] * (S[4 * i + e] - v); o += q[e] * S[4 * i + e]; } }
                o = red8(o);
                if (k8 == 0) os[s * 64 + jl] = o;
            }
        }
        __syncthreads();
        SCAN_WRITEOUT(NSUB - 1, false);
    }
}

__device__ __forceinline__ void scanB_phase(const Args& a, int l, LAS unsigned char* lds) {
    const int tid = opaque_tid(), k8 = tid & 7, jl = tid >> 3;
    const bf16_t* P = (const bf16_t*)(a.ws + WS_BIG); bf16_t* O = (bf16_t*)(a.ws + WS_O); const float* SC = (const float*)(a.ws + WS_SC);
    SCAN_LDS(); (void)misc;
    for (int it = blockIdx.x; it < 256; it += gridDim.x) {
        const int vh = it & 1, dir = (it >> 1) & 1, h = (it >> 2) & 3, b = it >> 4;
        const float bi = a.in[I_MGB][l * 16 + dir * 4 + h], bfg = a.in[I_MGB][l * 16 + (2 + dir) * 4 + h];
        float S[16], n[16], m = 0.f;
#pragma unroll
        for (int i = 0; i < 16; ++i) { S[i] = 0.f; n[i] = 0.f; }
        for (int sc = 0; sc < NSUB; ++sc) {
            __syncthreads();
            if (sc > 0) SCAN_WRITEOUT(sc - 1, true);
            { const int s = tid >> 5, c4 = (tid & 31) * 4; const int row = b * LPB + pos_of_step(sc * 16 + s, dir, true);
                const bf16_t* pr = P + (size_t)row * LDP + h * 128;
                const f32x4 q = ld_bf16x4(pr + c4), k = ld_bf16x4(pr + 512 + c4) * 0.08838834764831845f;
                *(LAS f32x4*)(qs + s * 128 + c4) = q; *(LAS f32x4*)(ks + s * 128 + c4) = k;
                const int j2 = (tid & 31) * 2; const unsigned vv = *(const unsigned*)(pr + 1024 + vh * 64 + j2);
                vs[s * 64 + j2] = __uint_as_float(vv << 16); vs[s * 64 + j2 + 1] = __uint_as_float(vv & 0xffff0000u);
                if ((tid & 31) == 0) { const float ig = SC[(size_t)row * 32 + dir * 4 + h] + bi, fg = SC[(size_t)row * 32 + (2 + dir) * 4 + h] + bfg;
                    sc0[s] = ig; sc1[s] = fminf(fg, 0.f) - log1pf(__expf(-fabsf(fg))); } }
            __syncthreads();
#pragma unroll 2
            for (int s = 0; s < 16; ++s) {
                const float ig = sc0[s], lf = sc1[s]; const float mn = fmaxf(lf + m, ig), ip = __expf(ig - mn), fp = __expf(lf + m - mn); m = mn;
                const float v = vs[s * 64 + jl] * ip; float num = 0.f, den = 0.f;
#pragma unroll
                for (int i = 0; i < 4; ++i) { const f32x4 q = *(const LAS f32x4*)(qs + s * 128 + k8 * 16 + 4 * i), k = *(const LAS f32x4*)(ks + s * 128 + k8 * 16 + 4 * i);
#pragma unroll
                    for (int e = 0; e < 4; ++e) { S[4 * i + e] = fp * S[4 * i + e] + k[e] * v; n[4 * i + e] = fp * n[4 * i + e] + ip * k[e]; num += q[e] * S[4 * i + e]; den += q[e] * n[4 * i + e]; } }
                num = red8(num); den = red8(den);
                if (k8 == 0) os[s * 64 + jl] = num / fmaxf(fabsf(den), __expf(-mn));
            }
        }
        __syncthreads();
        SCAN_WRITEOUT(NSUB - 1, true);
    }
}

__device__ __forceinline__ void scanC_phase(const Args& a, int l, LAS unsigned char* lds) {
    const int tid = opaque_tid(), k8 = tid & 7, jl = tid >> 3;
    const bf16_t* P = (const bf16_t*)(a.ws + WS_BIG); bf16_t* O = (bf16_t*)(a.ws + WS_O); const float* SC = (const float*)(a.ws + WS_SC);
    SCAN_LDS(); (void)misc;
    for (int it = blockIdx.x; it < 256; it += gridDim.x) {
        const int vh = it & 1, dir = (it >> 1) & 1, h = (it >> 2) & 3, b = it >> 4;
        const float nalog = -__expf(a.in[I_ALOG][l * 8 + dir * 4 + h]), dtb = a.in[I_DTB][l * 8 + dir * 4 + h];
        const int c4 = (tid & 31) * 4, j2 = (tid & 31) * 2;
        const float* cw = a.in[I_CONVW] + (size_t)l * 3 * 1536;
        f32x4 wq[3], wk[3]; float wv[3][2];
#pragma unroll
        for (int j = 0; j < 3; ++j) { wq[j] = *(const f32x4*)(cw + j * 1536 + h * 128 + c4); wk[j] = *(const f32x4*)(cw + j * 1536 + 512 + h * 128 + c4);
            wv[j][0] = cw[j * 1536 + 1024 + h * 128 + vh * 64 + j2]; wv[j][1] = cw[j * 1536 + 1024 + h * 128 + vh * 64 + j2 + 1]; }
        float S[16];
#pragma unroll
        for (int i = 0; i < 16; ++i) S[i] = 0.f;
        for (int sc = 0; sc < NSUB; ++sc) {
            __syncthreads();
            if (sc > 0) SCAN_WRITEOUT(sc - 1, false);
            { const int s = tid >> 5; const int pos = pos_of_step(sc * 16 + s, dir, false); const int row = b * LPB + pos;
                const bool isctx = pos < CTX; const int lp = isctx ? pos : pos - CTX, Ls = isctx ? CTX : SEQ;
                const bool hasm = lp > 0, hasp = lp < Ls - 1;
                const bf16_t* pr = P + (size_t)row * LDP + h * 128;
                const f32x4 z4 = (f32x4){0.f, 0.f, 0.f, 0.f};
                f32x4 xq = ld_bf16x4(pr + c4) * wq[1]; if (hasm) xq += ld_bf16x4(pr - LDP + c4) * wq[0]; if (hasp) xq += ld_bf16x4(pr + LDP + c4) * wq[2];
                f32x4 xk = ld_bf16x4(pr + 512 + c4) * wk[1]; if (hasm) xk += ld_bf16x4(pr - LDP + 512 + c4) * wk[0]; if (hasp) xk += ld_bf16x4(pr + LDP + 512 + c4) * wk[2];
                (void)z4;
                float sq = 0.f, sk = 0.f;
#pragma unroll
                for (int j = 0; j < 4; ++j) { xq[j] = silu_f(xq[j]); xk[j] = silu_f(xk[j]); sq += xq[j] * xq[j]; sk += xk[j] * xk[j]; }
#pragma unroll
                for (int o = 1; o < 32; o <<= 1) { sq += __shfl_xor(sq, o); sk += __shfl_xor(sk, o); }
                const float rq = 0.08838834764831845f / sqrtf(sq + L2_EPS), rk = 1.0f / sqrtf(sk + L2_EPS);
                *(LAS f32x4*)(qs + s * 128 + c4) = xq * rq; *(LAS f32x4*)(ks + s * 128 + c4) = xk * rk;
                const bf16_t* pv = pr + 1024 + vh * 64 + j2;
                unsigned v0 = *(const unsigned*)pv; float a0 = __uint_as_float(v0 << 16) * wv[1][0], a1 = __uint_as_float(v0 & 0xffff0000u) * wv[1][1];
                if (hasm) { v0 = *(const unsigned*)(pv - LDP); a0 += __uint_as_float(v0 << 16) * wv[0][0]; a1 += __uint_as_float(v0 & 0xffff0000u) * wv[0][1]; }
                if (hasp) { v0 = *(const unsigned*)(pv + LDP); a0 += __uint_as_float(v0 << 16) * wv[2][0]; a1 += __uint_as_float(v0 & 0xffff0000u) * wv[2][1]; }
                vs[s * 64 + j2] = silu_f(a0); vs[s * 64 + j2 + 1] = silu_f(a1);
                if ((tid & 31) == 0) { const float ap = SC[(size_t)row * 32 + 16 + dir * 4 + h] + dtb, bp = SC[(size_t)row * 32 + 16 + (2 + dir) * 4 + h];
                    const float sp = fmaxf(ap, 0.f) + log1pf(__expf(-fabsf(ap)));
                    sc0[s] = __expf(nalog * sp); sc1[s] = sigm(bp); } }
            __syncthreads();
#pragma unroll 2
            for (int s = 0; s < 16; ++s) {
                const float av = sc0[s], bv = sc1[s], v = vs[s * 64 + jl];
                f32x4 k[4]; float kS = 0.f;
#pragma unroll
                for (int i = 0; i < 4; ++i) { k[i] = *(const LAS f32x4*)(ks + s * 128 + k8 * 16 + 4 * i);
#pragma unroll
                    for (int e = 0; e < 4; ++e) kS += k[i][e] * S[4 * i + e]; }
                kS = red8(kS);
                const float w = bv * (v - av * kS); float o = 0.f;
#pragma unroll
                for (int i = 0; i < 4; ++i) { const f32x4 q = *(const LAS f32x4*)(qs + s * 128 + k8 * 16 + 4 * i);
#pragma unroll
                    for (int e = 0; e < 4; ++e) { S[4 * i + e] = av * S[4 * i + e] + k[i][e] * w; o += q[e] * S[4 * i + e]; } }
                o = red8(o);
                if (k8 == 0) os[s * 64 + jl] = o;
            }
        }
        __syncthreads();
        SCAN_WRITEOUT(NSUB - 1, false);
    }
}

__device__ __forceinline__ void finalize_phase(const Args& a, int l, int mx, LAS unsigned char* lds) {
    const int tid = opaque_tid(), lane = tid & 63, wave = __builtin_amdgcn_readfirstlane(tid >> 6), G = gridDim.x;
    const bf16_t* P = (const bf16_t*)(a.ws + WS_BIG); const bf16_t* O = (const bf16_t*)(a.ws + WS_O); bf16_t* YS = (bf16_t*)(a.ws + WS_YS);
    const int gate_off = (mx == 0) ? 2048 : 1536, c8 = lane * 8;
    const float* gn = a.in[I_MIXN] + (size_t)(l * 3 + mx) * 512 + c8;
    const f32x4 g0 = *(const f32x4*)gn, g1 = *(const f32x4*)(gn + 4);
    const int gw = blockIdx.x * NWAVES + wave, NGW = G * NWAVES;
    for (int row = gw; row < T; row += NGW) {
        const u32x4 of = *(const u32x4*)(O + (size_t)row * 512 + c8), ob = *(const u32x4*)(O + ((size_t)T + row) * 512 + c8), gt = *(const u32x4*)(P + (size_t)row * LDP + gate_off + c8);
        float o[8], g[8];
#pragma unroll
        for (int j = 0; j < 4; ++j) { o[2 * j] = __uint_as_float(of[j] << 16) + __uint_as_float(ob[j] << 16); o[2 * j + 1] = __uint_as_float(of[j] & 0xffff0000u) + __uint_as_float(ob[j] & 0xffff0000u);
            g[2 * j] = __uint_as_float(gt[j] << 16); g[2 * j + 1] = __uint_as_float(gt[j] & 0xffff0000u); }
        float ss = 0.f;
#pragma unroll
        for (int j = 0; j < 8; ++j) ss += o[j] * o[j];
        ss += __shfl_xor(ss, 1); ss += __shfl_xor(ss, 2); ss += __shfl_xor(ss, 4); ss += __shfl_xor(ss, 8);
        const float r = 1.0f / sqrtf(ss * (1.0f / 128.0f) + RMS_EPS);
        float y[8];
#pragma unroll
        for (int j = 0; j < 8; ++j) { const float gain = j < 4 ? g0[j & 3] : g1[j & 3]; const float act = (mx == 1) ? sigm(g[j]) : silu_f(g[j]); y[j] = o[j] * r * gain * act; }
        u32x4 w; w.x = cvt_pk_bf16(y[0], y[1]); w.y = cvt_pk_bf16(y[2], y[3]); w.z = cvt_pk_bf16(y[4], y[5]); w.w = cvt_pk_bf16(y[6], y[7]);
        *(u32x4*)(YS + (size_t)row * LDYS + mx * 512 + c8) = w;
    }
}

#ifdef NO_SCANS
#define SCAN_CALL(x)
#else
#define SCAN_CALL(x) x
#endif
#ifdef NO_ROWS
#define ROW_CALL(x)
#else
#define ROW_CALL(x) x
#endif
#ifndef SITES
#define SITES 0xff
#endif
#define GEMM_SITE(i) if ((SITES >> (i)) & 1)
#ifndef MK_ONE_LAUNCH
#define MK_ONE_LAUNCH 0
#endif
constexpr int PH_TOTAL = 2 + 2 * (13 + 2 + 1) + 2 * (13 + 16 + 1);

__global__ void __launch_bounds__(NTHR, 2) mk_fwd(Args a) {
    extern __shared__ __attribute__((aligned(16))) unsigned char lds_raw[];
    LAS unsigned char* lds = (LAS unsigned char*)lds_raw;
    const int tid = opaque_tid(), G = gridDim.x;
    for (int u = tid; u < (LDS_BYTES - LDSCTL_OFF) / 4; u += NTHR) ((LAS unsigned*)(lds + LDSCTL_OFF))[u] = 0u;
    __syncthreads();
    volatile LAS unsigned* MISC = (volatile LAS unsigned*)(lds + LDSCTL_OFF + 320);
    unsigned* ctl = (unsigned*)(a.ws + WS_CTL);
    const int lo = a.ph_lo, hi = a.ph_hi;
    XcdBarrier bar; bar.bar = ctl + CW_BAR; bar.x = 0; bar.st = nullptr;
    if (hi - lo > 1) bar = xcd_barrier_post(ctl + CW_BAR, MISC + 8);
    int ph = 0;
#define RUN (ph >= lo && ph < hi)
#define NEXT() do { if (RUN && ph + 1 < hi) xcd_barrier(bar); ++ph; } while (0)
    bf16_t* H = (bf16_t*)(a.ws + WS_H); bf16_t* YS = (bf16_t*)(a.ws + WS_YS); bf16_t* BIG = (bf16_t*)(a.ws + WS_BIG);
    float* XS = (float*)(a.ws + WS_XS); float* SC = (float*)(a.ws + WS_SC); const float* MOD = (const float*)(a.ws + WS_MOD); const float* COMB = (const float*)(a.ws + WS_COMB);

    if (RUN) { ROW_CALL(pro_a(a, lds)); }
    NEXT();
    if (RUN) { ROW_CALL(rowpass<0>(a, 0, lds)); }
    NEXT();
    for (int l = 0; l < DEPTH; ++l) {
        unsigned char* lw = a.ws + WS_W + (size_t)l * LW_BYTES;
        const bf16_t* WinT = (const bf16_t*)lw; const bf16_t* WbT = (const bf16_t*)(lw + LW_WB); const bf16_t* WoT = (const bf16_t*)(lw + LW_WO);
        if (RUN) { pg8::Gemm g{H, WinT, D, D}; pg8::StaticOrder S; S.init(T, 2560, G, (int)blockIdx.x); pg8::EpiP E{BIG, LDP, nullptr, -1, 0};
            GEMM_SITE(0) pg8::gemm_phase<pg8::EpiP, pg8::StaticOrder, true, true>(lds, g, S, E); }
        NEXT();
        if (RUN) { SCAN_CALL(scanA_phase(a, l, lds)); }
        NEXT();
        if (RUN) { ROW_CALL(finalize_phase(a, l, 0, lds)); }
        NEXT();
        if (RUN) { pg8::Gemm g{H, WinT + (size_t)2560 * D, D, D}; pg8::StaticOrder S; S.init(T, 2304, G, (int)blockIdx.x); pg8::EpiP E{BIG, LDP, SC, 8, 0};
            GEMM_SITE(1) pg8::gemm_phase<pg8::EpiP, pg8::StaticOrder, true, true>(lds, g, S, E); }
        NEXT();
        if (RUN) { SCAN_CALL(scanB_phase(a, l, lds)); }
        NEXT();
        if (RUN) { ROW_CALL(finalize_phase(a, l, 1, lds)); }
        NEXT();
        if (RUN) { pg8::Gemm g{H, WinT + (size_t)4864 * D, D, D}; pg8::StaticOrder S; S.init(T, 2048, G, (int)blockIdx.x); pg8::EpiP E{BIG, LDP, nullptr, -1, 0};
            GEMM_SITE(2) pg8::gemm_phase<pg8::EpiP, pg8::StaticOrder, true, true>(lds, g, S, E); }
        NEXT();
        if (RUN) { SCAN_CALL(scanC_phase(a, l, lds)); }
        NEXT();
        if (RUN) { ROW_CALL(finalize_phase(a, l, 2, lds)); }
        NEXT();
        if (RUN) { pg8::Gemm g{H, WinT + (size_t)6912 * D, D, D}; pg8::StaticOrder S; S.init(T, 3072, G, (int)blockIdx.x); pg8::EpiP E{BIG, LDMG, nullptr, -1, 1};
            GEMM_SITE(3) pg8::gemm_phase<pg8::EpiP, pg8::StaticOrder, true, true>(lds, g, S, E); }
        NEXT();
        if (RUN) { pg8::Gemm g{YS, WbT, LDYS, 512}; pg8::BranchOrder S; S.init(T, 3072, G, (int)blockIdx.x); pg8::EpiMul E{BIG, LDMG};
            GEMM_SITE(4) pg8::gemm_phase<pg8::EpiMul, pg8::BranchOrder, true, true>(lds, g, S, E); }
        NEXT();
        if (RUN) { pg8::Gemm g{BIG, WoT, LDMG, 3072}; pg8::StaticOrder S; S.init(T, 1024, G, (int)blockIdx.x); pg8::EpiRes E{XS, MOD + (size_t)l * 17 * 6144 + 2 * 1024, nullptr, ALPHA};
            GEMM_SITE(5) pg8::gemm_phase<pg8::EpiRes, pg8::StaticOrder, true, true>(lds, g, S, E); }
        NEXT();
        const bool moe = (l & 1) != 0; const int ne = moe ? NEXP : 1;
        if (RUN) { ROW_CALL(rowpass<1>(a, l, lds)); if (moe) { __syncthreads(); ROW_CALL(conv_moe(a, l >> 1, lds)); } }
        NEXT();
        for (int e = 0; e < ne; ++e) {
            unsigned char* fw = moe ? a.ws + WS_YS + (size_t)e * FFNW_BYTES : a.ws + WS_WFFN + (size_t)(l >> 1) * FFNW_BYTES;
            if (RUN) { pg8::Gemm g{H, (const bf16_t*)fw, D, D}; pg8::StaticOrder S; S.init(T, 2 * FFN, G, (int)blockIdx.x); pg8::EpiSwiglu E{BIG, FFN};
                GEMM_SITE(6) pg8::gemm_phase<pg8::EpiSwiglu, pg8::StaticOrder, true, true>(lds, g, S, E); }
            NEXT();
            if (RUN) { pg8::Gemm g{BIG, (const bf16_t*)(fw + FFNW_WD), FFN, FFN}; pg8::StaticOrder S; S.init(T, 1024, G, (int)blockIdx.x);
                pg8::EpiRes E{XS, MOD + (size_t)l * 17 * 6144 + 5 * 1024, moe ? COMB + e : nullptr, e == 0 ? ALPHA : 1.0f};
                GEMM_SITE(7) pg8::gemm_phase<pg8::EpiRes, pg8::StaticOrder, true, true>(lds, g, S, E); }
            NEXT();
        }
        if (RUN) { ROW_CALL(rowpass<2>(a, l, lds)); }
        NEXT();
    }
#undef RUN
#undef NEXT
}
}

extern "C" void kernel_launch(void* const* d_in, const int* in_sizes, int n_in, void* d_out, int out_size, void* d_ws, size_t ws_size, hipStream_t stream) {
    using namespace mk;
    static int grid = 0;
    if (grid == 0) {
        if (n_in != 24 || in_sizes[0] != NB * SEQ * D || out_size != NB * SEQ * D || ws_size < WS_END) {
            fprintf(stderr, "kernel_launch: unexpected shapes or workspace (n_in %d, in0 %d, out %d, ws %zu, need %zu); nothing launched\n", n_in, n_in > 0 ? in_sizes[0] : -1, out_size, ws_size, (size_t)WS_END); grid = -1; return; }
        int dev = 0, cus = 0, per_cu = 0;
        if (hipGetDevice(&dev) != hipSuccess || hipDeviceGetAttribute(&cus, hipDeviceAttributeMultiprocessorCount, dev) != hipSuccess) { grid = -1; return; }
        if (hipFuncSetAttribute((const void*)mk_fwd, hipFuncAttributeMaxDynamicSharedMemorySize, LDS_BYTES) != hipSuccess) { fprintf(stderr, "kernel_launch: hipFuncSetAttribute failed\n"); grid = -1; return; }
        if (hipOccupancyMaxActiveBlocksPerMultiprocessor(&per_cu, (const void*)mk_fwd, NTHR, LDS_BYTES) != hipSuccess || per_cu < 1) { fprintf(stderr, "kernel_launch: occupancy query reports %d\n", per_cu); }
        (void)hipGetLastError();
        grid = cus;
    }
    if (grid < 0) return;
    if (hipMemsetAsync((char*)d_ws + WS_CTL, 0, CTL_ZERO_BYTES, stream) != hipSuccess) return;
    Args a{};
    for (int i = 0; i < 24; ++i) a.in[i] = (const float*)d_in[i];
    a.out = (float*)d_out; a.ws = (unsigned char*)d_ws;
#if MK_ONE_LAUNCH
    a.ph_lo = 0; a.ph_hi = PH_TOTAL;
    hipLaunchKernelGGL(mk_fwd, dim3(grid), dim3(NTHR), LDS_BYTES, stream, a);
#else
    for (int p = 0; p < PH_TOTAL; ++p) { a.ph_lo = p; a.ph_hi = p + 1; hipLaunchKernelGGL(mk_fwd, dim3(grid), dim3(NTHR), LDS_BYTES, stream, a); }
#endif
}
```

```cpp
#include <hip/hip_runtime.h>
#include <cstdio>
#include <cstdint>
namespace pg8 {
#define PG8_LAS __attribute__((address_space(3)))
typedef unsigned short bf16_t;
typedef short bf16x8 __attribute__((ext_vector_type(8)));
typedef float f32x4 __attribute__((ext_vector_type(4)));
typedef unsigned u32x4 __attribute__((ext_vector_type(4)));
constexpr int BM = 256, BK = 64, HALF = 128, HTB = HALF * BK * 2  , STAGE_BYTES = 8 * HTB, NXCD = 8, WGM = 4;

__host__ __device__ __forceinline__ int lds_byte(int r, int c) { const int st = (r >> 4) * 2 + (c >> 5), rr = r & 15, cc = c & 31, ob = rr * 64 + cc * 2; return st * 1024 + (ob ^ (((ob >> 9) & 1) << 5)); }
__host__ __device__ __forceinline__ void stage_rc(int b, int& R, int& C) { const int st = b / 1024, sb = b % 1024, swz = sb ^ (((sb >> 9) & 1) << 5); R = (st >> 1) * 16 + swz / 64; C = (st & 1) * 32 + (swz % 64) / 2; }
__host__ __device__ __forceinline__ int perm32(int rho) { const int n = rho >> 4, i = rho & 15; return 8 * (i >> 2) + 4 * n + (i & 3); }

struct Unit { int pm, pn; };
struct Gemm { const bf16_t* A; const bf16_t* Bt; int lda, K; const int* perm; };

struct StaticOrder {
    int nM, nN, nwg, G, c, lat;
    int L0, lim;
    int gap0, gaplen;
    __host__ __device__ void init(int M, int N, int G_, int c_) { nM = M / BM; nN = N / BM; nwg = nM * nN; G = G_; c = c_; lat = 0; L0 = 0; lim = nwg; gap0 = 0x7fffffff; gaplen = 0; }
    __host__ __device__ bool next(int i, Unit& u) const {
        const long Lp = (long)i * G + c + L0; if (Lp >= lim) return false;
        const long L = Lp + (Lp >= gap0 ? gaplen : 0);
        int wgid = (int)L; { const int q = nwg / NXCD, r = nwg % NXCD, xcd = wgid % NXCD, off = wgid / NXCD; wgid = (xcd < r ? xcd * (q + 1) : r * (q + 1) + (xcd - r) * q) + off; }
        const int nig = WGM * nN, gid = wgid / nig, fm = gid * WGM, gsz = (nM - fm) < WGM ? (nM - fm) : WGM;
        u.pm = fm + ((wgid % nig) % gsz); u.pn = (wgid % nig) / gsz; if (lat) u.pm += u.pm / 16 + 1; return true;
    }
    __host__ __device__ int pos_of(int pm, int pn) const {
        const int fm = (pm / WGM) * WGM, gsz = (nM - fm) < WGM ? (nM - fm) : WGM, wgid = (pm / WGM) * (WGM * nN) + pn * gsz + (pm - fm);
        const int q = nwg / NXCD, r = nwg % NXCD; int xcd, off;
        if (wgid < r * (q + 1)) { xcd = wgid / (q + 1); off = wgid % (q + 1); } else { const int w2 = wgid - r * (q + 1); xcd = r + w2 / q; off = w2 % q; }
        return off * NXCD + xcd; }
    __device__ __forceinline__ void a_ready(const Unit&) const {}
    __device__ __forceinline__ void done(const Unit&) const {}
    __device__ __forceinline__ size_t a_off(const Unit& u, int lda) const { return (size_t)u.pm * BM * lda * 2; }
    __device__ __forceinline__ size_t b_off(const Unit& u, int K) const { return (size_t)u.pn * BM * K * 2; }
};

typedef float f32x2c_t __attribute__((ext_vector_type(2)));
typedef __bf16 bf16x2c_t __attribute__((ext_vector_type(2)));
__device__ __forceinline__ unsigned cvt_pk_bf16(float lo, float hi) { const f32x2c_t v = {lo, hi}; return __builtin_bit_cast(unsigned, __builtin_convertvector(v, bf16x2c_t)); }
typedef float f32x2 __attribute__((ext_vector_type(2)));
__device__ __forceinline__ float bf2f(unsigned short b) { return __uint_as_float(((unsigned)b) << 16); }
__device__ __forceinline__ float sigm(float x) { return 1.0f / (1.0f + __expf(-x)); }
__device__ __forceinline__ void sigm2(float a, float b, float& sa, float& sb) { const float da = 1.0f + __expf(fminf(-a, 40.0f)), db = 1.0f + __expf(fminf(-b, 40.0f)); const float r = __builtin_amdgcn_rcpf(da * db); sa = r * db; sb = r * da; }
__device__ __forceinline__ int mi_of_pm(int pm) { const int b = pm / 17, j = pm - b * 17; return j == 0 ? 16 : b; }

template <int BANKS> __device__ __forceinline__ unsigned dpp_ror8_upd(unsigned old, unsigned v) { return (unsigned)__builtin_amdgcn_update_dpp((int)old, (int)v, 0x128, 0xf, BANKS, false); }
__device__ __forceinline__ void store_pair_lines(bf16_t* p, int ldc, int fr, u32x4 w0, u32x4 w1) {
    u32x4 s1, s2;
#pragma unroll
    for (int j = 0; j < 4; ++j) { s1[j] = dpp_ror8_upd<0xC>(w0[j], w1[j]); s2[j] = dpp_ror8_upd<0x3>(w1[j], w0[j]); }
    bf16_t* q = p + (fr < 8 ? 0 : 32);
    *(u32x4*)q = s1; *(u32x4*)(q + (size_t)8 * ldc) = s2;
}
struct EpiP {
    static constexpr bool PERM = true, AFTER_DRAIN = false, MID = false;
    bf16_t* O; int ldc; float* SC; int sc_pn; int act; int pn_shift;
    const float* oml; int fg_lo, fg_hi;
    __device__ __forceinline__ void operator()(const f32x4 (&acc)[2][2][4][2], const Unit& u, int wr, int wc, int fr, int fq) const {
        const int row0 = u.pm * BM + wr * 64 + fr;
        if (u.pn == sc_pn) {
            if (wc == 0) {
#pragma unroll
                for (int ai = 0; ai < 2; ++ai)
#pragma unroll
                    for (int m = 0; m < 4; ++m) { float* rp = SC + (size_t)(row0 + ai * HALF + m * 16) * 32 + 8 * fq;
#pragma unroll
                        for (int n = 0; n < 2; ++n) *(f32x4*)(rp + 4 * n) = acc[ai][0][m][n]; }
            }
            return;
        }
        const int col0 = (u.pn - pn_shift) * BM + wc * 64 + 8 * fq;
        const bool fg = u.pn >= fg_lo && u.pn < fg_hi;
        f32x4 om[2][2];
        if (fg) {
#pragma unroll
            for (int bj = 0; bj < 2; ++bj)
#pragma unroll
                for (int n = 0; n < 2; ++n) om[bj][n] = *(const f32x4*)(oml + ((col0 + 32 * bj + 4 * n) & 511)); }
#pragma unroll
        for (int ai = 0; ai < 2; ++ai)
#pragma unroll
            for (int m = 0; m < 4; ++m) { bf16_t* rowp = O + (size_t)(u.pm * BM + wr * 64 + ai * HALF + m * 16 + (fr & 7)) * ldc + col0;
                u32x4 w[2];
#pragma unroll
                for (int bj = 0; bj < 2; ++bj) { f32x4 v0 = acc[ai][bj][m][0], v1 = acc[ai][bj][m][1];
                    if (act) {
#pragma unroll
                        for (int j = 0; j < 4; ++j) { v0[j] = __builtin_amdgcn_rcpf(1.0f + __builtin_amdgcn_exp2f(-v0[j])); v1[j] = __builtin_amdgcn_rcpf(1.0f + __builtin_amdgcn_exp2f(-v1[j])); } }
                    if (fg) {
#pragma unroll
                        for (int j = 0; j < 4; ++j) { v0[j] = om[bj][0][j] * __builtin_amdgcn_rcpf(1.0f + __builtin_amdgcn_exp2f(v0[j])); v1[j] = om[bj][1][j] * __builtin_amdgcn_rcpf(1.0f + __builtin_amdgcn_exp2f(v1[j])); } }
                    w[bj].x = cvt_pk_bf16(v0[0], v0[1]); w[bj].y = cvt_pk_bf16(v0[2], v0[3]); w[bj].z = cvt_pk_bf16(v1[0], v1[1]); w[bj].w = cvt_pk_bf16(v1[2], v1[3]); }
                store_pair_lines(rowp, ldc, fr, w[0], w[1]); }
    }
};
struct EpiMixed {
    static constexpr bool PERM = true, AFTER_DRAIN = false, MID = true;
    const bf16_t* G; bf16_t* O;
    __device__ __forceinline__ void mid(f32x4 (&acc)[2][2][4][2], const Unit& u, int seg, int wr, int wc, int fr, int fq) const {
        int row0 = u.pm * BM + wr * 64 + fr, col0 = u.pn * BM + wc * 64 + 8 * fq; asm volatile("" : "+v"(row0), "+v"(col0));
        u32x4 ga[2][2], gb[2][2];
#define MIX_LOAD(g_, buf_) do { const bf16_t* gp_ = G + (size_t)(row0 + ((g_) >> 2) * HALF + ((g_) & 3) * 16) * 3072 + (seg - 1) * 1024 + col0; \
            ga[buf_][0] = *(const u32x4*)gp_; gb[buf_][0] = *(const u32x4*)(gp_ + 1024); ga[buf_][1] = *(const u32x4*)(gp_ + 32); gb[buf_][1] = *(const u32x4*)(gp_ + 1024 + 32); } while (0)
        MIX_LOAD(0, 0);
#pragma unroll
        for (int g = 0; g < 8; ++g) { const int ai = g >> 2, m = g & 3, cb = g & 1;
            if (g + 1 < 8) MIX_LOAD(g + 1, cb ^ 1);
#pragma unroll
            for (int bj = 0; bj < 2; ++bj) { const u32x4 xa = ga[cb][bj], xb = gb[cb][bj];
                f32x4 r0, r1;
#pragma unroll
                for (int j = 0; j < 2; ++j) {
                    r0[2 * j] = __uint_as_float(xa[j] << 16) * __builtin_amdgcn_rcpf(fmaxf(__uint_as_float(xb[j] << 16), 1e-30f)); r0[2 * j + 1] = __uint_as_float(xa[j] & 0xffff0000u) * __builtin_amdgcn_rcpf(fmaxf(__uint_as_float(xb[j] & 0xffff0000u), 1e-30f));
                    r1[2 * j] = __uint_as_float(xa[2 + j] << 16) * __builtin_amdgcn_rcpf(fmaxf(__uint_as_float(xb[2 + j] << 16), 1e-30f)); r1[2 * j + 1] = __uint_as_float(xa[2 + j] & 0xffff0000u) * __builtin_amdgcn_rcpf(fmaxf(__uint_as_float(xb[2 + j] & 0xffff0000u), 1e-30f)); }
                acc[ai][bj][m][0] *= r0; acc[ai][bj][m][1] *= r1; }
            asm volatile("" ::: "memory"); __builtin_amdgcn_sched_barrier(0); }
#undef MIX_LOAD
    }
    __device__ __forceinline__ void operator()(const f32x4 (&acc)[2][2][4][2], const Unit& u, int wr, int wc, int fr, int fq) const {
        const int row0 = u.pm * BM + wr * 64, col0 = u.pn * BM + wc * 64 + 8 * fq;
#pragma unroll
        for (int ai = 0; ai < 2; ++ai)
#pragma unroll
            for (int m = 0; m < 4; ++m) { const size_t rowb = (size_t)(row0 + ai * HALF + m * 16); const bf16_t* gp = G + (rowb + fr) * 3072 + 2048 + col0;
                u32x4 w[2];
#pragma unroll
                for (int bj = 0; bj < 2; ++bj) { const f32x4 v0 = acc[ai][bj][m][0], v1 = acc[ai][bj][m][1]; const u32x4 g = *(const u32x4*)(gp + bj * 32);
                    w[bj].x = cvt_pk_bf16(v0[0] * __uint_as_float(g.x << 16), v0[1] * __uint_as_float(g.x & 0xffff0000u));
                    w[bj].y = cvt_pk_bf16(v0[2] * __uint_as_float(g.y << 16), v0[3] * __uint_as_float(g.y & 0xffff0000u));
                    w[bj].z = cvt_pk_bf16(v1[0] * __uint_as_float(g.z << 16), v1[1] * __uint_as_float(g.z & 0xffff0000u));
                    w[bj].w = cvt_pk_bf16(v1[2] * __uint_as_float(g.w << 16), v1[3] * __uint_as_float(g.w & 0xffff0000u)); }
                store_pair_lines(O + (rowb + (fr & 7)) * 1024 + col0, 1024, fr, w[0], w[1]); }
    }
};
struct EpiSwiglu {
    static constexpr bool PERM = true, AFTER_DRAIN = false, MID = false;
    bf16_t* O; int ldc;
    __device__ __forceinline__ void operator()(const f32x4 (&acc)[2][2][4][2], const Unit& u, int wr, int wc, int fr, int fq) const {
        const int row0 = u.pm * BM + wr * 64 + fr, col0 = u.pn * HALF + wc * 32 + 8 * fq;
#pragma unroll
        for (int ai = 0; ai < 2; ++ai)
#pragma unroll
            for (int m = 0; m < 4; ++m) { bf16_t* rowp = O + (size_t)(row0 + ai * HALF + m * 16) * ldc + col0;
                f32x4 v0, v1;
#pragma unroll
                for (int j = 0; j < 4; ++j) { const float g0 = acc[ai][0][m][0][j], g1 = acc[ai][0][m][1][j];
                    v0[j] = g0 * __builtin_amdgcn_rcpf(1.0f + __builtin_amdgcn_exp2f(-g0)) * acc[ai][1][m][0][j]; v1[j] = g1 * __builtin_amdgcn_rcpf(1.0f + __builtin_amdgcn_exp2f(-g1)) * acc[ai][1][m][1][j]; }
                u32x4 w; w.x = cvt_pk_bf16(v0[0], v0[1]); w.y = cvt_pk_bf16(v0[2], v0[3]); w.z = cvt_pk_bf16(v1[0], v1[1]); w.w = cvt_pk_bf16(v1[2], v1[3]);
                *(u32x4*)rowp = w; }
    }
};
struct EpiRes {
    static constexpr bool PERM = false, AFTER_DRAIN = false, MID = false;
    float* X; const float* mod; const float* stat; const float* lng; const float* lnb;
    const float* inx; const float* inc; float alpha; int first;
    __device__ __forceinline__ void operator()(const f32x4 (&acc)[2][2][4][2], const Unit& u, int wr, int wc, int fr, int fq) const {
        const int row0 = u.pm * BM + wr * 64 + fr, col0 = u.pn * BM + wc * 32 + 4 * fq;
        const float* mp = mod + (size_t)mi_of_pm(u.pm) * 6144 + col0;
        const int ib = u.pm / 17, ij = u.pm - ib * 17;
        const unsigned long long a_x = (unsigned long long)X + (unsigned long long)(u.pm * BM) * 4096ull, a_c = (unsigned long long)inc + (unsigned long long)(ib * 256) * 4096ull, a_i = (unsigned long long)inx + (unsigned long long)(ib * 4096 + (ij - 1) * 256) * 4096ull;
        const unsigned long long a_sel = first ? (ij == 0 ? a_c : a_i) : a_x;
        const __attribute__((address_space(1))) float* rsrc = (const __attribute__((address_space(1))) float*)(a_sel + (unsigned long long)((wr * 64 + fr) * 1024 + col0) * 4ull);
        f32x4 gv[2][2], lg[2][2], lb[2][2];
#pragma unroll
        for (int bj = 0; bj < 2; ++bj)
#pragma unroll
            for (int n = 0; n < 2; ++n) { gv[bj][n] = *(const f32x4*)(mp + bj * HALF + n * 16); lg[bj][n] = *(const f32x4*)(lng + col0 + bj * HALF + n * 16); lb[bj][n] = *(const f32x4*)(lnb + col0 + bj * HALF + n * 16); }
#pragma unroll
        for (int bj = 0; bj < 2; ++bj)
#pragma unroll
            for (int n = 0; n < 2; ++n) lb[bj][n] *= alpha;
#pragma unroll
        for (int ai = 0; ai < 2; ++ai)
#pragma unroll
            for (int m = 0; m < 4; ++m) { const int row = row0 + ai * HALF + m * 16; float* rowp = X + (size_t)row * 1024 + col0;
                const f32x2 st = *(const f32x2*)(stat + (size_t)row * 2); const float ar = alpha * (st.y + 1.0f), br = -st.x * ar;
#pragma unroll
                for (int bj = 0; bj < 2; ++bj)
#pragma unroll
                    for (int n = 0; n < 2; ++n) { const f32x4 x = *(const __attribute__((address_space(1))) f32x4*)(rsrc + (size_t)(ai * HALF + m * 16) * 1024 + bj * HALF + n * 16);
                        *(f32x4*)(rowp + bj * HALF + n * 16) = lg[bj][n] * (x * ar + br) + lb[bj][n] + gv[bj][n] * acc[ai][bj][m][n]; } }
    }
};
struct EpiScatter {
    static constexpr bool PERM = false, AFTER_DRAIN = false, MID = false;
    float* X; const float* mod; const int* perm; const float* permw; const float* stat; const float* lng; const float* lnb; float alpha;
    __device__ __forceinline__ void operator()(const f32x4 (&acc)[2][2][4][2], const Unit& u, int wr, int wc, int fr, int fq) const {
        const int row0 = u.pm * BM + wr * 64 + fr, col0 = u.pn * BM + wc * 32 + 4 * fq;
        f32x4 lg[2][2], lb[2][2];
#pragma unroll
        for (int bj = 0; bj < 2; ++bj)
#pragma unroll
            for (int n = 0; n < 2; ++n) { lg[bj][n] = *(const f32x4*)(lng + col0 + bj * HALF + n * 16); lb[bj][n] = *(const f32x4*)(lnb + col0 + bj * HALF + n * 16); }
#pragma unroll
        for (int bj = 0; bj < 2; ++bj)
#pragma unroll
            for (int n = 0; n < 2; ++n) lb[bj][n] *= alpha;
#pragma unroll
        for (int ai = 0; ai < 2; ++ai)
#pragma unroll
            for (int m = 0; m < 4; ++m) { const int r = row0 + ai * HALF + m * 16; const int tok = perm[r];
                if (tok >= 0) { const float w = permw ? permw[r] : 1.0f; const int b = tok / 4352, p = tok - b * 4352; const int mi = p < 256 ? 16 : b;
                    const float* mp = mod + (size_t)mi * 6144 + col0; float* rowp = X + (size_t)tok * 1024 + col0;
                    const f32x2 st = *(const f32x2*)(stat + (size_t)tok * 2); const float ar = alpha * (st.y + 1.0f), br = -st.x * ar;
#pragma unroll
                    for (int bj = 0; bj < 2; ++bj)
#pragma unroll
                        for (int n = 0; n < 2; ++n) { const f32x4 gv = *(const f32x4*)(mp + bj * HALF + n * 16); const f32x4 x = *(const f32x4*)(rowp + bj * HALF + n * 16);
                            *(f32x4*)(rowp + bj * HALF + n * 16) = lg[bj][n] * (x * ar + br) + lb[bj][n] + (gv * w) * acc[ai][bj][m][n]; } } }
    }
};
struct MoeOrder : StaticOrder {
    int ts1, ts2, ts3, ts4, ts5, ts6, ts7; size_t estride;
    __device__ __forceinline__ void init2(int nM_, int nN_, int G_, int c_) { nM = nM_; nN = nN_; nwg = nM * nN; G = G_; c = c_; lat = 0; L0 = 0; lim = nwg; gap0 = 0x7fffffff; gaplen = 0; }
    __device__ __forceinline__ size_t b_off(const Unit& u, int K) const {
        const int e = (u.pm >= ts1) + (u.pm >= ts2) + (u.pm >= ts3) + (u.pm >= ts4) + (u.pm >= ts5) + (u.pm >= ts6) + (u.pm >= ts7);
        return (size_t)e * estride + (size_t)u.pn * BM * K * 2; }
};

template <class Epi, class Sched, bool ALIGN_EPI = false, bool SP2 = false, bool GATHER = false>
__device__ __forceinline__ void gemm_phase(PG8_LAS unsigned char* lds, const Gemm g, const Sched& S, const Epi& E) {
    int tid_ = threadIdx.x; asm volatile("" : "+v"(tid_));
    const int tid = tid_, wid = __builtin_amdgcn_readfirstlane(tid >> 6), lane = tid & 63, wr = wid >> 2, wc = wid & 3, fr = lane & 15, fq = lane >> 4;
    const int K = g.K, nt = K / BK;
    unsigned voffA[2], voffB[2];
#pragma unroll
    for (int i = 0; i < 2; ++i) { int R, C; stage_rc(tid * 16 + i * 8192, R, C); const int Rb = Epi::PERM ? ((R & ~31) + perm32(R & 31)) : R;
        voffA[i] = (unsigned)(R * g.lda + C) * 2u; voffB[i] = (unsigned)(Rb * K + C) * 2u; }
    const size_t kstep = (size_t)(BK * 2);
    const size_t hstepA = (size_t)HALF * g.lda * 2, hstepB = (size_t)HALF * K * 2;
    const unsigned ldsw = (unsigned)wid * 1024u;
    const int aoff = lds_byte(wr * 64 + fr, fq * 8), boff = lds_byte(wc * 32 + fr, fq * 8);
#define PG8_SA(b, h) (((b) * 2 + (h)) * HTB)
#define PG8_SB(b, h) ((4 + (b) * 2 + (h)) * HTB)
#define PG8_STAGE(bufoff, gbase, voff) do { _Pragma("unroll") for (int _i = 0; _i < 2; ++_i) \
        __builtin_amdgcn_global_load_lds((const unsigned*)((const char*)(gbase) + (voff)[_i]), (PG8_LAS unsigned*)(lds + (bufoff) + ldsw + _i * 8192), 16, 0, 0); } while (0)
#define PG8_STAGE_A(bufoff, kptr, h, nx) do { if constexpr (GATHER) { _Pragma("unroll") for (int _i = 0; _i < 2; ++_i) { const unsigned _vo = (nx) ? vN[h][_i] : vC[h][_i]; \
        __builtin_amdgcn_global_load_lds((const unsigned*)((const char*)(kptr) + _vo), (PG8_LAS unsigned*)(lds + (bufoff) + ldsw + _i * 8192), 16, 0, 0); } } \
    else { PG8_STAGE(bufoff, (kptr) + (h) * hstepA, voffA); } } while (0)
#define PG8_LOADR(RW, u) do { _Pragma("unroll") for (int _h = 0; _h < 2; ++_h) _Pragma("unroll") for (int _i = 0; _i < 2; ++_i) { int _R, _C; stage_rc(tid * 16 + _i * 8192, _R, _C); \
        RW[_h][_i] = g.perm[(u).pm * BM + _h * HALF + _R]; } } while (0)
#define PG8_CONV(V, RW) do { _Pragma("unroll") for (int _h = 0; _h < 2; ++_h) _Pragma("unroll") for (int _i = 0; _i < 2; ++_i) { int _R, _C; stage_rc(tid * 16 + _i * 8192, _R, _C); \
        int _ix = RW[_h][_i]; _ix = _ix < 0 ? 0 : _ix; V[_h][_i] = (unsigned)(_ix * g.lda + _C) * 2u; } } while (0)
#define PG8_LDA(dst, b, h) do { _Pragma("unroll") for (int m = 0; m < 4; ++m) _Pragma("unroll") for (int k = 0; k < 2; ++k) dst[m][k] = *(const PG8_LAS bf16x8*)(lds + PG8_SA(b, h) + aoff + m * 2048 + k * 1024); } while (0)
#define PG8_LDB(dst, b, h) do { _Pragma("unroll") for (int n = 0; n < 2; ++n) _Pragma("unroll") for (int k = 0; k < 2; ++k) dst[n][k] = *(const PG8_LAS bf16x8*)(lds + PG8_SB(b, h) + boff + n * 2048 + k * 1024); } while (0)
#define PG8_MMA(ai, bj, At, Bt) do { __builtin_amdgcn_s_setprio(1); _Pragma("unroll") for (int m = 0; m < 4; ++m) _Pragma("unroll") for (int n = 0; n < 2; ++n) _Pragma("unroll") for (int k = 0; k < 2; ++k) \
        acc[ai][bj][m][n] = __builtin_amdgcn_mfma_f32_16x16x32_bf16(Bt[n][k], At[m][k], acc[ai][bj][m][n], 0, 0, 0); __builtin_amdgcn_s_setprio(0); } while (0)
#define PG8_WAIT_V(n) asm volatile("s_waitcnt vmcnt(" #n ")" ::: "memory")
#define PG8_WAIT_L(n) asm volatile("s_waitcnt lgkmcnt(" #n ")" ::: "memory")
#define PG8_BAR __builtin_amdgcn_s_barrier()
#define PG8_SCHED __builtin_amdgcn_sched_barrier(0)
    Unit cur, nxt; int ui = 0;
    if (!S.next(0, cur)) return;
    f32x4 acc[2][2][4][2];
#pragma unroll
    for (int a = 0; a < 2; ++a)
#pragma unroll
        for (int b = 0; b < 2; ++b)
#pragma unroll
            for (int m = 0; m < 4; ++m)
#pragma unroll
                for (int n = 0; n < 2; ++n) acc[a][b][m][n] = (f32x4){0.f, 0.f, 0.f, 0.f};
    bf16x8 At[4][2], B0[2][2], B1[2][2];
    const char* cA = (const char*)g.A + (GATHER ? (size_t)0 : S.a_off(cur, g.lda)); const char* cB = (const char*)g.Bt + S.b_off(cur, K);
    unsigned vC[2][2], vN[2][2];
    int rN[2][2];
    if constexpr (GATHER) { int rC[2][2]; PG8_LOADR(rC, cur); Unit n1; if (S.next(1, n1)) PG8_LOADR(rN, n1); PG8_CONV(vC, rC); }
    S.a_ready(cur);
    if constexpr (SP2) {
        PG8_STAGE(PG8_SB(0, 0), cB, voffB); PG8_STAGE(PG8_SB(0, 1), cB + hstepB, voffB); PG8_STAGE_A(PG8_SA(0, 0), cA, 0, false); PG8_STAGE_A(PG8_SA(0, 1), cA, 1, false);
        if (wr == 1) PG8_BAR;
        PG8_WAIT_V(2); PG8_BAR;
        PG8_STAGE(PG8_SB(1, 0), cB + kstep, voffB); PG8_STAGE_A(PG8_SA(1, 0), cA + kstep, 0, false); PG8_STAGE(PG8_SB(1, 1), cB + hstepB + kstep, voffB);
        PG8_WAIT_V(6); PG8_BAR;
    } else {
        PG8_STAGE(PG8_SB(0, 0), cB, voffB); PG8_STAGE_A(PG8_SA(0, 0), cA, 0, false); PG8_STAGE(PG8_SB(0, 1), cB + hstepB, voffB); PG8_STAGE_A(PG8_SA(0, 1), cA, 1, false);
        if (wr == 1) PG8_BAR;
        PG8_WAIT_V(4); PG8_BAR;
        PG8_STAGE(PG8_SB(1, 0), cB + kstep, voffB); PG8_STAGE_A(PG8_SA(1, 0), cA + kstep, 0, false); PG8_STAGE(PG8_SB(1, 1), cB + hstepB + kstep, voffB);
        PG8_WAIT_V(6); PG8_BAR;
    }
    for (;;) {
        const bool has_next = S.next(ui + 1, nxt);
        const char* nA = has_next ? (const char*)g.A + (GATHER ? (size_t)0 : S.a_off(nxt, g.lda)) : cA; const char* nB = has_next ? (const char*)g.Bt + S.b_off(nxt, K) : cB;
        if constexpr (GATHER) { if (has_next) PG8_CONV(vN, rN); else { vN[0][0] = vC[0][0]; vN[0][1] = vC[0][1]; vN[1][0] = vC[1][0]; vN[1][1] = vC[1][1]; }
            Unit n2; if (S.next(ui + 2, n2)) PG8_LOADR(rN, n2); }
        for (int t = 0; t < nt; t += 2) {
            const bool last = (t == nt - 2);
            const char* a1 = cA + (size_t)(t + 1) * kstep;
            const char* a2 = last ? nA : cA + (size_t)(t + 2) * kstep; const char* b2 = last ? nB : cB + (size_t)(t + 2) * kstep;
            const char* a3 = a2 + kstep; const char* b3 = b2 + kstep;
            if (last && has_next) S.a_ready(nxt);
            if constexpr (SP2) {
            PG8_LDB(B0, 0, 0); PG8_LDB(B1, 0, 1); PG8_SCHED; PG8_LDA(At, 0, 0); PG8_STAGE_A(PG8_SA(1, 1), a1, 1, false);
            PG8_WAIT_V(8); PG8_WAIT_L(0); PG8_BAR; PG8_MMA(0, 0, At, B0); PG8_MMA(0, 1, At, B1); PG8_BAR; PG8_SCHED;
            PG8_LDA(At, 0, 1); PG8_STAGE(PG8_SB(0, 0), b2, voffB); PG8_STAGE(PG8_SB(0, 1), b2 + hstepB, voffB); PG8_STAGE_A(PG8_SA(0, 0), a2, 0, last);
            PG8_WAIT_V(8); PG8_WAIT_L(0); PG8_BAR; PG8_MMA(1, 0, At, B0); PG8_MMA(1, 1, At, B1); PG8_BAR; PG8_SCHED;
            PG8_LDB(B0, 1, 0); PG8_LDB(B1, 1, 1); PG8_SCHED; PG8_LDA(At, 1, 0); PG8_STAGE_A(PG8_SA(0, 1), a2, 1, last);
            PG8_WAIT_V(8); PG8_WAIT_L(0); PG8_BAR; PG8_MMA(0, 0, At, B0); PG8_MMA(0, 1, At, B1); PG8_BAR; PG8_SCHED;
            PG8_LDA(At, 1, 1); PG8_STAGE(PG8_SB(1, 0), b3, voffB); PG8_STAGE(PG8_SB(1, 1), b3 + hstepB, voffB); PG8_STAGE_A(PG8_SA(1, 0), a3, 0, last);
            PG8_WAIT_V(8); PG8_WAIT_L(0); PG8_BAR; PG8_MMA(1, 0, At, B0); PG8_MMA(1, 1, At, B1); PG8_BAR; PG8_SCHED;
            } else {
            PG8_LDB(B0, 0, 0); PG8_SCHED; PG8_LDA(At, 0, 0); PG8_STAGE_A(PG8_SA(1, 1), a1, 1, false);
            PG8_WAIT_L(8); PG8_BAR; PG8_WAIT_L(0); PG8_MMA(0, 0, At, B0); PG8_BAR; PG8_SCHED;
            PG8_LDB(B1, 0, 1); PG8_STAGE(PG8_SB(0, 0), b2, voffB);
            PG8_BAR; PG8_WAIT_L(0); PG8_MMA(0, 1, At, B1); PG8_BAR;
            PG8_LDA(At, 0, 1); PG8_STAGE_A(PG8_SA(0, 0), a2, 0, last);
            PG8_BAR; PG8_WAIT_L(0); PG8_MMA(1, 0, At, B0); PG8_BAR; PG8_SCHED;
            PG8_STAGE(PG8_SB(0, 1), b2 + hstepB, voffB);
            PG8_WAIT_V(6); PG8_BAR; PG8_MMA(1, 1, At, B1); PG8_BAR;
            PG8_LDB(B0, 1, 0); PG8_SCHED; PG8_LDA(At, 1, 0); PG8_STAGE_A(PG8_SA(0, 1), a2, 1, last);
            PG8_WAIT_L(8); PG8_BAR; PG8_WAIT_L(0); PG8_MMA(0, 0, At, B0); PG8_BAR; PG8_SCHED;
            PG8_LDB(B1, 1, 1); PG8_STAGE(PG8_SB(1, 0), b3, voffB);
            PG8_BAR; PG8_WAIT_L(0); PG8_MMA(0, 1, At, B1); PG8_BAR;
            PG8_LDA(At, 1, 1); PG8_STAGE_A(PG8_SA(1, 0), a3, 0, last);
            PG8_BAR; PG8_WAIT_L(0); PG8_MMA(1, 0, At, B0); PG8_BAR; PG8_SCHED;
            PG8_STAGE(PG8_SB(1, 1), b3 + hstepB, voffB);
            PG8_WAIT_V(6); PG8_BAR; PG8_MMA(1, 1, At, B1); PG8_BAR;
            }
            if constexpr (Epi::MID) { if (((t + 2) & 7) == 0 && t + 2 < nt) E.mid(acc, cur, (t + 2) >> 3, wr, wc, fr, fq); }
        }
        if constexpr (ALIGN_EPI) { if (wr == 0) PG8_BAR; }
        if constexpr (!Epi::AFTER_DRAIN) { E(acc, cur, wr, wc, fr, fq); S.done(cur); }
        if (!has_next) break;
#pragma unroll
        for (int a = 0; a < 2; ++a)
#pragma unroll
            for (int b = 0; b < 2; ++b)
#pragma unroll
                for (int m = 0; m < 4; ++m)
#pragma unroll
                    for (int n = 0; n < 2; ++n) acc[a][b][m][n] = (f32x4){0.f, 0.f, 0.f, 0.f};
        cur = nxt; cA = nA; cB = nB; ++ui;
        if constexpr (GATHER) { vC[0][0] = vN[0][0]; vC[0][1] = vN[0][1]; vC[1][0] = vN[1][0]; vC[1][1] = vN[1][1]; }
        if constexpr (ALIGN_EPI) { if (wr == 1) PG8_BAR; }
    }
    PG8_WAIT_V(0);
    if constexpr (!ALIGN_EPI) { if (wr == 0) PG8_BAR; }
    PG8_BAR;
    if constexpr (Epi::AFTER_DRAIN) { E.fused(acc, cur, wr, wc, fr, fq, lds, wid, lane); S.done(cur); }
#undef PG8_SA
#undef PG8_SB
#undef PG8_STAGE
#undef PG8_STAGE_A
#undef PG8_LOADR
#undef PG8_CONV
#undef PG8_LDA
#undef PG8_LDB
#undef PG8_MMA
#undef PG8_WAIT_V
#undef PG8_WAIT_L
#undef PG8_BAR
#undef PG8_SCHED
}
}
namespace mk {
#define GAS __attribute__((address_space(1)))
#define LAS __attribute__((address_space(3)))
typedef unsigned short bf16;
typedef unsigned v4u __attribute__((ext_vector_type(4)));
typedef GAS unsigned gu32;
typedef GAS unsigned long long gu64;
#define RLX_AGENT __ATOMIC_RELAXED, __HIP_MEMORY_SCOPE_AGENT
#define LDS_WAIT() asm volatile("s_waitcnt lgkmcnt(0)" ::: "memory")
#define VM_WAIT() asm volatile("s_waitcnt vmcnt(0)" ::: "memory")
__device__ __forceinline__ unsigned long long rt() { return __builtin_amdgcn_s_memrealtime(); }
__device__ __forceinline__ unsigned f2bf(float f) { unsigned u = __builtin_bit_cast(unsigned, f); return (u + 0x7fffu + ((u >> 16) & 1u)) >> 16; }
__device__ __forceinline__ unsigned pk2(float lo, float hi) { return f2bf(lo) | (f2bf(hi) << 16); }

#define XB_TMO      128
#define XB_XCNT(j)  (256  + 64 * (j))
#define XB_XSUB(j)  (1280 + 64 * (j))
#define XB_XGEN(j)  (2304 + 64 * (j))
#define XB_TOP      3328
#define XB_TOPGEN   3392
#define XCD_BAR_WORDS 3456
#define XB_SPIN_CAP (1u << 20)

__device__ __forceinline__ unsigned xb_ld(unsigned* p)              { return __hip_atomic_load(p, __ATOMIC_RELAXED, __HIP_MEMORY_SCOPE_AGENT); }
__device__ __forceinline__ unsigned xb_add(unsigned* p, unsigned v) { return __hip_atomic_fetch_add(p, v, __ATOMIC_RELAXED, __HIP_MEMORY_SCOPE_AGENT); }
__device__ __forceinline__ unsigned xb_xcc_id() { return (unsigned)__builtin_amdgcn_s_getreg((3 << 11) | 20) & 0xFu; }
#define XB_SPIN(cond, bar) do { unsigned _sp = 0; while (cond) { __builtin_amdgcn_s_sleep(1); \
    if ((++_sp & 255u) == 0u) { if (xb_ld(&(bar)[XB_TMO])) break; if (_sp > XB_SPIN_CAP) { atomicAdd(&(bar)[XB_TMO], 1u); break; } } } } while (0)

struct XcdBarrier {
    unsigned* bar; unsigned x;
    volatile LAS unsigned* st;
};

__device__ __forceinline__ XcdBarrier xcd_barrier_post(unsigned* bar, volatile LAS unsigned* st) {
    XcdBarrier b; b.bar = bar; b.x = xb_xcc_id(); b.st = st;
    if (threadIdx.x == 0) (void)xb_add(&bar[XB_XCNT(b.x)], 1u);
    return b;
}
__device__ __forceinline__ void xcd_barrier_complete(unsigned* bar, unsigned x, unsigned& nloc, unsigned& nx) {
    const unsigned G = gridDim.x * gridDim.y * gridDim.z;
    unsigned sum, cnt, mine, sp = 0u;
    for (;;) {
        sum = 0u; cnt = 0u; mine = 0u;
#pragma unroll
        for (unsigned j = 0; j < 16; ++j) { const unsigned c = xb_ld(&bar[XB_XCNT(j)]); sum += c; cnt += (c > 0u) ? 1u : 0u; mine = (j == x) ? c : mine; }
        if (sum == G) break;
        __builtin_amdgcn_s_sleep(1);
        if ((++sp & 255u) == 0u) { if (xb_ld(&bar[XB_TMO])) break; if (sp > XB_SPIN_CAP) { atomicAdd(&bar[XB_TMO], 1u); break; } }
    }
    nloc = mine > 0u ? mine : 1u; nx = cnt > 0u ? cnt : 1u;
}

__device__ __forceinline__ void xcd_barrier(const XcdBarrier& b) {
    asm volatile("s_waitcnt vmcnt(0)" ::: "memory");
    __syncthreads();
    if (threadIdx.x == 0) {
        unsigned* bar = b.bar;
        __builtin_amdgcn_s_waitcnt(0);
        unsigned nloc = b.st[0], nx = b.st[1];
        if (nloc == 0u) { xcd_barrier_complete(bar, b.x, nloc, nx); b.st[0] = nloc; b.st[1] = nx; }
        const unsigned old = xb_add(&bar[XB_XSUB(b.x)], 1u);
        const unsigned gen = old / nloc;
        if (old + 1u == (gen + 1u) * nloc) {
            __builtin_amdgcn_fence(__ATOMIC_RELEASE, "agent");
            asm volatile("s_waitcnt vmcnt(0)" ::: "memory");
            const unsigned og = xb_add(&bar[XB_TOP], 1u);
            const unsigned tg = og / nx;
            if (og + 1u == (tg + 1u) * nx) xb_add(&bar[XB_TOPGEN], 1u);
            else XB_SPIN(xb_ld(&bar[XB_TOPGEN]) == tg, bar);
            __builtin_amdgcn_fence(__ATOMIC_ACQUIRE, "agent");
            xb_add(&bar[XB_XGEN(b.x)], 1u);
            asm volatile("s_waitcnt vmcnt(0)" ::: "memory");
        } else {
            XB_SPIN(xb_ld(&bar[XB_XGEN(b.x)]) == gen, bar);
            __builtin_amdgcn_fence(__ATOMIC_ACQUIRE, "agent");
            asm volatile("s_waitcnt vmcnt(0)" ::: "memory");
        }
    }
    __syncthreads();
}

}
namespace mk {
using pg8::bf16_t; using pg8::f32x2; using pg8::f32x4; using pg8::u32x4; using pg8::bf2f; using pg8::sigm; using pg8::sigm2; using pg8::cvt_pk_bf16; using pg8::f32x2c_t;
typedef unsigned u32x2 __attribute__((ext_vector_type(2)));
constexpr int NB = 16, SEQ = 4096, CTX = 256, D = 1024, DEPTH = 4, LPB = SEQ + CTX, T = NB * LPB, NTILE = T / 256;
constexpr int NIN = 9760, FFN = 3584, NEXP = 8;
constexpr int LDP = 2560, LDMG = 3072, LDYS = 1536;
constexpr float ALPHA = 1.681792830507429f;
constexpr float LN_EPS = 1e-5f, RMS_EPS = 1e-6f, L2_EPS = 1e-6f;
constexpr float LOG2E = 1.4426950408889634f, LN2 = 0.6931471805599453f;
constexpr int NWAVES = 8, NTHR = 512;

constexpr size_t MiB = 1u << 20;
constexpr size_t WS_CTL = 0, CTL_ZERO_BYTES = 1 * MiB;
constexpr size_t WS_MOD = 1 * MiB;
constexpr int TP = T + 2048;
constexpr size_t WS_ZSTAT = 128 * 1024;
constexpr size_t WS_STAT = 3 * MiB;
constexpr size_t WS_OML = 3 * MiB + 800 * 1024;
constexpr size_t WS_LNID = 3 * MiB + 768 * 1024;
constexpr size_t WS_TOP = 4 * MiB;
constexpr size_t WS_PERM = 5 * MiB + 128 * 1024;
constexpr size_t WS_PERMW = 5 * MiB + 768 * 1024;
constexpr size_t WS_PERMID = 6 * MiB + 384 * 1024;
constexpr size_t WS_SC = 7 * MiB;
constexpr size_t WS_W = 16 * MiB;
constexpr size_t LW_BYTES = 29 * MiB, LW_WB = 20 * MiB, LW_WO = 23 * MiB;
constexpr size_t WS_WFFN = WS_W + 4 * LW_BYTES;
constexpr size_t FFNW_BYTES = 21 * MiB, FFNW_WD = 14 * MiB;
constexpr size_t WS_XS = WS_WFFN + 2 * FFNW_BYTES;
constexpr size_t WS_H = WS_XS + 272 * MiB;
constexpr size_t WS_YS = WS_H + 136 * MiB;
constexpr size_t WS_BIG = WS_YS + 204 * MiB;
constexpr size_t WS_O = WS_BIG + 340 * MiB;
constexpr size_t WS_END = WS_BIG + 490 * MiB;
static_assert(WS_MOD + (size_t)4 * 17 * 6144 * 4 <= WS_STAT && WS_STAT + (size_t)T * 8 <= WS_LNID && WS_ZSTAT + (size_t)T * 8 <= CTL_ZERO_BYTES && (size_t)(4096 + 3456) * 4 <= WS_ZSTAT, "small buffers");
static_assert((size_t)TP * 3584 * 2 <= 490 * MiB && WS_XS == 174 * MiB && (size_t)T * 2560 * 2 == 340 * MiB && (size_t)T * 3584 * 2 == 476 * MiB && (size_t)T * 1024 * 4 == 272 * MiB, "ws map");
constexpr int CW_MOE = 2048;
constexpr int CW_BAR = 4096;

constexpr int RING_BYTES = 131072, LDS_BYTES = 163840, LDSCTL_OFF = LDS_BYTES - 1024;


struct Args { const float* in[24]; float* out; unsigned char* ws; int ph_lo, ph_hi; };
typedef const __attribute__((address_space(4))) Args* KArgs;
__device__ __forceinline__ KArgs fresh_args(KArgs a) { asm volatile("" : "+s"(a)); return a; }
enum { I_X = 0, I_C, I_CTX, I_CCTX, I_WADA, I_BADA, I_WIN, I_CONVW, I_LBRAW, I_MGB, I_ALOG, I_DTB, I_MIXN, I_WBR, I_WOUT, I_LNG, I_LNB, I_FG, I_FU, I_FD, I_ROUTER, I_MG, I_MU, I_MD };

__device__ __forceinline__ int opaque_tid() { int t = threadIdx.x; asm volatile("" : "+v"(t)); return t; }
__device__ __forceinline__ float wave_sum(float v) {
    v += __builtin_bit_cast(float, __builtin_amdgcn_mov_dpp(__builtin_bit_cast(int, v), 0xB1, 0xf, 0xf, false)); v += __builtin_bit_cast(float, __builtin_amdgcn_mov_dpp(__builtin_bit_cast(int, v), 0x4E, 0xf, 0xf, false));
    v += __builtin_bit_cast(float, __builtin_amdgcn_mov_dpp(__builtin_bit_cast(int, v), 0x141, 0xf, 0xf, false)); v += __builtin_bit_cast(float, __builtin_amdgcn_mov_dpp(__builtin_bit_cast(int, v), 0x140, 0xf, 0xf, false));
    const int vi = __builtin_bit_cast(int, v);
    return (__builtin_bit_cast(float, __builtin_amdgcn_readlane(vi, 0)) + __builtin_bit_cast(float, __builtin_amdgcn_readlane(vi, 16))) + (__builtin_bit_cast(float, __builtin_amdgcn_readlane(vi, 32)) + __builtin_bit_cast(float, __builtin_amdgcn_readlane(vi, 48)));
}
__device__ __forceinline__ float silu_f(float x) { return x * sigm(x); }

typedef short v4i16c_t __attribute__((ext_vector_type(4)));
__device__ __forceinline__ void tr_item(const float* colp4, size_t ldw, bf16_t* dst, size_t ldd, LAS unsigned char* scr, int lane, float scale = 1.0f) {
    const int kr = lane >> 3, pc = lane & 7;
    pg8::f32x4 v[8];
#pragma unroll
    for (int j = 0; j < 8; ++j) v[j] = *(const pg8::f32x4*)(colp4 + (size_t)(kr + 8 * j) * ldw);
#pragma unroll
    for (int j = 0; j < 8; ++j) { const pg8::f32x4 x = v[j] * scale; u32x2 w; w.x = cvt_pk_bf16(x[0], x[1]); w.y = cvt_pk_bf16(x[2], x[3]); *(LAS u32x2*)(scr + (kr + 8 * j) * 64 + pc * 8) = w; }
    asm volatile("" ::: "memory");
    const int i = lane & 15, gq = lane >> 4, nh = gq & 1;
    const LAS unsigned char* rb = scr + (i >> 2) * 64 + nh * 32 + (i & 3) * 8;
#pragma unroll
    for (int j = 0; j < 4; ++j) { const int c = (gq >> 1) + 2 * j;
        const v4i16c_t lo = __builtin_amdgcn_ds_read_tr16_b64_v4i16((LAS v4i16c_t*)(rb + (8 * c) * 64)), hi = __builtin_amdgcn_ds_read_tr16_b64_v4i16((LAS v4i16c_t*)(rb + (8 * c + 4) * 64));
        v4u o; o.x = (unsigned)(unsigned short)lo[0] | ((unsigned)(unsigned short)lo[1] << 16); o.y = (unsigned)(unsigned short)lo[2] | ((unsigned)(unsigned short)lo[3] << 16);
        o.z = (unsigned)(unsigned short)hi[0] | ((unsigned)(unsigned short)hi[1] << 16); o.w = (unsigned)(unsigned short)hi[2] | ((unsigned)(unsigned short)hi[3] << 16);
        *(v4u*)(dst + (size_t)(16 * nh + i) * ldd + 8 * c) = o; }
    asm volatile("" ::: "memory");
}
__device__ __forceinline__ int win_col(int r) {
    if (r < 4608) return r;
    if (r < 4864) { const int rr = r - 4608; return rr < 16 ? 4608 + rr : (rr < 32 ? 6672 + (rr - 16) : -1); }
    if (r < 6912) return 4624 + (r - 4864);
    return 6688 + (r - 6912);
}
constexpr int IT_WIN = 16 * 312, IT_WB = 3 * 8 * 32, IT_WO = 16 * 32, IT_LAYER = IT_WIN + IT_WB + IT_WO;
constexpr int IT_GU = 16 * 224, IT_DN = 56 * 32, IT_FFN = IT_GU + IT_DN;
__device__ __forceinline__ void conv_ffn_item(const float* wg, const float* wu, const float* wd, bf16_t* gu_t, bf16_t* dn_t, int r, LAS unsigned char* scr, int lane) {
    const int ln = 4 * (lane & 7);
    if (r < IT_GU) { const int kb = r / 224, nb = r % 224, k0 = 64 * kb, r0 = 32 * nb, tile = r0 >> 8, within = r0 & 255;
        const float* src = (within < 128) ? wg + (size_t)k0 * FFN + tile * 128 + within + ln : wu + (size_t)k0 * FFN + tile * 128 + (within - 128) + ln;
        tr_item(src, FFN, gu_t + (size_t)r0 * D + k0, D, scr, lane, within < 128 ? LOG2E : LN2); return; }
    r -= IT_GU;
    { const int kb = r / 32, nb = r % 32, k0 = 64 * kb, n0 = 32 * nb;
        tr_item(wd + (size_t)k0 * D + n0 + ln, D, dn_t + (size_t)n0 * FFN + k0, FFN, scr, lane); }
}
__device__ __forceinline__ void conv_layer_item(KArgs a, int l, int r, LAS unsigned char* scr, int lane) {
    a = fresh_args(a);
    unsigned char* lw = a->ws + WS_W + (size_t)l * LW_BYTES; const int ln = 4 * (lane & 7);
    if (r < IT_WIN) { const int kb = r / 312, nb = r % 312, k0 = 64 * kb, col = win_col((nb >> 3) * 256 + 64 * (nb & 3) + 32 * ((nb >> 2) & 1) + ln);
        const float* src = a->in[I_WIN] + ((size_t)l * D + k0) * NIN + (col >= 0 ? col : 0);
        const int lc = (nb >> 3) * 256 + 64 * (nb & 3) + 32 * ((nb >> 2) & 1);
        tr_item(src, NIN, (bf16_t*)lw + (size_t)(32 * nb) * D + k0, D, scr, lane, col < 0 ? 0.0f : (((lc >= 512 && lc < 1536) || lc >= 6912) ? LOG2E : 1.0f)); return; }
    r -= IT_WIN;
    if (r < IT_WB) { const int n = r / 256, rem = r % 256, kb = rem / 32, nb = rem % 32, k0 = 64 * kb, n0 = 32 * nb;
        const int lc0 = (nb >> 3) * 256 + 64 * (nb & 3) + 32 * ((nb >> 2) & 1);
        tr_item(a->in[I_WBR] + ((size_t)(l * 3 + n) * 512 + k0) * D + lc0 + ln, D, (bf16_t*)(lw + LW_WB) + (size_t)n0 * 1536 + n * 512 + k0, 1536, scr, lane); return; }
    r -= IT_WB;
    { const int kb = r / 32, nb = r % 32, k0 = 64 * kb, n0 = 32 * nb;
        tr_item(a->in[I_WOUT] + ((size_t)l * D + k0) * D + n0 + ln, D, (bf16_t*)(lw + LW_WO) + (size_t)n0 * D + k0, D, scr, lane); }
}

__device__ __forceinline__ void pro_a(KArgs a, LAS unsigned char* lds) {
    a = fresh_args(a);
    const int tid = opaque_tid(), lane = tid & 63, wave = __builtin_amdgcn_readfirstlane(tid >> 6), G = gridDim.x;
    LAS float* s_lds = (LAS float*)lds;
    LAS float* red = s_lds + 17 * 1024;
    for (int i = tid; i < 17 * 1024; i += NTHR) { const int mi = i >> 10, k = i & 1023; const float c = mi < 16 ? a->in[I_C][mi * 1024 + k] : a->in[I_CCTX][k]; s_lds[i] = silu_f(c); }
    __syncthreads();
    float* MOD = (float*)(a->ws + WS_MOD);
    { int* pid = (int*)(a->ws + WS_PERMID); for (int i = blockIdx.x * NTHR + tid; i < T; i += G * NTHR) pid[i] = i; }
    if (blockIdx.x == 1) { float* om = (float*)(a->ws + WS_OML); const float* lr = a->in[I_LBRAW];
        for (int cc = tid; cc < 512; cc += NTHR) { const float r0 = lr[cc], r1 = lr[512 + cc], r2 = lr[1024 + cc], r3 = lr[1536 + cc]; const float mx = fmaxf(fmaxf(r0, r1), fmaxf(r2, r3));
            const float e0 = __expf(r0 - mx), e1 = __expf(r1 - mx), e2 = __expf(r2 - mx), e3 = __expf(r3 - mx), inv = 1.0f / (e0 + e1 + e2 + e3);
            om[cc] = 1.0f; om[512 + cc] = 1.0f - e1 * inv; om[1024 + cc] = 1.0f - (e1 + e2) * inv; om[1536 + cc] = 1.0f - (e1 + e2 + e3) * inv; } }
    if (blockIdx.x == 0) { float* id = (float*)(a->ws + WS_LNID); for (int i = tid; i < 2048; i += NTHR) id[i] = i < 1024 ? 1.0f : 0.0f; }
    for (int it = blockIdx.x; it < DEPTH * 96; it += G) {
        const int l = it / 96, jg = it % 96;
        const float* wp = a->in[I_WADA] + ((size_t)l * D + wave * 128) * 6144 + jg * 64 + lane;
        float acc[17];
#pragma unroll
        for (int mi = 0; mi < 17; ++mi) acc[mi] = 0.f;
        for (int k = 0; k < 128; k += 4) {
            const float w0 = wp[(size_t)(k + 0) * 6144], w1 = wp[(size_t)(k + 1) * 6144], w2 = wp[(size_t)(k + 2) * 6144], w3 = wp[(size_t)(k + 3) * 6144];
#pragma unroll
            for (int mi = 0; mi < 17; ++mi) { const f32x4 sv = *(const LAS f32x4*)(s_lds + mi * 1024 + wave * 128 + k); acc[mi] += sv[0] * w0 + sv[1] * w1 + sv[2] * w2 + sv[3] * w3; }
        }
#pragma unroll
        for (int mi = 0; mi < 17; ++mi) red[(wave * 17 + mi) * 64 + lane] = acc[mi];
        __syncthreads();
        for (int i = tid; i < 17 * 64; i += NTHR) { const int mi = i >> 6, ln = i & 63; float s = a->in[I_BADA][l * 6144 + jg * 64 + ln];
#pragma unroll
            for (int w = 0; w < 8; ++w) s += red[(w * 17 + mi) * 64 + ln];
            MOD[(size_t)(l * 17 + mi) * 6144 + jg * 64 + ln] = s; }
        __syncthreads();
    }
    __syncthreads();
    LAS unsigned char* scr = lds + wave * 16384;
    const int gw = blockIdx.x * NWAVES + wave, NGW = G * NWAVES;
    constexpr int NITEMS = DEPTH * IT_LAYER + 2 * IT_FFN;
    for (int it = gw; it < NITEMS; it += NGW) {
        if (it < DEPTH * IT_LAYER) { conv_layer_item(a, it / IT_LAYER, it % IT_LAYER, scr, lane); continue; }
        const int r = it - DEPTH * IT_LAYER, i = r / IT_FFN;
        unsigned char* fw = a->ws + WS_WFFN + (size_t)i * FFNW_BYTES;
        conv_ffn_item(a->in[I_FG] + (size_t)i * D * FFN, a->in[I_FU] + (size_t)i * D * FFN, a->in[I_FD] + (size_t)i * FFN * D, (bf16_t*)fw, (bf16_t*)(fw + FFNW_WD), r % IT_FFN, scr, lane);
    }
}
__device__ __forceinline__ void conv_moe(KArgs a, int i, LAS unsigned char* lds) {
    a = fresh_args(a);
    const int tid = opaque_tid(), lane = tid & 63, wave = __builtin_amdgcn_readfirstlane(tid >> 6), G = gridDim.x;
    LAS unsigned char* scr = lds + wave * 16384;
    const int gw = blockIdx.x * NWAVES + wave, NGW = G * NWAVES;
    for (int it = gw; it < NEXP * IT_FFN; it += NGW) {
        const int e = it / IT_FFN; const size_t eo = (size_t)(i * NEXP + e) * D * FFN;
        unsigned char* fw = a->ws + WS_YS + (size_t)e * FFNW_BYTES;
        conv_ffn_item(a->in[I_MG] + eo, a->in[I_MU] + eo, a->in[I_MD] + eo, (bf16_t*)fw, (bf16_t*)(fw + FFNW_WD), it % IT_FFN, scr, lane);
    }
}

template <int MODE> __device__ __forceinline__ void rowpass(KArgs a, int l, LAS unsigned char* lds, int part = 0, int wg0 = 0, int lim = 0) {
    a = fresh_args(a);
    const int tid = opaque_tid(), lane = tid & 63, wave = __builtin_amdgcn_readfirstlane(tid >> 6), G = gridDim.x;
    const float* MOD = (const float*)(a->ws + WS_MOD);
    float* XS = (float*)(a->ws + WS_XS); bf16_t* H = (bf16_t*)(a->ws + WS_H); float* TOP = (float*)(a->ws + WS_TOP);
    LAS float* wr = (LAS float*)lds;
    LAS unsigned* hist = (LAS unsigned*)(lds + 32768);
    const bool moe = (MODE == 1) && (l & 1);
    if (moe) { const float* r = a->in[I_ROUTER] + (size_t)(l >> 1) * D * NEXP;
        for (int i = tid; i < D * NEXP; i += NTHR) { const int k = i >> 3, e = i & 7; wr[e * 1024 + k] = r[i]; }
        if (tid < 16) hist[tid] = 0u;
        __syncthreads(); }
    const int gw = ((int)blockIdx.x - wg0) * NWAVES + wave, NGW = (G - wg0) * NWAVES;
    const int lh = (MODE == 2) ? l + 1 : l, si = (MODE == 1) ? 3 : 0;
    pg8::StaticOrder SO; SO.init(T, D, G, 0);
    f32x4 lng4[4], lnb4[4];
    if (MODE != 0) { const float* gp0 = a->in[I_LNG] + (size_t)(l * 2 + (MODE - 1)) * D; const float* bp0 = a->in[I_LNB] + (size_t)(l * 2 + (MODE - 1)) * D;
#pragma unroll
        for (int j = 0; j < 4; ++j) { lng4[j] = ((const f32x4*)gp0)[lane + 64 * j]; lnb4[j] = ((const f32x4*)bp0)[lane + 64 * j]; } }
    auto accepted = [&](int row_) -> bool {
        if (part) { const int pm = row_ >> 8; const bool late = SO.pos_of(pm, 0) >= lim || SO.pos_of(pm, 1) >= lim || SO.pos_of(pm, 2) >= lim || SO.pos_of(pm, 3) >= lim; if (late != (part == 2)) return false; }
        if (MODE != 0 && l == DEPTH - 1 && (row_ % LPB) < CTX) return false;
        return true; };
    auto row_src = [&](int row_) -> const float* { const int b_ = row_ / LPB, p_ = row_ - b_ * LPB;
        return (MODE == 0) ? (p_ < CTX ? a->in[I_CTX] + ((size_t)b_ * CTX + p_) * D : a->in[I_X] + ((size_t)b_ * SEQ + (p_ - CTX)) * D) : XS + (size_t)row_ * D; };
    int nrow = gw; while (nrow < T && !accepted(nrow)) nrow += NGW;
    f32x4 vn[4];
    if (nrow < T) { const float* s0 = row_src(nrow);
#pragma unroll
        for (int j = 0; j < 4; ++j) vn[j] = ((const f32x4*)s0)[lane + 64 * j]; }
    while (nrow < T) {
        const int row = nrow;
        const int b = row / LPB, p = row - b * LPB; const bool isctx = p < CTX; const int mi = isctx ? 16 : b;
        f32x4 v[4], sc4[4], sh4[4];
        { const float* shp = MOD + (size_t)(lh * 17 + mi) * 6144 + si * 1024; const float* scp = shp + 1024;
#pragma unroll
            for (int j = 0; j < 4; ++j) { sc4[j] = ((const f32x4*)scp)[lane + 64 * j]; sh4[j] = ((const f32x4*)shp)[lane + 64 * j]; } }
#pragma unroll
        for (int j = 0; j < 4; ++j) v[j] = vn[j];
        nrow += NGW; while (nrow < T && !accepted(nrow)) nrow += NGW;
        if (nrow < T) { const float* s1 = row_src(nrow);
#pragma unroll
            for (int j = 0; j < 4; ++j) vn[j] = ((const f32x4*)s1)[lane + 64 * j]; }
        if (MODE != 0) {
            float s = 0.f;
#pragma unroll
            for (int j = 0; j < 4; ++j) s += (v[j][0] + v[j][1]) + (v[j][2] + v[j][3]);
            const float mean = wave_sum(s) * (1.f / D); float s2 = 0.f;
#pragma unroll
            for (int j = 0; j < 4; ++j) { v[j] = v[j] - mean; s2 += (v[j][0] * v[j][0] + v[j][1] * v[j][1]) + (v[j][2] * v[j][2] + v[j][3] * v[j][3]); }
            const float rstd = 1.0f / sqrtf(wave_sum(s2) * (1.f / D) + LN_EPS);
            if (lane == 0 && !(MODE == 2 && l == DEPTH - 1)) *(f32x2*)((float*)(a->ws + WS_STAT) + (size_t)row * 2) = (f32x2){mean, rstd - 1.0f};
#pragma unroll
            for (int j = 0; j < 4; ++j) v[j] = v[j] * rstd * lng4[j] + lnb4[j];
        }
        if (MODE == 2 && l == DEPTH - 1) {
            if (!isctx) { f32x4* o = (f32x4*)(a->out + ((size_t)b * SEQ + (p - CTX)) * D);
#pragma unroll
                for (int j = 0; j < 4; ++j) o[lane + 64 * j] = v[j]; }
            continue;
        }
        float s = 0.f;
#pragma unroll
        for (int j = 0; j < 4; ++j) s += (v[j][0] + v[j][1]) + (v[j][2] + v[j][3]);
        const float mean = wave_sum(s) * (1.f / D); float s2 = 0.f;
#pragma unroll
        for (int j = 0; j < 4; ++j) { v[j] = v[j] - mean; s2 += (v[j][0] * v[j][0] + v[j][1] * v[j][1]) + (v[j][2] * v[j][2] + v[j][3] * v[j][3]); }
        const float rstd = 1.0f / sqrtf(wave_sum(s2) * (1.f / D) + LN_EPS);
#pragma unroll
        for (int j = 0; j < 4; ++j) { const f32x4 sc = sc4[j], sh = sh4[j];
            v[j] = v[j] * rstd * (sc + 1.0f) + sh;
            u32x2 w; w.x = cvt_pk_bf16(v[j][0], v[j][1]); w.y = cvt_pk_bf16(v[j][2], v[j][3]);
            ((u32x2*)(H + (size_t)row * D))[lane + 64 * j] = w; }
        if (moe) {
            float lg[8];
#pragma unroll
            for (int e = 0; e < 8; ++e) { float t = 0.f;
#pragma unroll
                for (int j = 0; j < 4; ++j) { const f32x4 w4 = *(const LAS f32x4*)(wr + e * 1024 + 4 * (lane + 64 * j)); t += v[j][0] * w4[0] + v[j][1] * w4[1] + v[j][2] * w4[2] + v[j][3] * w4[3]; }
                lg[e] = wave_sum(t); }
            int i1 = 0; float v1 = lg[0];
#pragma unroll
            for (int e = 1; e < 8; ++e) if (lg[e] > v1) { v1 = lg[e]; i1 = e; }
            int i2 = -1; float v2 = -3.0e38f;
#pragma unroll
            for (int e = 0; e < 8; ++e) if (e != i1 && lg[e] > v2) { v2 = lg[e]; i2 = e; }
            const float p1 = 1.0f / (1.0f + __expf(v2 - v1)), p2 = 1.0f - p1;
            if (lane == 0) { TOP[(size_t)row * 4 + 0] = p1; TOP[(size_t)row * 4 + 1] = p2; TOP[(size_t)row * 4 + 2] = __uint_as_float((unsigned)i1 | ((unsigned)i2 << 8));
                __hip_atomic_fetch_add(hist + i1, 1u, __ATOMIC_RELAXED, __HIP_MEMORY_SCOPE_WORKGROUP); __hip_atomic_fetch_add(hist + 8 + i2, 1u, __ATOMIC_RELAXED, __HIP_MEMORY_SCOPE_WORKGROUP); }
        }
    }
    if (moe) { __syncthreads(); if (tid < 16) { const unsigned hv = hist[tid]; if (hv) __hip_atomic_fetch_add((unsigned*)(a->ws + WS_CTL) + CW_MOE + 32 * (l >> 1) + tid, hv, __ATOMIC_RELAXED, __HIP_MEMORY_SCOPE_AGENT); } }
}

__device__ __forceinline__ void moe_tile_starts(KArgs a, int i, int s, int (&ts)[9]) {
    const unsigned* cnt = (const unsigned*)(a->ws + WS_CTL) + CW_MOE + 32 * i + 8 * s; int acc = 0;
#pragma unroll
    for (int e = 0; e < 8; ++e) { ts[e] = acc; acc += (int)((__hip_atomic_load(cnt + e, __ATOMIC_RELAXED, __HIP_MEMORY_SCOPE_AGENT) + 255u) >> 8); }
    ts[8] = acc;
}
__device__ __forceinline__ void moe_fill(KArgs a, int i, int skipctx) {
    a = fresh_args(a);
    const int tid = opaque_tid(), lane = tid & 63, wave = __builtin_amdgcn_readfirstlane(tid >> 6), G = gridDim.x;
    unsigned* ctl = (unsigned*)(a->ws + WS_CTL) + CW_MOE + 32 * i;
    const float* TOP = (const float*)(a->ws + WS_TOP); int* PERM = (int*)(a->ws + WS_PERM); float* PERMW = (float*)(a->ws + WS_PERMW);
    int ts0[9], ts1[9]; moe_tile_starts(a, i, 0, ts0); moe_tile_starts(a, i, 1, ts1);
    const int gw = blockIdx.x * NWAVES + wave, NGW = G * NWAVES;
    for (int base = gw * 64; base < T; base += NGW * 64) {
        const int row = base + lane; const unsigned bits = __float_as_uint(TOP[(size_t)row * 4 + 2]);
        const float p1 = TOP[(size_t)row * 4 + 0], p2 = TOP[(size_t)row * 4 + 1];
        const bool dead = skipctx && (row % LPB) < CTX;
        const int mine0 = dead ? -1 : (int)(bits & 255u), mine1 = dead ? -1 : (int)(bits >> 8) & 255;
        unsigned long long m[16]; unsigned cntj = 0u;
#pragma unroll
        for (int j = 0; j < 16; ++j) { m[j] = __ballot((j < 8 ? mine0 : mine1) == (j & 7)); if (lane == j) cntj = (unsigned)__popcll(m[j]); }
        unsigned b0j = 0u;
        if (lane < 16 && cntj) b0j = __hip_atomic_fetch_add(ctl + 16 + lane, cntj, __ATOMIC_RELAXED, __HIP_MEMORY_SCOPE_AGENT);
        const unsigned long long below = (1ull << lane) - 1ull;
        int pos0 = 0, pos1 = 0;
#pragma unroll
        for (int j = 0; j < 16; ++j) { const int bj = __builtin_amdgcn_readlane((int)b0j, j), pj = (j < 8 ? ts0[j & 7] : ts1[j & 7]) * 256 + bj + __popcll(m[j] & below);
            if (j < 8) { if (mine0 == j) pos0 = pj; } else { if (mine1 == (j & 7)) pos1 = pj; } }
        if (!dead) { PERM[pos0] = row; PERMW[pos0] = p1; PERM[(size_t)TP + pos1] = row; PERMW[(size_t)TP + pos1] = p2; }
    }
    if (blockIdx.x < 16) { const int s = blockIdx.x >> 3, e = blockIdx.x & 7;
        const int cnt = (int)__hip_atomic_load(ctl + 8 * s + e, __ATOMIC_RELAXED, __HIP_MEMORY_SCOPE_AGENT), pad = ((cnt + 255) & ~255); int t0 = 0;
#pragma unroll
        for (int j = 0; j < 8; ++j) if (j == e) t0 = (s ? ts1[j] : ts0[j]) * 256;
        for (int p = cnt + tid; p < pad; p += NTHR) { PERM[(size_t)s * TP + t0 + p] = -1; PERMW[(size_t)s * TP + t0 + p] = 0.f; } }
}

__device__ __forceinline__ int pos_of_step(int st, int dir, bool colmajor) {
    if (st < CTX) return dir ? (CTX - 1 - st) : st;
    int u = st - CTX; if (dir) u = SEQ - 1 - u;
    if (colmajor) u = (u & 63) * 64 + (u >> 6);
    return CTX + u;
}
template <int CTRL> __device__ __forceinline__ float dpp_f(float v) { return __builtin_bit_cast(float, __builtin_amdgcn_mov_dpp(__builtin_bit_cast(int, v), CTRL, 0xf, 0xf, false)); }
__device__ __forceinline__ float red8(float v) { v += dpp_f<0xB1>(v); v += dpp_f<0x4E>(v); v += dpp_f<0x141>(v); return v; }
__device__ __forceinline__ float red16(float v) { v = red8(v); v += dpp_f<0x140>(v); return v; }
template <int CTRL, int RMASK> __device__ __forceinline__ float dpp_upd(float idv, float v) { return __builtin_bit_cast(float, __builtin_amdgcn_update_dpp(__builtin_bit_cast(int, idv), __builtin_bit_cast(int, v), CTRL, RMASK, 0xf, false)); }
__device__ __forceinline__ float wave_scan_add(float v) {
    v += dpp_upd<0x111, 0xf>(0.f, v); v += dpp_upd<0x112, 0xf>(0.f, v); v += dpp_upd<0x114, 0xf>(0.f, v); v += dpp_upd<0x118, 0xf>(0.f, v); v += dpp_upd<0x142, 0xa>(0.f, v); v += dpp_upd<0x143, 0xc>(0.f, v); return v; }
__device__ __forceinline__ float wave_scan_max(float v) { const float ni = -__builtin_inff();
    v = fmaxf(v, dpp_upd<0x111, 0xf>(ni, v)); v = fmaxf(v, dpp_upd<0x112, 0xf>(ni, v)); v = fmaxf(v, dpp_upd<0x114, 0xf>(ni, v)); v = fmaxf(v, dpp_upd<0x118, 0xf>(ni, v)); v = fmaxf(v, dpp_upd<0x142, 0xa>(ni, v)); v = fmaxf(v, dpp_upd<0x143, 0xc>(ni, v)); return v; }
__device__ __forceinline__ float lane63(float v) { return __builtin_bit_cast(float, __builtin_amdgcn_readlane(__builtin_bit_cast(int, v), 63)); }
__device__ __forceinline__ f32x4 ld_bf16x4(const bf16_t* p) { const u32x2 w = *(const u32x2*)p; return (f32x4){__uint_as_float(w.x << 16), __uint_as_float(w.x & 0xffff0000u), __uint_as_float(w.y << 16), __uint_as_float(w.y & 0xffff0000u)}; }

__device__ __forceinline__ void lds_barrier() { asm volatile("s_waitcnt lgkmcnt(0)" ::: "memory"); __builtin_amdgcn_s_barrier(); asm volatile("" ::: "memory"); }
typedef short bf16x8_t __attribute__((ext_vector_type(8)));
#define MFMA16(a, b, c) __builtin_amdgcn_mfma_f32_16x16x32_bf16((a), (b), (c), 0, 0, 0)
__device__ __forceinline__ bf16x8_t ldfrag(const LAS unsigned char* base, int stride, int row, int col) { return *(const LAS bf16x8_t*)(base + row * stride + col * 2); }
__device__ __forceinline__ unsigned short f2bf16(float f) { return (unsigned short)(cvt_pk_bf16(f, 0.f) & 0xffffu); }
constexpr int RS = 272, TS = 144;
constexpr int NCHUNK = LPB / 64;

constexpr int RK = 336;
constexpr int SA_QTG = 0, SA_KT = SA_QTG + 128 * 336, SA_KD = SA_KT + 128 * 336, SA_VT = SA_KD + 128 * TS, SA_AB = SA_VT + 64 * RK, SA_SB = SA_AB + 64 * TS, SA_TOT = SA_SB + 64 * RS, SA_DL = SA_TOT + 2048, SA_END = SA_DL + 512;
static_assert(SA_END <= LDSCTL_OFF, "scan A images vs LDS");
typedef short v4i16_t __attribute__((ext_vector_type(4)));
__device__ __forceinline__ v4i16_t tr4(const LAS unsigned char* base, int pitch, int row0, int col0, int r) {
    return __builtin_amdgcn_ds_read_tr16_b64_v4i16((LAS v4i16_t*)(base + (row0 + (r >> 2)) * pitch + (col0 + 4 * (r & 3)) * 2)); }
__device__ __forceinline__ bf16x8_t trfrag(const LAS unsigned char* base, int pitch, int col0, int ch0, int r, int q) {
    const v4i16_t lo = tr4(base, pitch, ch0 + 8 * q, col0, r), hi = tr4(base, pitch, ch0 + 8 * q + 4, col0, r);
    return (bf16x8_t){lo[0], lo[1], lo[2], lo[3], hi[0], hi[1], hi[2], hi[3]}; }
__device__ __forceinline__ void scanA_mfma(KArgs a, int l, LAS unsigned char* lds) {
    a = fresh_args(a);
    const int tid = opaque_tid(), lane = tid & 63, w = __builtin_amdgcn_readfirstlane(tid >> 6), r = lane & 15, q = lane >> 4;
    const bf16_t* P = (const bf16_t*)(a->ws + WS_BIG); bf16_t* O = (bf16_t*)(a->ws + WS_O);
    const int c = tid & 127, sb = __builtin_amdgcn_readfirstlane(tid >> 7);
    const int vtok = tid >> 3, v8 = (tid & 7) * 8;
    LAS float* TOT = (LAS float*)(lds + SA_TOT); LAS float* DL = (LAS float*)(lds + SA_DL);
    const int kbase = (sb == 0) ? 0 : (sb == 1 ? 16 : (sb == 2 ? 48 : 96));
    for (int it = blockIdx.x; it < 256; it += gridDim.x) {
        const int vh = it & 1, dir = (it >> 1) & 1, h = (it >> 2) & 3, b = it >> 4;
        __syncthreads();
        for (int i = tid; i < (SA_TOT - SA_AB) / 4; i += NTHR) ((LAS unsigned*)(lds + SA_AB))[i] = 0u;
        f32x4 Sacc[4];
#pragma unroll
        for (int i = 0; i < 4; ++i) Sacc[i] = (f32x4){0.f, 0.f, 0.f, 0.f};
        u32x4 qst[2], fst[2], vraw;
#define SA_LOAD(n) do { _Pragma("unroll") for (int k = 0; k < 2; ++k) { const int pi = tid + 512 * k; const bf16_t* pr = P + (size_t)(b * LPB + pos_of_step((n) * 64 + (pi >> 4), dir, false)) * LDP + h * 128 + 8 * (pi & 15); \
                qst[k] = *(const u32x4*)pr; fst[k] = *(const u32x4*)(pr + (1 + dir) * 512); } \
            vraw = *(const u32x4*)(P + (size_t)(b * LPB + pos_of_step((n) * 64 + vtok, dir, false)) * LDP + 1536 + h * 128 + vh * 64 + v8); } while (0)
#define SA_STAGE() do { _Pragma("unroll") for (int k = 0; k < 2; ++k) { const int pi = tid + 512 * k; LAS unsigned char* sp_ = lds + SA_KT + (pi >> 4) * RK + (pi & 15) * 16; \
                *(LAS u32x4*)sp_ = qst[k]; *(LAS u32x4*)(sp_ + 64 * RK) = fst[k]; } } while (0)
        SA_LOAD(0);
        SA_STAGE();
        lds_barrier();
        for (int n = 0; n < NCHUNK; ++n) {
            float cp[16], sp[16], kk[16], qv[16], fv[16]; float run = 1.f;
            unsigned short qraw[16], fraw[16];
#pragma unroll
            for (int g4 = 0; g4 < 4; ++g4) { const v4i16_t qq = tr4(lds + SA_KT, RK, sb * 16 + 4 * g4, c & ~15, lane & 15), ff = tr4(lds + SA_KT + 64 * RK, RK, sb * 16 + 4 * g4, c & ~15, lane & 15);
#pragma unroll
                for (int j = 0; j < 4; ++j) { qraw[4 * g4 + j] = (unsigned short)qq[j]; fraw[4 * g4 + j] = (unsigned short)ff[j]; } }
#pragma unroll
            for (int tt = 0; tt < 16; tt += 2) { const float k0 = bf2f(fraw[tt]), k1 = bf2f(fraw[tt + 1]);
                const float f0 = fmaxf(1.0f - k0, 1e-30f), f1 = fmaxf(1.0f - k1, 1e-30f);
                run *= f0; cp[tt] = run; kk[tt] = k0; fv[tt] = f0; qv[tt] = bf2f(qraw[tt]); run *= f1; cp[tt + 1] = run; kk[tt + 1] = k1; fv[tt + 1] = f1; qv[tt + 1] = bf2f(qraw[tt + 1]); }
            { float suf = 1.f;
#pragma unroll
                for (int tt = 15; tt >= 0; --tt) { sp[tt] = suf; suf *= fv[tt]; } }
            TOT[sb * 128 + c] = run;
            *(LAS u32x4*)(lds + SA_VT + vtok * RK + v8 * 2) = vraw;
            lds_barrier();
            const float t0 = TOT[c], t1 = TOT[128 + c], t2 = TOT[256 + c], t3 = TOT[384 + c];
            const float egref = (sb >= 1 ? t0 : 1.f) * (sb >= 2 ? t1 : 1.f) * (sb >= 3 ? t2 : 1.f);
            const float ekd = (sb <= 0 ? t1 : 1.f) * (sb <= 1 ? t2 : 1.f) * (sb <= 2 ? t3 : 1.f);
            const float f1 = 1.0f, f2 = (sb == 0 ? t1 : (sb == 1 ? t2 : 1.f)), f3 = (sb == 0 ? t1 * t2 : 1.f);
            if (sb == 0) DL[c] = (t0 * t1) * (t2 * t3);
            if (n + 1 < NCHUNK) SA_LOAD(n + 1);
            { unsigned qtp[8], qgp[8], kop[8], bap[8], b2p[8], b3p[8], kdp[8]; const float rrun = fminf(__builtin_amdgcn_rcpf(run), 5.5e34f);
#pragma unroll
                for (int tp = 0; tp < 8; ++tp) { const int t0 = 2 * tp;
                    const f32x2c_t cpv = {cp[t0], cp[t0 + 1]}, kkv = {kk[t0], kk[t0 + 1]}, spv = {sp[t0], sp[t0 + 1]}, qvv = {qv[t0], qv[t0 + 1]};
                    const f32x2c_t icp = spv * rrun;
                    const f32x2c_t qt = qvv * cpv, qg = qt * egref, kown = kkv * icp, base = kkv * spv, kd = base * ekd;
                    qtp[tp] = cvt_pk_bf16(qt[0], qt[1]); qgp[tp] = cvt_pk_bf16(qg[0], qg[1]); kop[tp] = cvt_pk_bf16(kown[0], kown[1]); kdp[tp] = cvt_pk_bf16(kd[0], kd[1]);
                    if (sb <= 2) bap[tp] = cvt_pk_bf16(base[0], base[1]);
                    if (sb <= 1) { const f32x2c_t b2 = base * f2; b2p[tp] = cvt_pk_bf16(b2[0], b2[1]); }
                    if (sb == 0) { const f32x2c_t b3 = base * f3; b3p[tp] = cvt_pk_bf16(b3[0], b3[1]); }
                }
#define ST16(addr_, x_) do { LAS u32x4* p_ = (LAS u32x4*)(addr_); p_[0] = (u32x4){x_[0], x_[1], x_[2], x_[3]}; p_[1] = (u32x4){x_[4], x_[5], x_[6], x_[7]}; } while (0)
                LAS unsigned char* rq = lds + SA_QTG + c * 336; LAS unsigned char* rk = lds + SA_KT + c * 336;
                ST16(rq + sb * 32, qtp); ST16(rq + 128 + sb * 32, qgp); ST16(rk + (kbase + sb * 16) * 2, kop);
                if (sb == 0) { ST16(rk + 16 * 2, bap); ST16(rk + 48 * 2, b2p); ST16(rk + 96 * 2, b3p); }
                if (sb == 1) { ST16(rk + (48 + 16) * 2, bap); ST16(rk + (96 + 16) * 2, b2p); }
                if (sb == 2) { ST16(rk + (96 + 32) * 2, bap); }
                ST16(lds + SA_KD + c * TS + sb * 32, kdp);
#undef ST16
            }
            lds_barrier();
            for (int ti = w; ti < 10; ti += 8) {
                const int bi = ti < 1 ? 0 : (ti < 3 ? 1 : (ti < 6 ? 2 : 3)), bj = ti - (bi * (bi + 1)) / 2;
                const int kb = bi == 0 ? 0 : (bi == 1 ? 16 : (bi == 2 ? 48 : 96));
                f32x4 acc = (f32x4){0.f, 0.f, 0.f, 0.f};
#pragma unroll
                for (int ks = 0; ks < 4; ++ks) acc = MFMA16(trfrag(lds + SA_KT, 336, kb + bj * 16, ks * 32, r, q), trfrag(lds + SA_QTG, 336, bi * 16, ks * 32, r, q), acc);
#pragma unroll
                for (int jj = 0; jj < 4; ++jj) if (bi == bj && 4 * q + jj > r) acc[jj] = 0.f;
                u32x2 aw; aw.x = cvt_pk_bf16(acc[0], acc[1]); aw.y = cvt_pk_bf16(acc[2], acc[3]);
                *(LAS u32x2*)(lds + SA_AB + (bi * 16 + r) * TS + (bj * 16 + 4 * q) * 2) = aw;
            }
            const int tb = w >> 1, vb0 = 2 * (w & 1);
            f32x4 oacc[2] = {(f32x4){0.f, 0.f, 0.f, 0.f}, (f32x4){0.f, 0.f, 0.f, 0.f}};
#pragma unroll
            for (int ks = 0; ks < 4; ++ks) { const bf16x8_t af = trfrag(lds + SA_QTG, 336, 64 + tb * 16, ks * 32, r, q);
#pragma unroll
                for (int u = 0; u < 2; ++u) oacc[u] = MFMA16(ldfrag(lds + SA_SB, RS, (vb0 + u) * 16 + r, ks * 32 + q * 8), af, oacc[u]); }
            lds_barrier();
            for (int ks = 0; ks <= (tb >> 1); ++ks) { const bf16x8_t af = ldfrag(lds + SA_AB, TS, tb * 16 + r, ks * 32 + q * 8);
#pragma unroll
                for (int u = 0; u < 2; ++u) oacc[u] = MFMA16(trfrag(lds + SA_VT, RK, (vb0 + u) * 16, ks * 32, r, q), af, oacc[u]); }
            { const int row = b * LPB + pos_of_step(n * 64 + tb * 16 + r, dir, false);
                bf16_t* op = O + ((size_t)dir * T + row) * 512 + h * 128 + vh * 64 + vb0 * 16 + 4 * q;
#pragma unroll
                for (int u = 0; u < 2; ++u) { u32x2 ow; ow.x = cvt_pk_bf16(oacc[u][0], oacc[u][1]); ow.y = cvt_pk_bf16(oacc[u][2], oacc[u][3]); *(u32x2*)(op + 16 * u) = ow; } }
            { const int kh = w >> 2, vq = w & 3;
                const bf16x8_t vf0 = trfrag(lds + SA_VT, RK, vq * 16, 0, r, q), vf1 = trfrag(lds + SA_VT, RK, vq * 16, 32, r, q);
#pragma unroll
                for (int kt = 0; kt < 4; ++kt) { const f32x4 dl = *(const LAS f32x4*)(DL + kh * 64 + kt * 16 + 4 * q);
                    f32x4 s = Sacc[kt] * dl;
                    s = MFMA16(ldfrag(lds + SA_KD, TS, kh * 64 + kt * 16 + r, q * 8), vf0, s); s = MFMA16(ldfrag(lds + SA_KD, TS, kh * 64 + kt * 16 + r, 32 + q * 8), vf1, s);
                    Sacc[kt] = s;
                    u32x2 pk; pk.x = cvt_pk_bf16(s[0], s[1]); pk.y = cvt_pk_bf16(s[2], s[3]);
                    *(LAS u32x2*)(lds + SA_SB + (vq * 16 + r) * RS + (kh * 64 + kt * 16 + 4 * q) * 2) = pk; } }
            if (n + 1 < NCHUNK) SA_STAGE();
            lds_barrier();
        }
#undef SA_LOAD
#undef SA_STAGE
    }
}


constexpr int SB_Q = 0, SB_K = SB_Q + 64 * RS, SB_KW = SB_K + 64 * RS, SB_VT = SB_KW + 128 * TS, SB_AB = SB_VT + 64 * RK, SB_CB = SB_AB + 64 * TS, SB_DENP = SB_CB + 64 * RS,
              SB_NP = SB_DENP + 4096, SB_N = SB_NP + 2048, SB_QN = SB_N + 512, SB_AS = SB_QN + 256, SB_MS = SB_AS + 256, SB_IN = SB_MS + 256, SB_EN = SB_IN + 256, SB_WS = SB_EN + 256, SB_DC = SB_WS + 256, SB_END = SB_DC + 16;
static_assert(SB_END <= 131072, "scan B images vs LDS");
__device__ __forceinline__ void scanB_mfma(KArgs a, int l, LAS unsigned char* lds) {
    a = fresh_args(a);
    const int tid = opaque_tid(), lane = tid & 63, w = __builtin_amdgcn_readfirstlane(tid >> 6), r = lane & 15, q = lane >> 4;
    const bf16_t* P = (const bf16_t*)(a->ws + WS_BIG); bf16_t* O = (bf16_t*)(a->ws + WS_O); const float* SC = (const float*)(a->ws + WS_SC);
    const int c = tid & 127, sb = __builtin_amdgcn_readfirstlane(tid >> 7);
    const int stok = tid >> 3, sp = tid & 7;
    LAS float* DENP = (LAS float*)(lds + SB_DENP); LAS float* NP = (LAS float*)(lds + SB_NP); LAS float* NV = (LAS float*)(lds + SB_N); LAS float* QN = (LAS float*)(lds + SB_QN);
    LAS float* AS = (LAS float*)(lds + SB_AS); LAS float* MS = (LAS float*)(lds + SB_MS); LAS float* IN = (LAS float*)(lds + SB_IN); LAS float* EN = (LAS float*)(lds + SB_EN); LAS float* WS = (LAS float*)(lds + SB_WS); LAS float* DC = (LAS float*)(lds + SB_DC);
    constexpr float KSCALE = 0.08838834764831845f;
    for (int it = blockIdx.x; it < 256; it += gridDim.x) {
        const int vh = it & 1, dir = (it >> 1) & 1, h = (it >> 2) & 3, b = it >> 4;
        const float bi = a->in[I_MGB][l * 16 + dir * 4 + h], bfg = a->in[I_MGB][l * 16 + (2 + dir) * 4 + h];
        __syncthreads();
        for (int i = tid; i < (SB_N + 512 - SB_AB) / 4; i += NTHR) ((LAS unsigned*)(lds + SB_AB))[i] = 0u;
        f32x4 Cacc[4];
#pragma unroll
        for (int i = 0; i < 4; ++i) Cacc[i] = (f32x4){0.f, 0.f, 0.f, 0.f};
        float m_run = 0.f;
        u32x4 qraw[2], kraw[2], vraw;
#define SB_LOAD(n) do { const bf16_t* pr = P + (size_t)(b * LPB + pos_of_step((n) * 64 + stok, dir, true)) * LDP + h * 128; \
            qraw[0] = *(const u32x4*)(pr + sp * 16); qraw[1] = *(const u32x4*)(pr + sp * 16 + 8); kraw[0] = *(const u32x4*)(pr + 512 + sp * 16); kraw[1] = *(const u32x4*)(pr + 512 + sp * 16 + 8); \
            vraw = *(const u32x4*)(pr + 1024 + vh * 64 + sp * 8); \
            if (w == 0) { const size_t srow = (size_t)(b * LPB + pos_of_step((n) * 64 + lane, dir, true)); igpre = SC[srow * 32 + dir * 4 + h]; fgpre = SC[srow * 32 + (2 + dir) * 4 + h]; } } while (0)
        float igpre = 0.f, fgpre = 0.f;
        SB_LOAD(0);
        for (int n = 0; n < NCHUNK; ++n) {
            *(LAS u32x4*)(lds + SB_Q + stok * RS + sp * 32) = qraw[0]; *(LAS u32x4*)(lds + SB_Q + stok * RS + sp * 32 + 16) = qraw[1];
            *(LAS u32x4*)(lds + SB_K + stok * RS + sp * 32) = kraw[0]; *(LAS u32x4*)(lds + SB_K + stok * RS + sp * 32 + 16) = kraw[1];
            *(LAS u32x4*)(lds + SB_VT + stok * RK + sp * 16) = vraw;
            if (w == 0) {
                const float ig = igpre + bi, fg = fgpre + bfg;
                float bb = fminf(fg, 0.f) - log1pf(__expf(-fabsf(fg)));
                bb = wave_scan_add(bb);
                const float av = ig - bb; float pm = av;
                pm = wave_scan_max(pm);
                const float M = fmaxf(pm, m_run), M63 = lane63(M), bb63 = lane63(bb);
                AS[lane] = av; MS[lane] = M; IN[lane] = __expf(m_run - M); EN[lane] = __expf(-(bb + M)); WS[lane] = __expf(av - M63) * KSCALE;
                if (lane == 0) DC[0] = __expf(m_run - M63);
                m_run = bb63 + M63;
            }
            lds_barrier();
            if (n + 1 < NCHUNK) SB_LOAD(n + 1);
            { float np = 0.f; unsigned kwp[8];
#pragma unroll
                for (int g4 = 0; g4 < 4; ++g4) { const v4i16_t kq = tr4(lds + SB_K, RS, sb * 16 + 4 * g4, c & ~15, lane & 15); const f32x4 wv = *(const LAS f32x4*)(WS + sb * 16 + 4 * g4);
                    const float k0 = bf2f((unsigned short)kq[0]) * wv[0], k1 = bf2f((unsigned short)kq[1]) * wv[1], k2 = bf2f((unsigned short)kq[2]) * wv[2], k3 = bf2f((unsigned short)kq[3]) * wv[3];
                    np += (k0 + k1) + (k2 + k3); kwp[2 * g4] = cvt_pk_bf16(k0, k1); kwp[2 * g4 + 1] = cvt_pk_bf16(k2, k3); }
                LAS u32x4* pkw = (LAS u32x4*)(lds + SB_KW + c * TS + sb * 32);
                pkw[0] = (u32x4){kwp[0], kwp[1], kwp[2], kwp[3]}; pkw[1] = (u32x4){kwp[4], kwp[5], kwp[6], kwp[7]};
                NP[sb * 128 + c] = np; }
            { const u32x4 q0 = *(const LAS u32x4*)(lds + SB_Q + stok * RS + sp * 32), q1 = *(const LAS u32x4*)(lds + SB_Q + stok * RS + sp * 32 + 16); float s = 0.f;
#pragma unroll
                for (int j = 0; j < 4; ++j) { const f32x4 n0 = *(const LAS f32x4*)(NV + sp * 16 + 4 * j);
                    const unsigned u0 = j < 2 ? q0[2 * j] : q1[2 * j - 4], u1 = j < 2 ? q0[2 * j + 1] : q1[2 * j - 3];
                    s += __uint_as_float(u0 << 16) * n0[0] + __uint_as_float(u0 & 0xffff0000u) * n0[1] + __uint_as_float(u1 << 16) * n0[2] + __uint_as_float(u1 & 0xffff0000u) * n0[3]; }
                s = red8(s);
                if (sp == 0) QN[stok] = s; }
            for (int ti = w; ti < 10; ti += 8) {
                const int tbi = ti < 1 ? 0 : (ti < 3 ? 1 : (ti < 6 ? 2 : 3)), tbj = ti - (tbi * (tbi + 1)) / 2;
                f32x4 acc = (f32x4){0.f, 0.f, 0.f, 0.f};
#pragma unroll
                for (int ks = 0; ks < 4; ++ks) acc = MFMA16(ldfrag(lds + SB_K, RS, tbj * 16 + r, ks * 32 + q * 8), ldfrag(lds + SB_Q, RS, tbi * 16 + r, ks * 32 + q * 8), acc);
                const f32x4 as4 = *(const LAS f32x4*)(AS + tbj * 16 + 4 * q); const float mt = MS[tbi * 16 + r];
#pragma unroll
                for (int jj = 0; jj < 4; ++jj) { acc[jj] *= KSCALE * __expf(as4[jj] - mt); if (tbi == tbj && 4 * q + jj > r) acc[jj] = 0.f; }
                u32x2 aw; aw.x = cvt_pk_bf16(acc[0], acc[1]); aw.y = cvt_pk_bf16(acc[2], acc[3]);
                *(LAS u32x2*)(lds + SB_AB + (tbi * 16 + r) * TS + (tbj * 16 + 4 * q) * 2) = aw;
                DENP[(tbi * 16 + r) * 16 + tbj * 4 + q] = (acc[0] + acc[1]) + (acc[2] + acc[3]);
            }
            const int tb = w >> 1, vb0 = 2 * (w & 1);
            f32x4 oacc[2] = {(f32x4){0.f, 0.f, 0.f, 0.f}, (f32x4){0.f, 0.f, 0.f, 0.f}};
#pragma unroll
            for (int ks = 0; ks < 4; ++ks) { const bf16x8_t af = ldfrag(lds + SB_Q, RS, tb * 16 + r, ks * 32 + q * 8);
#pragma unroll
                for (int u = 0; u < 2; ++u) oacc[u] = MFMA16(ldfrag(lds + SB_CB, RS, (vb0 + u) * 16 + r, ks * 32 + q * 8), af, oacc[u]); }
            lds_barrier();
            { const int t1 = tb * 16 + r; const float inr = IN[t1]; oacc[0] *= inr; oacc[1] *= inr;
                for (int ks = 0; ks <= (tb >> 1); ++ks) { const bf16x8_t af = ldfrag(lds + SB_AB, TS, tb * 16 + r, ks * 32 + q * 8);
#pragma unroll
                    for (int u = 0; u < 2; ++u) oacc[u] = MFMA16(trfrag(lds + SB_VT, RK, (vb0 + u) * 16, ks * 32, r, q), af, oacc[u]); }
                const f32x4 dp0 = *(const LAS f32x4*)(DENP + t1 * 16), dp1 = *(const LAS f32x4*)(DENP + t1 * 16 + 4), dp2 = *(const LAS f32x4*)(DENP + t1 * 16 + 8), dp3 = *(const LAS f32x4*)(DENP + t1 * 16 + 12);
                const f32x4 dps = (dp0 + dp1) + (dp2 + dp3);
                const float den = (dps[0] + dps[1]) + (dps[2] + dps[3]) + inr * QN[t1]; const float dn = 1.0f / fmaxf(fabsf(den), EN[t1]);
                const int row = b * LPB + pos_of_step(n * 64 + t1, dir, true);
                bf16_t* op = O + ((size_t)dir * T + row) * 512 + h * 128 + vh * 64 + vb0 * 16 + 4 * q;
#pragma unroll
                for (int u = 0; u < 2; ++u) { u32x2 ow; ow.x = cvt_pk_bf16(oacc[u][0] * dn, oacc[u][1] * dn); ow.y = cvt_pk_bf16(oacc[u][2] * dn, oacc[u][3] * dn); *(u32x2*)(op + 16 * u) = ow; } }
            { const int kh = w >> 2, vq = w & 3; const float dc = DC[0];
                const bf16x8_t vf0 = trfrag(lds + SB_VT, RK, vq * 16, 0, r, q), vf1 = trfrag(lds + SB_VT, RK, vq * 16, 32, r, q);
#pragma unroll
                for (int kt = 0; kt < 4; ++kt) { f32x4 s = Cacc[kt] * dc;
                    s = MFMA16(ldfrag(lds + SB_KW, TS, kh * 64 + kt * 16 + r, q * 8), vf0, s); s = MFMA16(ldfrag(lds + SB_KW, TS, kh * 64 + kt * 16 + r, 32 + q * 8), vf1, s);
                    Cacc[kt] = s;
                    u32x2 pk; pk.x = cvt_pk_bf16(s[0], s[1]); pk.y = cvt_pk_bf16(s[2], s[3]);
                    *(LAS u32x2*)(lds + SB_CB + (vq * 16 + r) * RS + (kh * 64 + kt * 16 + 4 * q) * 2) = pk; }
                if (tid < 128) NV[tid] = dc * NV[tid] + ((NP[tid] + NP[128 + tid]) + (NP[256 + tid] + NP[384 + tid])); }
            lds_barrier();
        }
#undef SB_LOAD
    }
}


__device__ __forceinline__ void prepC_phase(KArgs a, int l, LAS unsigned char* lds) {
    a = fresh_args(a);
    const int tid = opaque_tid(), lane = tid & 63, wave = __builtin_amdgcn_readfirstlane(tid >> 6), G = gridDim.x;
    const bf16_t* P = (const bf16_t*)(a->ws + WS_BIG); bf16_t* QP = (bf16_t*)(a->ws + WS_YS);
    LAS float* CW = (LAS float*)lds;
    { const float* cw = a->in[I_CONVW] + (size_t)l * 3 * 1536; for (int i = tid; i < 3 * 1536; i += NTHR) CW[i] = cw[i]; }
    __syncthreads();
    const int gw = blockIdx.x * NWAVES + wave, NGW = G * NWAVES;
    u32x4 nx[3][3];
#define PC_LOAD(r_) do { const int b_ = (r_) / LPB, p_ = (r_) - b_ * LPB; const bool ic_ = p_ < CTX; const int lp_ = ic_ ? p_ : p_ - CTX, Ls_ = ic_ ? CTX : SEQ; \
        const bf16_t* pr_ = P + (size_t)(r_) * LDP + lane * 8; const u32x4 z4_ = (u32x4){0u, 0u, 0u, 0u}; \
        _Pragma("unroll") for (int part_ = 0; part_ < 3; ++part_) { nx[part_][1] = *(const u32x4*)(pr_ + part_ * 512); nx[part_][0] = lp_ > 0 ? *(const u32x4*)(pr_ + part_ * 512 - LDP) : z4_; nx[part_][2] = lp_ < Ls_ - 1 ? *(const u32x4*)(pr_ + part_ * 512 + LDP) : z4_; } } while (0)
    if (gw < T) PC_LOAD(gw);
    for (int row = gw; row < T; row += NGW) {
        u32x4 cx[3][3];
#pragma unroll
        for (int i_ = 0; i_ < 3; ++i_)
#pragma unroll
            for (int j_ = 0; j_ < 3; ++j_) cx[i_][j_] = nx[i_][j_];
        if (row + NGW < T) PC_LOAD(row + NGW);
#pragma unroll
        for (int part = 0; part < 3; ++part) {
            const u32x4 x0 = cx[part][0], x1 = cx[part][1], x2 = cx[part][2];
            float y[8];
#pragma unroll
            for (int g4 = 0; g4 < 2; ++g4) { const f32x4 w0 = *(const LAS f32x4*)(CW + part * 512 + lane * 8 + 4 * g4), w1 = *(const LAS f32x4*)(CW + 1536 + part * 512 + lane * 8 + 4 * g4), w2 = *(const LAS f32x4*)(CW + 3072 + part * 512 + lane * 8 + 4 * g4);
#pragma unroll
                for (int h2 = 0; h2 < 2; ++h2) { const unsigned u0 = x0[2 * g4 + h2], u1 = x1[2 * g4 + h2], u2 = x2[2 * g4 + h2];
                    const float lo = __uint_as_float(u0 << 16) * w0[2 * h2] + __uint_as_float(u1 << 16) * w1[2 * h2] + __uint_as_float(u2 << 16) * w2[2 * h2];
                    const float hi = __uint_as_float(u0 & 0xffff0000u) * w0[2 * h2 + 1] + __uint_as_float(u1 & 0xffff0000u) * w1[2 * h2 + 1] + __uint_as_float(u2 & 0xffff0000u) * w2[2 * h2 + 1];
                    float s0, s1; sigm2(lo, hi, s0, s1); y[4 * g4 + 2 * h2] = lo * s0; y[4 * g4 + 2 * h2 + 1] = hi * s1; } }
            if (part < 2) { float ss = 0.f;
#pragma unroll
                for (int j = 0; j < 8; ++j) ss += y[j] * y[j];
                ss = red16(ss);
                const float rn = (part == 0 ? 0.08838834764831845f : 1.0f) / sqrtf(ss + L2_EPS);
#pragma unroll
                for (int j = 0; j < 8; ++j) y[j] *= rn; }
            u32x4 o; o.x = cvt_pk_bf16(y[0], y[1]); o.y = cvt_pk_bf16(y[2], y[3]); o.z = cvt_pk_bf16(y[4], y[5]); o.w = cvt_pk_bf16(y[6], y[7]);
            *(u32x4*)(QP + (size_t)row * 1536 + part * 512 + lane * 8) = o;
        }
    }
#undef PC_LOAD
}

constexpr int SC_Q = 0, SC_K = SC_Q + 64 * RS, SC_P0N = 0, SC_P0T = 64 * TS, SC_W = 0, SC_KT = SC_K + 64 * RS, SC_VT = SC_KT + 128 * TS, SC_QKM = SC_VT + 64 * TS,
              SC_A = SC_QKM + 64 * TS, SC_AT = SC_A + 64 * TS, SC_TB = SC_A, SC_TBG = SC_AT, SC_TX = SC_AT + 64 * TS, SC_TY = SC_TX + 64 * TS, SC_VN2 = SC_TX, SC_VNT = SC_TY, SC_SB = SC_TY + 64 * TS,
              SC_BG = SC_SB + 64 * RS, SC_KGS = SC_BG + 256, SC_EG = SC_KGS + 256, SC_GAM = SC_EG + 256, SC_BT = SC_GAM + 256, SC_GL = SC_BT + 256, SC_END = SC_GL + 16;
static_assert(SC_END <= LDSCTL_OFF && 2 * 64 * TS <= 64 * RS + 64 * RS && 64 * RS <= 2 * 64 * RS, "scan C images vs LDS");
__device__ __forceinline__ f32x4 ld_bf16x4_lds(const LAS unsigned char* p) { const u32x2 wv = *(const LAS u32x2*)p; return (f32x4){__uint_as_float(wv.x << 16), __uint_as_float(wv.x & 0xffff0000u), __uint_as_float(wv.y << 16), __uint_as_float(wv.y & 0xffff0000u)}; }
__device__ __forceinline__ f32x4 tile64(const LAS unsigned char* lds, int xi, int yi, int bx, int by, int lts, f32x4 acc) {
#pragma unroll
    for (int ks = 0; ks < 2; ++ks) acc = MFMA16(*(const LAS bf16x8_t*)(lds + xi + bx * 16 * TS + ks * 64 + lts), *(const LAS bf16x8_t*)(lds + yi + by * 16 * TS + ks * 64 + lts), acc);
    return acc;
}
__device__ __forceinline__ void st4(LAS unsigned char* lds, int img, int bx, int by, int ltt, f32x4 v) {
    u32x2 pk; pk.x = cvt_pk_bf16(v[0], v[1]); pk.y = cvt_pk_bf16(v[2], v[3]); *(LAS u32x2*)(lds + img + by * 16 * TS + bx * 32 + ltt) = pk;
}
constexpr int TC_ITEMS = NB * 4 * 2 * NCHUNK; constexpr size_t TQ_ITEM = 16384;
static_assert((size_t)TC_ITEMS * TQ_ITEM <= (size_t)2 * T * 512 * 2 && TC_ITEMS % 2 == 0, "TQ fits the O region");
constexpr int TQ_Q = 0, TQ_K = TQ_Q + 64 * RS, TQ_P0N = 0, TQ_P0T = 64 * TS, TQ_A = TQ_K + 64 * RS, TQ_AT = TQ_A + 64 * TS, TQ_TB = TQ_A, TQ_TX = TQ_AT + 64 * TS, TQ_TY = TQ_TX + 64 * TS, TQ_QKM = TQ_TY + 64 * TS,
              TQ_GAM = TQ_QKM + 64 * TS, TQ_BT = TQ_GAM + 256, TQ_SUB = TQ_BT + 256;
static_assert(2 * TQ_SUB <= LDSCTL_OFF && 2 * 64 * TS <= 2 * 64 * RS, "two transform pipelines vs LDS");
__device__ __forceinline__ void tcC_phase(KArgs a, int l, LAS unsigned char* lds0) {
    a = fresh_args(a);
    const int tid = opaque_tid(), w = __builtin_amdgcn_readfirstlane(tid >> 6), sub = w >> 2, w4 = w & 3;
    const bf16_t* QP = (const bf16_t*)(a->ws + WS_YS); unsigned char* TQ = a->ws + WS_O; const float* SC = (const float*)(a->ws + WS_SC);
    LAS unsigned char* lds = lds0 + sub * TQ_SUB;
    LAS float* GAM = (LAS float*)(lds + TQ_GAM); LAS float* BT = (LAS float*)(lds + TQ_BT);
    u32x4 rq[4], rk[4]; float gpre = 0.f, bpre = 0.f;
#define TC_LOAD(item) do { const int n_ = (item) % NCHUNK, rest_ = (item) / NCHUNK, dir_ = rest_ & 1, h_ = (rest_ >> 1) & 3, b_ = rest_ >> 3; \
        const bf16_t* pr = QP + (size_t)(b_ * LPB + pos_of_step(n_ * 64 + stok, dir_, false)) * 1536 + h_ * 128 + sp * 32; \
        _Pragma("unroll") for (int j_ = 0; j_ < 4; ++j_) { rq[j_] = *(const u32x4*)(pr + 8 * j_); rk[j_] = *(const u32x4*)(pr + 512 + 8 * j_); } \
        if (w4 == 0) { const size_t row = (size_t)(b_ * LPB + pos_of_step(n_ * 64 + (tid & 63), dir_, false)); gpre = SC[row * 32 + 16 + dir_ * 4 + h_]; bpre = SC[row * 32 + 16 + (2 + dir_) * 4 + h_]; } } while (0)
    { const int stok = (tid & 255) >> 2, sp = tid & 3; if (2 * (int)blockIdx.x + sub < TC_ITEMS) TC_LOAD(2 * (int)blockIdx.x + sub); }
    __syncthreads();
    for (int pr_ = blockIdx.x; 2 * pr_ < TC_ITEMS; pr_ += gridDim.x) {
        const int it = 2 * pr_ + sub;
        const int rest = it / NCHUNK, dir = rest & 1, h = (rest >> 1) & 3;
        const float nalog = -__expf(a->in[I_ALOG][l * 8 + dir * 4 + h]), dtb = a->in[I_DTB][l * 8 + dir * 4 + h];
        int oz = 0; asm volatile("" : "+v"(oz));
        const int t2 = tid + oz, lane = t2 & 63, r = lane & 15, q = lane >> 4, stok = (t2 & 255) >> 2, sp = t2 & 3;
        const int lrs = r * RS + q * 16 + oz, lts = r * TS + q * 16 + oz, ltt = r * TS + 8 * q + oz;
        { const int sto = stok * RS + sp * 64 + oz;
#pragma unroll
            for (int j = 0; j < 4; ++j) { *(LAS u32x4*)(lds + TQ_Q + 16 * j + sto) = rq[j]; *(LAS u32x4*)(lds + TQ_K + 16 * j + sto) = rk[j]; } }
        if (w4 == 0) {
            const float ap = gpre + dtb;
            float gm = nalog * (fmaxf(ap, 0.f) + log1pf(__expf(-fabsf(ap))));
            gm = wave_scan_add(gm);
            GAM[lane] = gm; BT[lane] = sigm(bpre);
        }
        lds_barrier();
        if (2 * (pr_ + (int)gridDim.x) < TC_ITEMS) TC_LOAD(2 * (pr_ + (int)gridDim.x) + sub);
        { const int by = w4; bf16x8_t fyk[4], fyq[4];
#pragma unroll
            for (int ks = 0; ks < 4; ++ks) { fyk[ks] = *(const LAS bf16x8_t*)(lds + TQ_K + by * 16 * RS + ks * 64 + lrs); fyq[ks] = *(const LAS bf16x8_t*)(lds + TQ_Q + by * 16 * RS + ks * 64 + lrs); }
            const int n_ = by * 16 + r; const float gn = GAM[n_], bn = BT[n_];
#pragma unroll
            for (int bx = 0; bx < 4; ++bx) { const int m0 = bx * 16 + 4 * q;
                f32x4 akk = (f32x4){0.f, 0.f, 0.f, 0.f}, aqk = (f32x4){0.f, 0.f, 0.f, 0.f};
#pragma unroll
                for (int ks = 0; ks < 4; ++ks) { const bf16x8_t fk = *(const LAS bf16x8_t*)(lds + TQ_K + bx * 16 * RS + ks * 64 + lrs); akk = MFMA16(fk, fyk[ks], akk); aqk = MFMA16(fk, fyq[ks], aqk); }
                const f32x4 gmv = *(const LAS f32x4*)(GAM + m0); f32x4 vq, va, v1;
#pragma unroll
                for (int jj = 0; jj < 4; ++jj) { const int m_ = m0 + jj; const float dec = __expf(-fabsf(gn - gmv[jj]));
                    vq[jj] = (m_ <= n_) ? aqk[jj] * dec : 0.f;
                    va[jj] = (m_ < n_) ? akk[jj] * dec * bn : 0.f;
                    v1[jj] = (m_ == n_ ? 1.0f : 0.f) - va[jj]; }
                st4(lds, TQ_QKM, bx, by, ltt, vq); st4(lds, TQ_A, bx, by, ltt, va); st4(lds, TQ_TX, bx, by, ltt, v1); }
        }
        lds_barrier();
#pragma unroll 1
        for (int rd = 1; rd <= 6; ++rd) {
            const int pn = (rd & 1) ? TQ_A : TQ_P0N, dn = (rd & 1) ? TQ_P0N : TQ_A, tsrc = (rd & 1) ? TQ_TY : TQ_TX, tdst = (rd & 1) ? TQ_TX : TQ_TY;
            { const int by = w4; bf16x8_t ypn[2], yts[2];
#pragma unroll
                for (int ks = 0; ks < 2; ++ks) { ypn[ks] = *(const LAS bf16x8_t*)(lds + pn + by * 16 * TS + ks * 64 + lts); yts[ks] = *(const LAS bf16x8_t*)(lds + tsrc + by * 16 * TS + ks * 64 + lts); }
                f32x4 rpn[4], rt[4];
#pragma unroll
                for (int bx = 0; bx < 4; ++bx) { rpn[bx] = (f32x4){0.f, 0.f, 0.f, 0.f}; rt[bx] = ld_bf16x4_lds(lds + tsrc + by * 16 * TS + bx * 32 + ltt);
#pragma unroll
                    for (int ks = 0; ks < 2; ++ks) { const bf16x8_t xpc = trfrag(lds + pn, TS, 16 * bx, 32 * ks, r, q);
                        rpn[bx] = MFMA16(xpc, ypn[ks], rpn[bx]);
                        rt[bx] = MFMA16(xpc, yts[ks], rt[bx]); } }
#pragma unroll
                for (int bx = 0; bx < 4; ++bx) {
                    if (rd < 6) st4(lds, dn, bx, by, ltt, rpn[bx]);
                    if (rd > 1) { if (rd < 6) st4(lds, tdst, bx, by, ltt, rt[bx]);
                        else { const f32x4 bs = *(const LAS f32x4*)(BT + bx * 16 + 4 * q); st4(lds, TQ_TB, bx, by, ltt, rt[bx] * bs); } } }
            }
            lds_barrier();
        }
        { unsigned char* dst = TQ + (size_t)it * TQ_ITEM + stok * 128 + sp * 32;
#pragma unroll
            for (int j = 0; j < 2; ++j) { *(u32x4*)(dst + 16 * j) = *(const LAS u32x4*)(lds + TQ_TB + stok * TS + sp * 32 + 16 * j + oz); *(u32x4*)(dst + 8192 + 16 * j) = *(const LAS u32x4*)(lds + TQ_QKM + stok * TS + sp * 32 + 16 * j + oz); } }
        lds_barrier();
    }
#undef TC_LOAD
}

constexpr int S3_Q = 0, S3_W = 0, S3_K = S3_Q + 64 * RS, S3_KT = S3_K + 64 * RS, S3_KTG = S3_KT + 128 * TS, S3_VT = S3_KTG + 128 * TS, S3_QKM = S3_VT + 64 * RK, S3_TB = S3_QKM + 64 * TS,
              S3_VNT = S3_TB + 64 * TS, S3_VN2 = S3_VNT + 64 * TS, S3_SB = S3_VN2 + 64 * TS, S3_EG = S3_SB + 64 * RS, S3_KGS = S3_EG + 256, S3_GL = S3_KGS + 256, S3_END = S3_GL + 16;
static_assert(S3_END <= LDSCTL_OFF, "scan C images vs LDS");
__device__ __forceinline__ void scanC_mfma(KArgs a, int l, LAS unsigned char* lds) {
    a = fresh_args(a);
    const int tid = opaque_tid(), w = __builtin_amdgcn_readfirstlane(tid >> 6);
    const bf16_t* QP = (const bf16_t*)(a->ws + WS_YS); const unsigned char* TQ = a->ws + WS_O; bf16_t* OP = (bf16_t*)(a->ws + WS_BIG); const float* SC = (const float*)(a->ws + WS_SC);
    LAS float* KGS = (LAS float*)(lds + S3_KGS); LAS float* EG = (LAS float*)(lds + S3_EG); LAS float* GL = (LAS float*)(lds + S3_GL);
    for (int it = blockIdx.x; it < 256; it += gridDim.x) {
        const int vh = it & 1, dir = (it >> 1) & 1, h = (it >> 2) & 3, b = it >> 4;
        const float nalog = -__expf(a->in[I_ALOG][l * 8 + dir * 4 + h]), dtb = a->in[I_DTB][l * 8 + dir * 4 + h];
        const unsigned char* tqb = TQ + (size_t)(((b * 4 + h) * 2 + dir) * NCHUNK) * TQ_ITEM;
        __syncthreads();
        for (int i = tid; i < 64 * RS / 4; i += NTHR) ((LAS unsigned*)(lds + S3_SB))[i] = 0u;
        __syncthreads();
        f32x4 Sacc[4];
#pragma unroll
        for (int i = 0; i < 4; ++i) Sacc[i] = (f32x4){0.f, 0.f, 0.f, 0.f};
        u32x4 rq[2], rk[2], rv, rtb, rqk; float gpre = 0.f;
#define SC_LOAD(n) do { const bf16_t* pr = QP + (size_t)(b * LPB + pos_of_step((n) * 64 + stok, dir, false)) * 1536 + h * 128; \
            rq[0] = *(const u32x4*)(pr + sp * 16); rq[1] = *(const u32x4*)(pr + sp * 16 + 8); rk[0] = *(const u32x4*)(pr + 512 + sp * 16); rk[1] = *(const u32x4*)(pr + 512 + sp * 16 + 8); rv = *(const u32x4*)(pr + 1024 + vh * 64 + sp * 8); \
            rtb = *(const u32x4*)(tqb + (size_t)(n) * TQ_ITEM + stok * 128 + sp * 16); rqk = *(const u32x4*)(tqb + (size_t)(n) * TQ_ITEM + 8192 + stok * 128 + sp * 16); \
            if (w == 0) { const size_t row = (size_t)(b * LPB + pos_of_step((n) * 64 + (tid & 63), dir, false)); gpre = SC[row * 32 + 16 + dir * 4 + h]; } } while (0)
        { const int stok = tid >> 3, sp = tid & 7; SC_LOAD(0); }
        for (int n = 0; n < NCHUNK; ++n) {
            int oz = 0; asm volatile("" : "+v"(oz));
            const int t2 = tid + oz, lane = t2 & 63, r = lane & 15, q = lane >> 4, c = t2 & 127, sb = w >> 1, stok = t2 >> 3, sp = t2 & 7;
            const int lrs = r * RS + q * 16 + oz, lts = r * TS + q * 16 + oz, ltt = r * TS + 8 * q + oz, lrt = r * RS + 8 * q + oz;
            { const int sto = stok * RS + sp * 32 + oz, tso = stok * TS + sp * 16 + oz;
                *(LAS u32x4*)(lds + S3_Q + sto) = rq[0]; *(LAS u32x4*)(lds + S3_Q + 16 + sto) = rq[1]; *(LAS u32x4*)(lds + S3_K + sto) = rk[0]; *(LAS u32x4*)(lds + S3_K + 16 + sto) = rk[1];
                *(LAS u32x4*)(lds + S3_TB + tso) = rtb; *(LAS u32x4*)(lds + S3_QKM + tso) = rqk;
                *(LAS u32x4*)(lds + S3_VT + stok * RK + sp * 16 + oz) = rv; }
            if (w == 0) {
                const float ap = gpre + dtb;
                float gm = nalog * (fmaxf(ap, 0.f) + log1pf(__expf(-fabsf(ap))));
                gm = wave_scan_add(gm);
                const float g63 = lane63(gm);
                EG[lane] = __expf(gm); KGS[lane] = __expf(g63 - gm);
                if (lane == 0) GL[0] = __expf(g63);
            }
            lds_barrier();
            if (n + 1 < NCHUNK) SC_LOAD(n + 1);
            { unsigned p0[8], p1[8];
#pragma unroll
                for (int g4 = 0; g4 < 4; ++g4) { const v4i16_t kq = tr4(lds + S3_K + oz, RS, sb * 16 + 4 * g4, c & ~15, r); const f32x4 eg4 = *(const LAS f32x4*)(EG + sb * 16 + 4 * g4);
                    const unsigned h0 = (unsigned short)kq[0], h1 = (unsigned short)kq[1], h2 = (unsigned short)kq[2], h3 = (unsigned short)kq[3];
                    p0[2 * g4] = h0 | (h1 << 16); p0[2 * g4 + 1] = h2 | (h3 << 16);
                    p1[2 * g4] = cvt_pk_bf16(__uint_as_float(h0 << 16) * eg4[0], __uint_as_float(h1 << 16) * eg4[1]); p1[2 * g4 + 1] = cvt_pk_bf16(__uint_as_float(h2 << 16) * eg4[2], __uint_as_float(h3 << 16) * eg4[3]); }
                LAS u32x4* d0 = (LAS u32x4*)(lds + S3_KT + c * TS + sb * 32 + oz); d0[0] = (u32x4){p0[0], p0[1], p0[2], p0[3]}; d0[1] = (u32x4){p0[4], p0[5], p0[6], p0[7]};
                LAS u32x4* d1 = (LAS u32x4*)(lds + S3_KTG + c * TS + sb * 32 + oz); d1[0] = (u32x4){p1[0], p1[1], p1[2], p1[3]}; d1[1] = (u32x4){p1[4], p1[5], p1[6], p1[7]}; }
            const int tb = w >> 1, vb0 = 2 * (w & 1);
            f32x4 oacc[2] = {(f32x4){0.f, 0.f, 0.f, 0.f}, (f32x4){0.f, 0.f, 0.f, 0.f}};
#pragma unroll
            for (int ks = 0; ks < 4; ++ks) { const bf16x8_t af = *(const LAS bf16x8_t*)(lds + S3_Q + tb * 16 * RS + ks * 64 + lrs);
#pragma unroll
                for (int u = 0; u < 2; ++u) oacc[u] = MFMA16(*(const LAS bf16x8_t*)(lds + S3_SB + (vb0 + u) * 16 * RS + ks * 64 + lrs), af, oacc[u]); }
            lds_barrier();
            f32x4 uacc[2];
#pragma unroll
            for (int u = 0; u < 2; ++u) uacc[u] = (f32x4){0.f, 0.f, 0.f, 0.f};
#pragma unroll
            for (int ks = 0; ks < 2; ++ks) { const bf16x8_t xf = *(const LAS bf16x8_t*)(lds + S3_TB + tb * 16 * TS + ks * 64 + lts);
#pragma unroll
                for (int u = 0; u < 2; ++u) uacc[u] = MFMA16(xf, trfrag(lds + S3_VT + oz, RK, (vb0 + u) * 16, ks * 32, r, q), uacc[u]); }
            { const int by = w & 3; bf16x8_t ytb[2], xkt[4][2];
#pragma unroll
                for (int ks = 0; ks < 2; ++ks) { ytb[ks] = *(const LAS bf16x8_t*)(lds + S3_TB + by * 16 * TS + ks * 64 + lts);
#pragma unroll
                    for (int jx = 0; jx < 4; ++jx) xkt[jx][ks] = *(const LAS bf16x8_t*)(lds + S3_KTG + ((w >> 2) + 2 * jx) * 16 * TS + ks * 64 + lts); }
#pragma unroll
                for (int jx = 0; jx < 4; ++jx) { const int kb = (w >> 2) + 2 * jx; f32x4 wv = (f32x4){0.f, 0.f, 0.f, 0.f};
#pragma unroll
                    for (int ks = 0; ks < 2; ++ks) wv = MFMA16(xkt[jx][ks], ytb[ks], wv);
                    u32x2 pk; pk.x = cvt_pk_bf16(wv[0], wv[1]); pk.y = cvt_pk_bf16(wv[2], wv[3]); *(LAS u32x2*)(lds + S3_W + by * 16 * RS + kb * 32 + lrt) = pk; } }
            lds_barrier();
            { const f32x4 kg = *(const LAS f32x4*)(KGS + tb * 16 + 4 * q);
                f32x4 ws[2] = {(f32x4){0.f, 0.f, 0.f, 0.f}, (f32x4){0.f, 0.f, 0.f, 0.f}};
#pragma unroll
                for (int ks = 0; ks < 4; ++ks) { const bf16x8_t xf = *(const LAS bf16x8_t*)(lds + S3_W + tb * 16 * RS + ks * 64 + lrs);
#pragma unroll
                    for (int u = 0; u < 2; ++u) ws[u] = MFMA16(xf, *(const LAS bf16x8_t*)(lds + S3_SB + (vb0 + u) * 16 * RS + ks * 64 + lrs), ws[u]); }
#pragma unroll
                for (int u = 0; u < 2; ++u) { const f32x4 vn = uacc[u] - ws[u]; st4(lds, S3_VNT, tb, vb0 + u, ltt, vn); st4(lds, S3_VN2, tb, vb0 + u, ltt, vn * kg); } }
            lds_barrier();
            { const float egt = EG[tb * 16 + r];
#pragma unroll
                for (int u = 0; u < 2; ++u) oacc[u] *= egt;
#pragma unroll
                for (int ks = 0; ks < 2; ++ks) { const bf16x8_t xf = *(const LAS bf16x8_t*)(lds + S3_QKM + tb * 16 * TS + ks * 64 + lts);
#pragma unroll
                    for (int u = 0; u < 2; ++u) oacc[u] = MFMA16(*(const LAS bf16x8_t*)(lds + S3_VNT + (vb0 + u) * 16 * TS + ks * 64 + lts), xf, oacc[u]); }
                const int row = b * LPB + pos_of_step(n * 64 + tb * 16 + r, dir, false);
                bf16_t* op = OP + (size_t)row * LDP + dir * 512 + h * 128 + vh * 64 + vb0 * 16 + 4 * q;
#pragma unroll
                for (int u = 0; u < 2; ++u) { u32x2 ow; ow.x = cvt_pk_bf16(oacc[u][0], oacc[u][1]); ow.y = cvt_pk_bf16(oacc[u][2], oacc[u][3]); *(u32x2*)(op + 16 * u) = ow; } }
            { const int kh = w >> 2, vq = w & 3; const float gl = GL[0];
                bf16x8_t yv[2];
#pragma unroll
                for (int ks = 0; ks < 2; ++ks) yv[ks] = *(const LAS bf16x8_t*)(lds + S3_VN2 + vq * 16 * TS + ks * 64 + lts);
#pragma unroll
                for (int kt = 0; kt < 4; ++kt) { f32x4 s = Sacc[kt] * gl;
#pragma unroll
                    for (int ks = 0; ks < 2; ++ks) s = MFMA16(*(const LAS bf16x8_t*)(lds + S3_KT + (kh * 4 + kt) * 16 * TS + ks * 64 + lts), yv[ks], s);
                    Sacc[kt] = s;
                    u32x2 pk; pk.x = cvt_pk_bf16(s[0], s[1]); pk.y = cvt_pk_bf16(s[2], s[3]);
                    *(LAS u32x2*)(lds + S3_SB + vq * 16 * RS + (kh * 64 + kt * 16) * 2 + lrt) = pk; } }
            lds_barrier();
        }
#undef SC_LOAD
    }
}

__device__ __forceinline__ void finalize_phase(KArgs a, int l, int mx, LAS unsigned char* lds) {
    a = fresh_args(a);
    const int tid = opaque_tid(), lane = tid & 63, wave = __builtin_amdgcn_readfirstlane(tid >> 6), G = gridDim.x;
    const bf16_t* P = (const bf16_t*)(a->ws + WS_BIG); const bf16_t* O = (const bf16_t*)(a->ws + WS_O); bf16_t* YS = (bf16_t*)(a->ws + WS_YS);
    const int gate_off = (mx == 0) ? 2048 : 1536, c8 = lane * 8;
    const float* gn = a->in[I_MIXN] + (size_t)(l * 3 + mx) * 512 + c8;
    const f32x4 g0 = *(const f32x4*)gn, g1 = *(const f32x4*)(gn + 4);
    const int gw = blockIdx.x * NWAVES + wave, NGW = G * NWAVES;
    for (int row = gw; row < T; row += NGW) {
        const u32x4 of = (mx == 2) ? *(const u32x4*)(P + (size_t)row * LDP + c8) : *(const u32x4*)(O + (size_t)row * 512 + c8);
        const u32x4 ob = (mx == 2) ? *(const u32x4*)(P + (size_t)row * LDP + 512 + c8) : *(const u32x4*)(O + ((size_t)T + row) * 512 + c8), gt = *(const u32x4*)(P + (size_t)row * LDP + gate_off + c8);
        float o[8], g[8];
#pragma unroll
        for (int j = 0; j < 4; ++j) { o[2 * j] = __uint_as_float(of[j] << 16) + __uint_as_float(ob[j] << 16); o[2 * j + 1] = __uint_as_float(of[j] & 0xffff0000u) + __uint_as_float(ob[j] & 0xffff0000u);
            g[2 * j] = __uint_as_float(gt[j] << 16); g[2 * j + 1] = __uint_as_float(gt[j] & 0xffff0000u); }
        float ss = 0.f;
#pragma unroll
        for (int j = 0; j < 8; ++j) ss += o[j] * o[j];
        ss = red16(ss);
        const float r = 1.0f / sqrtf(ss * (1.0f / 128.0f) + RMS_EPS);
        float y[8];
#pragma unroll
        for (int j = 0; j < 8; j += 2) { float s0, s1; sigm2(g[j], g[j + 1], s0, s1); const float a0 = (mx == 1) ? s0 : g[j] * s0, a1 = (mx == 1) ? s1 : g[j + 1] * s1;
            y[j] = o[j] * r * (j < 4 ? g0[j & 3] : g1[j & 3]) * a0; y[j + 1] = o[j + 1] * r * (j + 1 < 4 ? g0[(j + 1) & 3] : g1[(j + 1) & 3]) * a1; }
        u32x4 w; w.x = cvt_pk_bf16(y[0], y[1]); w.y = cvt_pk_bf16(y[2], y[3]); w.z = cvt_pk_bf16(y[4], y[5]); w.w = cvt_pk_bf16(y[6], y[7]);
        *(u32x4*)(YS + (size_t)row * LDYS + mx * 512 + c8) = w;
    }
}

#ifdef NO_SCANS
#define SCAN_CALL(x)
#else
#define SCAN_CALL(x) x
#endif
#ifdef NO_ROWS
#define ROW_CALL(x)
#else
#define ROW_CALL(x) x
#endif
#ifndef SITES
#define SITES 0xff
#endif
#define GEMM_SITE(i) if ((SITES >> (i)) & 1)
#ifndef MK_ONE_LAUNCH
#define MK_ONE_LAUNCH 1
#endif
constexpr int PH_TOTAL = 2 + 2 * (16 + 3 + 1) + 2 * (16 + 1 + 4 + 1);

__global__ void __launch_bounds__(NTHR, 2) mk_fwd(Args a_by_value) {
    (void)a_by_value; KArgs a = (KArgs)__builtin_amdgcn_kernarg_segment_ptr();
    extern __shared__ __attribute__((aligned(16))) unsigned char lds_raw[];
    LAS unsigned char* lds = (LAS unsigned char*)lds_raw;
    const int tid = opaque_tid(), G = gridDim.x;
    for (int u = tid; u < (LDS_BYTES - LDSCTL_OFF) / 4; u += NTHR) ((LAS unsigned*)(lds + LDSCTL_OFF))[u] = 0u;
    __syncthreads();
    volatile LAS unsigned* MISC = (volatile LAS unsigned*)(lds + LDSCTL_OFF + 320);
    unsigned* ctl = (unsigned*)(a->ws + WS_CTL);
    const int lo = a->ph_lo, hi = a->ph_hi;
    XcdBarrier bar; bar.bar = ctl + CW_BAR; bar.x = 0; bar.st = nullptr;
    if (hi - lo > 1) bar = xcd_barrier_post(ctl + CW_BAR, MISC + 8);
    int ph = 0;
#define RUN (ph >= lo && ph < hi)
#define NEXT() do { if (RUN && ph + 1 < hi) xcd_barrier(bar); ++ph; } while (0)
    bf16_t* H = (bf16_t*)(a->ws + WS_H); bf16_t* YS = (bf16_t*)(a->ws + WS_YS); bf16_t* BIG = (bf16_t*)(a->ws + WS_BIG);
    float* XS = (float*)(a->ws + WS_XS); float* SC = (float*)(a->ws + WS_SC); const float* MOD = (const float*)(a->ws + WS_MOD);

    if (RUN) { ROW_CALL(pro_a(a, lds)); }
    NEXT();
    if (RUN) { ROW_CALL(rowpass<0>(a, 0, lds)); }
    NEXT();
    for (int l = 0; l < DEPTH; ++l) {
        unsigned char* lw = a->ws + WS_W + (size_t)l * LW_BYTES;
        const bf16_t* WinT = (const bf16_t*)lw; const bf16_t* WbT = (const bf16_t*)(lw + LW_WB); const bf16_t* WoT = (const bf16_t*)(lw + LW_WO);
        if (RUN) { pg8::Gemm g{H, WinT + (size_t)4608 * D, D, D, nullptr}; pg8::StaticOrder S; S.init(T, 2304, G, (int)blockIdx.x); pg8::EpiP E{BIG, LDP, SC, 0, 0, 1, nullptr, 0, 0};
            GEMM_SITE(2) pg8::gemm_phase<pg8::EpiP, pg8::StaticOrder, true, true>(lds, g, S, E); }
        NEXT();
        if (RUN) { ROW_CALL(prepC_phase(a, l, lds)); }
        NEXT();
        if (RUN) { SCAN_CALL(tcC_phase(a, l, lds)); }
        NEXT();
        if (RUN) { SCAN_CALL(scanC_mfma(a, l, lds)); }
        NEXT();
        if (RUN) { ROW_CALL(finalize_phase(a, l, 2, lds)); }
        NEXT();
        if (RUN) { pg8::Gemm g{H, WinT, D, D, nullptr}; pg8::StaticOrder S; S.init(T, 2560, G, (int)blockIdx.x); pg8::EpiP E{BIG, LDP, nullptr, -1, 0, 0, (const float*)(a->ws + WS_OML) + l * 512, 2, 6};
            GEMM_SITE(0) pg8::gemm_phase<pg8::EpiP, pg8::StaticOrder, true, true>(lds, g, S, E); }
        NEXT();
        if (RUN) { SCAN_CALL(scanA_mfma(a, l, lds)); }
        NEXT();
        if (RUN) { ROW_CALL(finalize_phase(a, l, 0, lds)); }
        NEXT();
        if (RUN) { pg8::Gemm g{H, WinT + (size_t)2560 * D, D, D, nullptr}; pg8::StaticOrder S; S.init(T, 2048, G, (int)blockIdx.x); pg8::EpiP E{BIG, LDP, nullptr, -1, 0, 0, nullptr, 0, 0};
            GEMM_SITE(1) pg8::gemm_phase<pg8::EpiP, pg8::StaticOrder, true, true>(lds, g, S, E); }
        NEXT();
        if (RUN) { SCAN_CALL(scanB_mfma(a, l, lds)); }
        NEXT();
        if (RUN) { ROW_CALL(finalize_phase(a, l, 1, lds)); }
        NEXT();
        if (RUN) { pg8::Gemm g{H, WinT + (size_t)6912 * D, D, D, nullptr}; pg8::StaticOrder S; S.init(l == DEPTH - 1 ? NB * SEQ : T, 3072, G, (int)blockIdx.x); S.lat = (l == DEPTH - 1); pg8::EpiP E{BIG, LDMG, nullptr, -1, 1, 0, nullptr, 0, 0};
            GEMM_SITE(3) pg8::gemm_phase<pg8::EpiP, pg8::StaticOrder, true, true>(lds, g, S, E); }
        NEXT();
        const bool brsplit = (l != DEPTH - 1) && G == 256;
        if (RUN) { pg8::Gemm g{YS, WbT, LDYS, 1536, nullptr}; pg8::StaticOrder S; S.init(l == DEPTH - 1 ? NB * SEQ : T, 1024, G, (int)blockIdx.x); S.lat = (l == DEPTH - 1); pg8::EpiMixed E{BIG, H};
            if (brsplit) S.lim = 1024;
            GEMM_SITE(4) pg8::gemm_phase<pg8::EpiMixed, pg8::StaticOrder, true, true>(lds, g, S, E); }
        NEXT();
        if (RUN) { if (brsplit) {
                if ((int)blockIdx.x < 64) { pg8::Gemm g{YS, WbT, LDYS, 1536, nullptr}; pg8::StaticOrder S; S.init(T, 1024, G, (int)blockIdx.x); S.L0 = 1024; pg8::EpiMixed E{BIG, H};
                    GEMM_SITE(4) pg8::gemm_phase<pg8::EpiMixed, pg8::StaticOrder, true, true>(lds, g, S, E); }
                else { pg8::Gemm g{H, WoT, D, D, nullptr}; pg8::StaticOrder S; S.init(T, 1024, 192, (int)blockIdx.x - 64); S.L0 = 192; S.lim = 384; const float* lnid = (const float*)(a->ws + WS_LNID);
                    pg8::EpiRes E{XS, MOD + (size_t)l * 17 * 6144 + 2 * 1024, (const float*)(a->ws + (l ? WS_STAT : WS_ZSTAT)), l ? a->in[I_LNG] + (size_t)(l * 2 - 1) * D : lnid, l ? a->in[I_LNB] + (size_t)(l * 2 - 1) * D : lnid + 1024, a->in[I_X], a->in[I_CTX], ALPHA, l == 0};
                    GEMM_SITE(5) pg8::gemm_phase<pg8::EpiRes, pg8::StaticOrder, true, true>(lds, g, S, E); } } }
        NEXT();
        if (RUN) { pg8::Gemm g{H, WoT, D, D, nullptr}; pg8::StaticOrder S; S.init(l == DEPTH - 1 ? NB * SEQ : T, 1024, G, (int)blockIdx.x); S.lat = (l == DEPTH - 1); const float* lnid = (const float*)(a->ws + WS_LNID);
            if (brsplit) { S.gap0 = 192; S.gaplen = 192; S.lim = 1088 - 192; }
            pg8::EpiRes E{XS, MOD + (size_t)l * 17 * 6144 + 2 * 1024, (const float*)(a->ws + (l ? WS_STAT : WS_ZSTAT)), l ? a->in[I_LNG] + (size_t)(l * 2 - 1) * D : lnid, l ? a->in[I_LNB] + (size_t)(l * 2 - 1) * D : lnid + 1024, a->in[I_X], a->in[I_CTX], ALPHA, l == 0};
            GEMM_SITE(5) pg8::gemm_phase<pg8::EpiRes, pg8::StaticOrder, true, true>(lds, g, S, E); }
        NEXT();
        const bool moe = (l & 1) != 0; const int ns = moe ? 2 : 1;
        const int dlim = (NTILE * (D / 256) / G) * G, nleft = NTILE * (D / 256) - dlim;
        if (RUN) { ROW_CALL(rowpass<1>(a, l, lds)); if (moe) { __syncthreads(); ROW_CALL(conv_moe(a, l >> 1, lds)); } }
        NEXT();
        if (moe) { if (RUN) moe_fill(a, l >> 1, l == DEPTH - 1); NEXT(); }
        for (int s = 0; s < ns; ++s) {
            const unsigned char* fw = moe ? a->ws + WS_YS : a->ws + WS_WFFN + (size_t)(l >> 1) * FFNW_BYTES;
            const int* perm = moe ? (const int*)(a->ws + WS_PERM) + (size_t)s * TP : (const int*)(a->ws + WS_PERMID);
            const float* permw = moe ? (const float*)(a->ws + WS_PERMW) + (size_t)s * TP : nullptr;
            if (RUN) { int ts[9]; if (moe) moe_tile_starts(a, l >> 1, s, ts); else {
#pragma unroll
                    for (int e = 0; e < 9; ++e) ts[e] = e ? NTILE : 0; }
                pg8::Gemm g{H, (const bf16_t*)fw, D, D, perm}; pg8::MoeOrder S; S.init2(ts[8], 2 * FFN / 256, G, (int)blockIdx.x);
                S.ts1 = ts[1]; S.ts2 = ts[2]; S.ts3 = ts[3]; S.ts4 = ts[4]; S.ts5 = ts[5]; S.ts6 = ts[6]; S.ts7 = ts[7]; S.estride = FFNW_BYTES;
                pg8::EpiSwiglu E{BIG, FFN};
                GEMM_SITE(6) pg8::gemm_phase<pg8::EpiSwiglu, pg8::MoeOrder, true, true, true>(lds, g, S, E); }
            NEXT();
            if (RUN) { int ts[9]; if (moe) moe_tile_starts(a, l >> 1, s, ts); else {
#pragma unroll
                    for (int e = 0; e < 9; ++e) ts[e] = e ? NTILE : 0; }
                pg8::Gemm g{BIG, (const bf16_t*)(fw + FFNW_WD), FFN, FFN, nullptr}; pg8::MoeOrder S; S.init2(ts[8], D / 256, G, (int)blockIdx.x);
                S.ts1 = ts[1]; S.ts2 = ts[2]; S.ts3 = ts[3]; S.ts4 = ts[4]; S.ts5 = ts[5]; S.ts6 = ts[6]; S.ts7 = ts[7]; S.estride = FFNW_BYTES;
                const float* lnid = (const float*)(a->ws + WS_LNID);
                pg8::EpiScatter E{XS, MOD + (size_t)l * 17 * 6144 + 5 * 1024, perm, permw, (const float*)(a->ws + (s == 0 ? WS_STAT : WS_ZSTAT)), s == 0 ? a->in[I_LNG] + (size_t)(l * 2) * D : lnid, s == 0 ? a->in[I_LNB] + (size_t)(l * 2) * D : lnid + 1024, s == 0 ? ALPHA : 1.0f};
                if (!moe && nleft > 0) S.lim = dlim;
                GEMM_SITE(7) pg8::gemm_phase<pg8::EpiScatter, pg8::MoeOrder, true, true, false>(lds, g, S, E); }
            NEXT();
        }
        if (!moe && nleft > 0) {
            if (RUN) {
                if ((int)blockIdx.x < nleft) {
                    const unsigned char* fw = a->ws + WS_WFFN + (size_t)(l >> 1) * FFNW_BYTES;
                    pg8::Gemm g{BIG, (const bf16_t*)(fw + FFNW_WD), FFN, FFN, nullptr}; pg8::MoeOrder S; S.init2(NTILE, D / 256, G, (int)blockIdx.x); S.L0 = dlim;
                    S.ts1 = NTILE; S.ts2 = NTILE; S.ts3 = NTILE; S.ts4 = NTILE; S.ts5 = NTILE; S.ts6 = NTILE; S.ts7 = NTILE; S.estride = FFNW_BYTES;
                    pg8::EpiScatter E{XS, MOD + (size_t)l * 17 * 6144 + 5 * 1024, (const int*)(a->ws + WS_PERMID), nullptr, (const float*)(a->ws + WS_STAT), a->in[I_LNG] + (size_t)(l * 2) * D, a->in[I_LNB] + (size_t)(l * 2) * D, ALPHA};
                    GEMM_SITE(7) pg8::gemm_phase<pg8::EpiScatter, pg8::MoeOrder, true, true, false>(lds, g, S, E);
                } else { ROW_CALL(rowpass<2>(a, l, lds, 1, nleft, dlim)); } }
            NEXT();
            if (RUN) { ROW_CALL(rowpass<2>(a, l, lds, 2, 0, dlim)); }
            NEXT();
        } else {
        if (RUN) { ROW_CALL(rowpass<2>(a, l, lds)); }
        NEXT();
        }
    }
#undef RUN
#undef NEXT
}
}

extern "C" void kernel_launch(void* const* d_in, const int* in_sizes, int n_in, void* d_out, int out_size, void* d_ws, size_t ws_size, hipStream_t stream) {
    using namespace mk;
    static int grid = 0;
    if (grid == 0) {
        if (n_in != 24 || in_sizes[0] != NB * SEQ * D || out_size != NB * SEQ * D || ws_size < WS_END) {
            fprintf(stderr, "kernel_launch: unexpected shapes or workspace (n_in %d, in0 %d, out %d, ws %zu, need %zu); nothing launched\n", n_in, n_in > 0 ? in_sizes[0] : -1, out_size, ws_size, (size_t)WS_END); grid = -1; return; }
        int dev = 0, cus = 0, per_cu = 0;
        if (hipGetDevice(&dev) != hipSuccess || hipDeviceGetAttribute(&cus, hipDeviceAttributeMultiprocessorCount, dev) != hipSuccess) { grid = -1; return; }
        if (hipFuncSetAttribute((const void*)mk_fwd, hipFuncAttributeMaxDynamicSharedMemorySize, LDS_BYTES) != hipSuccess) { fprintf(stderr, "kernel_launch: hipFuncSetAttribute failed\n"); grid = -1; return; }
        if (hipOccupancyMaxActiveBlocksPerMultiprocessor(&per_cu, (const void*)mk_fwd, NTHR, LDS_BYTES) != hipSuccess || per_cu < 1) { fprintf(stderr, "kernel_launch: occupancy query reports %d\n", per_cu); }
        (void)hipGetLastError();
        grid = cus;
    }
    if (grid < 0) return;
    if (hipMemsetAsync((char*)d_ws + WS_CTL, 0, CTL_ZERO_BYTES, stream) != hipSuccess) return;
    Args a{};
    for (int i = 0; i < 24; ++i) a.in[i] = (const float*)d_in[i];
    a.out = (float*)d_out; a.ws = (unsigned char*)d_ws;
#if MK_ONE_LAUNCH
    a.ph_lo = 0; a.ph_hi = PH_TOTAL;
    hipLaunchKernelGGL(mk_fwd, dim3(grid), dim3(NTHR), LDS_BYTES, stream, a);
#else
    for (int p = 0; p < PH_TOTAL; ++p) { a.ph_lo = p; a.ph_hi = p + 1; hipLaunchKernelGGL(mk_fwd, dim3(grid), dim3(NTHR), LDS_BYTES, stream, a); }
#endif
}
```

```cpp
#include <hip/hip_runtime.h>
#include <cstdio>
#include <cstdint>
namespace pg8 {
#define PG8_LAS __attribute__((address_space(3)))
typedef unsigned short bf16_t;
typedef short bf16x8 __attribute__((ext_vector_type(8)));
typedef float f32x4 __attribute__((ext_vector_type(4)));
typedef unsigned u32x4 __attribute__((ext_vector_type(4)));
constexpr int BM = 256, BK = 64, HALF = 128, HTB = HALF * BK * 2  , STAGE_BYTES = 8 * HTB, NXCD = 8, WGM = 4;

__host__ __device__ __forceinline__ int lds_byte(int r, int c) { const int st = (r >> 4) * 2 + (c >> 5), rr = r & 15, cc = c & 31, ob = rr * 64 + cc * 2; return st * 1024 + (ob ^ (((ob >> 9) & 1) << 5)); }
__host__ __device__ __forceinline__ void stage_rc(int b, int& R, int& C) { const int st = b / 1024, sb = b % 1024, swz = sb ^ (((sb >> 9) & 1) << 5); R = (st >> 1) * 16 + swz / 64; C = (st & 1) * 32 + (swz % 64) / 2; }
__host__ __device__ __forceinline__ int perm32(int rho) { const int n = rho >> 4, i = rho & 15; return 8 * (i >> 2) + 4 * n + (i & 3); }

struct Unit { int pm, pn; };
struct Gemm { const bf16_t* A; const bf16_t* Bt; int lda, K; const int* perm; };

struct StaticOrder {
    int nM, nN, nwg, G, c, lat;
    int L0, lim;
    __host__ __device__ void init(int M, int N, int G_, int c_) { nM = M / BM; nN = N / BM; nwg = nM * nN; G = G_; c = c_; lat = 0; L0 = 0; lim = nwg; }
    __host__ __device__ bool next(int i, Unit& u) const {
        const long L = (long)i * G + c + L0; if (L >= lim) return false;
        int wgid = (int)L; { const int q = nwg / NXCD, r = nwg % NXCD, xcd = wgid % NXCD, off = wgid / NXCD; wgid = (xcd < r ? xcd * (q + 1) : r * (q + 1) + (xcd - r) * q) + off; }
        const int nig = WGM * nN, gid = wgid / nig, fm = gid * WGM, gsz = (nM - fm) < WGM ? (nM - fm) : WGM;
        u.pm = fm + ((wgid % nig) % gsz); u.pn = (wgid % nig) / gsz; if (lat) u.pm += u.pm / 16 + 1; return true;
    }
    __host__ __device__ int pos_of(int pm, int pn) const {
        const int fm = (pm / WGM) * WGM, gsz = (nM - fm) < WGM ? (nM - fm) : WGM, wgid = (pm / WGM) * (WGM * nN) + pn * gsz + (pm - fm);
        const int q = nwg / NXCD, r = nwg % NXCD; int xcd, off;
        if (wgid < r * (q + 1)) { xcd = wgid / (q + 1); off = wgid % (q + 1); } else { const int w2 = wgid - r * (q + 1); xcd = r + w2 / q; off = w2 % q; }
        return off * NXCD + xcd; }
    __device__ __forceinline__ void a_ready(const Unit&) const {}
    __device__ __forceinline__ void done(const Unit&) const {}
    __device__ __forceinline__ size_t a_off(const Unit& u, int lda) const { return (size_t)u.pm * BM * lda * 2; }
    __device__ __forceinline__ size_t b_off(const Unit& u, int K) const { return (size_t)u.pn * BM * K * 2; }
};

typedef float f32x2c_t __attribute__((ext_vector_type(2)));
typedef __bf16 bf16x2c_t __attribute__((ext_vector_type(2)));
__device__ __forceinline__ unsigned cvt_pk_bf16(float lo, float hi) { const f32x2c_t v = {lo, hi}; return __builtin_bit_cast(unsigned, __builtin_convertvector(v, bf16x2c_t)); }
typedef float f32x2 __attribute__((ext_vector_type(2)));
__device__ __forceinline__ float bf2f(unsigned short b) { return __uint_as_float(((unsigned)b) << 16); }
__device__ __forceinline__ float sigm(float x) { return 1.0f / (1.0f + __expf(-x)); }
__device__ __forceinline__ void sigm2(float a, float b, float& sa, float& sb) { const float da = 1.0f + __expf(fminf(-a, 40.0f)), db = 1.0f + __expf(fminf(-b, 40.0f)); const float r = __builtin_amdgcn_rcpf(da * db); sa = r * db; sb = r * da; }
__device__ __forceinline__ int mi_of_pm(int pm) { const int b = pm / 17, j = pm - b * 17; return j == 0 ? 16 : b; }

template <int BANKS> __device__ __forceinline__ unsigned dpp_ror8_upd(unsigned old, unsigned v) { return (unsigned)__builtin_amdgcn_update_dpp((int)old, (int)v, 0x128, 0xf, BANKS, false); }
__device__ __forceinline__ void store_pair_lines(bf16_t* p, int ldc, int fr, u32x4 w0, u32x4 w1) {
    u32x4 s1, s2;
#pragma unroll
    for (int j = 0; j < 4; ++j) { s1[j] = dpp_ror8_upd<0xC>(w0[j], w1[j]); s2[j] = dpp_ror8_upd<0x3>(w1[j], w0[j]); }
    bf16_t* q = p + (fr < 8 ? 0 : 32);
    *(u32x4*)q = s1; *(u32x4*)(q + (size_t)8 * ldc) = s2;
}
struct EpiP {
    static constexpr bool PERM = true, AFTER_DRAIN = false, MID = false;
    bf16_t* O; int ldc; float* SC; int sc_pn; int act; int pn_shift;
    const float* oml; int fg_lo, fg_hi;
    __device__ __forceinline__ void operator()(const f32x4 (&acc)[2][2][4][2], const Unit& u, int wr, int wc, int fr, int fq) const {
        const int row0 = u.pm * BM + wr * 64 + fr;
        if (u.pn == sc_pn) {
            if (wc == 0) {
#pragma unroll
                for (int ai = 0; ai < 2; ++ai)
#pragma unroll
                    for (int m = 0; m < 4; ++m) { float* rp = SC + (size_t)(row0 + ai * HALF + m * 16) * 32 + 8 * fq;
#pragma unroll
                        for (int n = 0; n < 2; ++n) *(f32x4*)(rp + 4 * n) = acc[ai][0][m][n]; }
            }
            return;
        }
        const int col0 = (u.pn - pn_shift) * BM + wc * 64 + 8 * fq;
        const bool fg = u.pn >= fg_lo && u.pn < fg_hi;
        f32x4 om[2][2];
        if (fg) {
#pragma unroll
            for (int bj = 0; bj < 2; ++bj)
#pragma unroll
                for (int n = 0; n < 2; ++n) om[bj][n] = *(const f32x4*)(oml + ((col0 + 32 * bj + 4 * n) & 511)); }
#pragma unroll
        for (int ai = 0; ai < 2; ++ai)
#pragma unroll
            for (int m = 0; m < 4; ++m) { bf16_t* rowp = O + (size_t)(u.pm * BM + wr * 64 + ai * HALF + m * 16 + (fr & 7)) * ldc + col0;
                u32x4 w[2];
#pragma unroll
                for (int bj = 0; bj < 2; ++bj) { f32x4 v0 = acc[ai][bj][m][0], v1 = acc[ai][bj][m][1];
                    if (act) {
#pragma unroll
                        for (int j = 0; j < 4; ++j) { v0[j] = __builtin_amdgcn_rcpf(1.0f + __builtin_amdgcn_exp2f(-v0[j])); v1[j] = __builtin_amdgcn_rcpf(1.0f + __builtin_amdgcn_exp2f(-v1[j])); } }
                    if (fg) {
#pragma unroll
                        for (int j = 0; j < 4; ++j) { v0[j] = om[bj][0][j] * __builtin_amdgcn_rcpf(1.0f + __builtin_amdgcn_exp2f(v0[j])); v1[j] = om[bj][1][j] * __builtin_amdgcn_rcpf(1.0f + __builtin_amdgcn_exp2f(v1[j])); } }
                    w[bj].x = cvt_pk_bf16(v0[0], v0[1]); w[bj].y = cvt_pk_bf16(v0[2], v0[3]); w[bj].z = cvt_pk_bf16(v1[0], v1[1]); w[bj].w = cvt_pk_bf16(v1[2], v1[3]); }
                store_pair_lines(rowp, ldc, fr, w[0], w[1]); }
    }
};
struct EpiMixed {
    static constexpr bool PERM = true, AFTER_DRAIN = false, MID = true;
    const bf16_t* G; bf16_t* O;
    __device__ __forceinline__ void mid(f32x4 (&acc)[2][2][4][2], const Unit& u, int seg, int wr, int wc, int fr, int fq) const {
        int row0 = u.pm * BM + wr * 64 + fr, col0 = u.pn * BM + wc * 64 + 8 * fq; asm volatile("" : "+v"(row0), "+v"(col0));
        u32x4 ga[2][2], gb[2][2];
#define MIX_LOAD(g_, buf_) do { const bf16_t* gp_ = G + (size_t)(row0 + ((g_) >> 2) * HALF + ((g_) & 3) * 16) * 3072 + (seg - 1) * 1024 + col0; \
            ga[buf_][0] = *(const u32x4*)gp_; gb[buf_][0] = *(const u32x4*)(gp_ + 1024); ga[buf_][1] = *(const u32x4*)(gp_ + 32); gb[buf_][1] = *(const u32x4*)(gp_ + 1024 + 32); } while (0)
        MIX_LOAD(0, 0);
#pragma unroll
        for (int g = 0; g < 8; ++g) { const int ai = g >> 2, m = g & 3, cb = g & 1;
            if (g + 1 < 8) MIX_LOAD(g + 1, cb ^ 1);
#pragma unroll
            for (int bj = 0; bj < 2; ++bj) { const u32x4 xa = ga[cb][bj], xb = gb[cb][bj];
                f32x4 r0, r1;
#pragma unroll
                for (int j = 0; j < 2; ++j) {
                    r0[2 * j] = __uint_as_float(xa[j] << 16) * __builtin_amdgcn_rcpf(fmaxf(__uint_as_float(xb[j] << 16), 1e-30f)); r0[2 * j + 1] = __uint_as_float(xa[j] & 0xffff0000u) * __builtin_amdgcn_rcpf(fmaxf(__uint_as_float(xb[j] & 0xffff0000u), 1e-30f));
                    r1[2 * j] = __uint_as_float(xa[2 + j] << 16) * __builtin_amdgcn_rcpf(fmaxf(__uint_as_float(xb[2 + j] << 16), 1e-30f)); r1[2 * j + 1] = __uint_as_float(xa[2 + j] & 0xffff0000u) * __builtin_amdgcn_rcpf(fmaxf(__uint_as_float(xb[2 + j] & 0xffff0000u), 1e-30f)); }
                acc[ai][bj][m][0] *= r0; acc[ai][bj][m][1] *= r1; }
            asm volatile("" ::: "memory"); __builtin_amdgcn_sched_barrier(0); }
#undef MIX_LOAD
    }
    __device__ __forceinline__ void operator()(const f32x4 (&acc)[2][2][4][2], const Unit& u, int wr, int wc, int fr, int fq) const {
        const int row0 = u.pm * BM + wr * 64, col0 = u.pn * BM + wc * 64 + 8 * fq;
#pragma unroll
        for (int ai = 0; ai < 2; ++ai)
#pragma unroll
            for (int m = 0; m < 4; ++m) { const size_t rowb = (size_t)(row0 + ai * HALF + m * 16); const bf16_t* gp = G + (rowb + fr) * 3072 + 2048 + col0;
                u32x4 w[2];
#pragma unroll
                for (int bj = 0; bj < 2; ++bj) { const f32x4 v0 = acc[ai][bj][m][0], v1 = acc[ai][bj][m][1]; const u32x4 g = *(const u32x4*)(gp + bj * 32);
                    w[bj].x = cvt_pk_bf16(v0[0] * __uint_as_float(g.x << 16), v0[1] * __uint_as_float(g.x & 0xffff0000u));
                    w[bj].y = cvt_pk_bf16(v0[2] * __uint_as_float(g.y << 16), v0[3] * __uint_as_float(g.y & 0xffff0000u));
                    w[bj].z = cvt_pk_bf16(v1[0] * __uint_as_float(g.z << 16), v1[1] * __uint_as_float(g.z & 0xffff0000u));
                    w[bj].w = cvt_pk_bf16(v1[2] * __uint_as_float(g.w << 16), v1[3] * __uint_as_float(g.w & 0xffff0000u)); }
                store_pair_lines(O + (rowb + (fr & 7)) * 1024 + col0, 1024, fr, w[0], w[1]); }
    }
};
struct EpiSwiglu {
    static constexpr bool PERM = true, AFTER_DRAIN = false, MID = false;
    bf16_t* O; int ldc;
    __device__ __forceinline__ void operator()(const f32x4 (&acc)[2][2][4][2], const Unit& u, int wr, int wc, int fr, int fq) const {
        const int row0 = u.pm * BM + wr * 64 + fr, col0 = u.pn * HALF + wc * 32 + 8 * fq;
#pragma unroll
        for (int ai = 0; ai < 2; ++ai)
#pragma unroll
            for (int m = 0; m < 4; ++m) { bf16_t* rowp = O + (size_t)(row0 + ai * HALF + m * 16) * ldc + col0;
                f32x4 v0, v1;
#pragma unroll
                for (int j = 0; j < 4; ++j) { const float g0 = acc[ai][0][m][0][j], g1 = acc[ai][0][m][1][j];
                    v0[j] = g0 * __builtin_amdgcn_rcpf(1.0f + __builtin_amdgcn_exp2f(-g0)) * acc[ai][1][m][0][j]; v1[j] = g1 * __builtin_amdgcn_rcpf(1.0f + __builtin_amdgcn_exp2f(-g1)) * acc[ai][1][m][1][j]; }
                u32x4 w; w.x = cvt_pk_bf16(v0[0], v0[1]); w.y = cvt_pk_bf16(v0[2], v0[3]); w.z = cvt_pk_bf16(v1[0], v1[1]); w.w = cvt_pk_bf16(v1[2], v1[3]);
                *(u32x4*)rowp = w; }
    }
};
struct EpiRes {
    static constexpr bool PERM = false, AFTER_DRAIN = false, MID = false;
    float* X; const float* mod; const float* stat; const float* lng; const float* lnb;
    const float* inx; const float* inc; float alpha; int first;
    __device__ __forceinline__ void operator()(const f32x4 (&acc)[2][2][4][2], const Unit& u, int wr, int wc, int fr, int fq) const {
        const int row0 = u.pm * BM + wr * 64 + fr, col0 = u.pn * BM + wc * 32 + 4 * fq;
        const float* mp = mod + (size_t)mi_of_pm(u.pm) * 6144 + col0;
        const int ib = u.pm / 17, ij = u.pm - ib * 17;
        const unsigned long long a_x = (unsigned long long)X + (unsigned long long)(u.pm * BM) * 4096ull, a_c = (unsigned long long)inc + (unsigned long long)(ib * 256) * 4096ull, a_i = (unsigned long long)inx + (unsigned long long)(ib * 4096 + (ij - 1) * 256) * 4096ull;
        const unsigned long long a_sel = first ? (ij == 0 ? a_c : a_i) : a_x;
        const __attribute__((address_space(1))) float* rsrc = (const __attribute__((address_space(1))) float*)(a_sel + (unsigned long long)((wr * 64 + fr) * 1024 + col0) * 4ull);
        f32x4 gv[2][2], lg[2][2], lb[2][2];
#pragma unroll
        for (int bj = 0; bj < 2; ++bj)
#pragma unroll
            for (int n = 0; n < 2; ++n) { gv[bj][n] = *(const f32x4*)(mp + bj * HALF + n * 16); lg[bj][n] = *(const f32x4*)(lng + col0 + bj * HALF + n * 16); lb[bj][n] = *(const f32x4*)(lnb + col0 + bj * HALF + n * 16); }
#pragma unroll
        for (int bj = 0; bj < 2; ++bj)
#pragma unroll
            for (int n = 0; n < 2; ++n) lb[bj][n] *= alpha;
#pragma unroll
        for (int ai = 0; ai < 2; ++ai)
#pragma unroll
            for (int m = 0; m < 4; ++m) { const int row = row0 + ai * HALF + m * 16; float* rowp = X + (size_t)row * 1024 + col0;
                const f32x2 st = *(const f32x2*)(stat + (size_t)row * 2); const float ar = alpha * (st.y + 1.0f), br = -st.x * ar;
#pragma unroll
                for (int bj = 0; bj < 2; ++bj)
#pragma unroll
                    for (int n = 0; n < 2; ++n) { const f32x4 x = *(const __attribute__((address_space(1))) f32x4*)(rsrc + (size_t)(ai * HALF + m * 16) * 1024 + bj * HALF + n * 16);
                        *(f32x4*)(rowp + bj * HALF + n * 16) = lg[bj][n] * (x * ar + br) + lb[bj][n] + gv[bj][n] * acc[ai][bj][m][n]; } }
    }
};
struct EpiScatter {
    static constexpr bool PERM = false, AFTER_DRAIN = false, MID = false;
    float* X; const float* mod; const int* perm; const float* permw; const float* stat; const float* lng; const float* lnb; float alpha;
    __device__ __forceinline__ void operator()(const f32x4 (&acc)[2][2][4][2], const Unit& u, int wr, int wc, int fr, int fq) const {
        const int row0 = u.pm * BM + wr * 64 + fr, col0 = u.pn * BM + wc * 32 + 4 * fq;
        f32x4 lg[2][2], lb[2][2];
#pragma unroll
        for (int bj = 0; bj < 2; ++bj)
#pragma unroll
            for (int n = 0; n < 2; ++n) { lg[bj][n] = *(const f32x4*)(lng + col0 + bj * HALF + n * 16); lb[bj][n] = *(const f32x4*)(lnb + col0 + bj * HALF + n * 16); }
#pragma unroll
        for (int bj = 0; bj < 2; ++bj)
#pragma unroll
            for (int n = 0; n < 2; ++n) lb[bj][n] *= alpha;
#pragma unroll
        for (int ai = 0; ai < 2; ++ai)
#pragma unroll
            for (int m = 0; m < 4; ++m) { const int r = row0 + ai * HALF + m * 16; const int tok = perm[r];
                if (tok >= 0) { const float w = permw ? permw[r] : 1.0f; const int b = tok / 4352, p = tok - b * 4352; const int mi = p < 256 ? 16 : b;
                    const float* mp = mod + (size_t)mi * 6144 + col0; float* rowp = X + (size_t)tok * 1024 + col0;
                    const f32x2 st = *(const f32x2*)(stat + (size_t)tok * 2); const float ar = alpha * (st.y + 1.0f), br = -st.x * ar;
#pragma unroll
                    for (int bj = 0; bj < 2; ++bj)
#pragma unroll
                        for (int n = 0; n < 2; ++n) { const f32x4 gv = *(const f32x4*)(mp + bj * HALF + n * 16); const f32x4 x = *(const f32x4*)(rowp + bj * HALF + n * 16);
                            *(f32x4*)(rowp + bj * HALF + n * 16) = lg[bj][n] * (x * ar + br) + lb[bj][n] + (gv * w) * acc[ai][bj][m][n]; } } }
    }
};
struct MoeOrder : StaticOrder {
    int ts1, ts2, ts3, ts4, ts5, ts6, ts7; size_t estride;
    __device__ __forceinline__ void init2(int nM_, int nN_, int G_, int c_) { nM = nM_; nN = nN_; nwg = nM * nN; G = G_; c = c_; lat = 0; L0 = 0; lim = nwg; }
    __device__ __forceinline__ size_t b_off(const Unit& u, int K) const {
        const int e = (u.pm >= ts1) + (u.pm >= ts2) + (u.pm >= ts3) + (u.pm >= ts4) + (u.pm >= ts5) + (u.pm >= ts6) + (u.pm >= ts7);
        return (size_t)e * estride + (size_t)u.pn * BM * K * 2; }
};

template <class Epi, class Sched, bool ALIGN_EPI = false, bool SP2 = false, bool GATHER = false>
__device__ __forceinline__ void gemm_phase(PG8_LAS unsigned char* lds, const Gemm g, const Sched& S, const Epi& E) {
    int tid_ = threadIdx.x; asm volatile("" : "+v"(tid_));
    const int tid = tid_, wid = __builtin_amdgcn_readfirstlane(tid >> 6), lane = tid & 63, wr = wid >> 2, wc = wid & 3, fr = lane & 15, fq = lane >> 4;
    const int K = g.K, nt = K / BK;
    unsigned voffA[2], voffB[2];
#pragma unroll
    for (int i = 0; i < 2; ++i) { int R, C; stage_rc(tid * 16 + i * 8192, R, C); const int Rb = Epi::PERM ? ((R & ~31) + perm32(R & 31)) : R;
        voffA[i] = (unsigned)(R * g.lda + C) * 2u; voffB[i] = (unsigned)(Rb * K + C) * 2u; }
    const size_t kstep = (size_t)(BK * 2);
    const size_t hstepA = (size_t)HALF * g.lda * 2, hstepB = (size_t)HALF * K * 2;
    const unsigned ldsw = (unsigned)wid * 1024u;
    const int aoff = lds_byte(wr * 64 + fr, fq * 8), boff = lds_byte(wc * 32 + fr, fq * 8);
#define PG8_SA(b, h) (((b) * 2 + (h)) * HTB)
#define PG8_SB(b, h) ((4 + (b) * 2 + (h)) * HTB)
#define PG8_STAGE(bufoff, gbase, voff) do { _Pragma("unroll") for (int _i = 0; _i < 2; ++_i) \
        __builtin_amdgcn_global_load_lds((const unsigned*)((const char*)(gbase) + (voff)[_i]), (PG8_LAS unsigned*)(lds + (bufoff) + ldsw + _i * 8192), 16, 0, 0); } while (0)
#define PG8_STAGE_A(bufoff, kptr, h, nx) do { if constexpr (GATHER) { _Pragma("unroll") for (int _i = 0; _i < 2; ++_i) { const unsigned _vo = (nx) ? vN[h][_i] : vC[h][_i]; \
        __builtin_amdgcn_global_load_lds((const unsigned*)((const char*)(kptr) + _vo), (PG8_LAS unsigned*)(lds + (bufoff) + ldsw + _i * 8192), 16, 0, 0); } } \
    else { PG8_STAGE(bufoff, (kptr) + (h) * hstepA, voffA); } } while (0)
#define PG8_LOADR(RW, u) do { _Pragma("unroll") for (int _h = 0; _h < 2; ++_h) _Pragma("unroll") for (int _i = 0; _i < 2; ++_i) { int _R, _C; stage_rc(tid * 16 + _i * 8192, _R, _C); \
        RW[_h][_i] = g.perm[(u).pm * BM + _h * HALF + _R]; } } while (0)
#define PG8_CONV(V, RW) do { _Pragma("unroll") for (int _h = 0; _h < 2; ++_h) _Pragma("unroll") for (int _i = 0; _i < 2; ++_i) { int _R, _C; stage_rc(tid * 16 + _i * 8192, _R, _C); \
        int _ix = RW[_h][_i]; _ix = _ix < 0 ? 0 : _ix; V[_h][_i] = (unsigned)(_ix * g.lda + _C) * 2u; } } while (0)
#define PG8_LDA(dst, b, h) do { _Pragma("unroll") for (int m = 0; m < 4; ++m) _Pragma("unroll") for (int k = 0; k < 2; ++k) dst[m][k] = *(const PG8_LAS bf16x8*)(lds + PG8_SA(b, h) + aoff + m * 2048 + k * 1024); } while (0)
#define PG8_LDB(dst, b, h) do { _Pragma("unroll") for (int n = 0; n < 2; ++n) _Pragma("unroll") for (int k = 0; k < 2; ++k) dst[n][k] = *(const PG8_LAS bf16x8*)(lds + PG8_SB(b, h) + boff + n * 2048 + k * 1024); } while (0)
#define PG8_MMA(ai, bj, At, Bt) do { __builtin_amdgcn_s_setprio(1); _Pragma("unroll") for (int m = 0; m < 4; ++m) _Pragma("unroll") for (int n = 0; n < 2; ++n) _Pragma("unroll") for (int k = 0; k < 2; ++k) \
        acc[ai][bj][m][n] = __builtin_amdgcn_mfma_f32_16x16x32_bf16(Bt[n][k], At[m][k], acc[ai][bj][m][n], 0, 0, 0); __builtin_amdgcn_s_setprio(0); } while (0)
#define PG8_WAIT_V(n) asm volatile("s_waitcnt vmcnt(" #n ")" ::: "memory")
#define PG8_WAIT_L(n) asm volatile("s_waitcnt lgkmcnt(" #n ")" ::: "memory")
#define PG8_BAR __builtin_amdgcn_s_barrier()
#define PG8_SCHED __builtin_amdgcn_sched_barrier(0)
    Unit cur, nxt; int ui = 0;
    if (!S.next(0, cur)) return;
    f32x4 acc[2][2][4][2];
#pragma unroll
    for (int a = 0; a < 2; ++a)
#pragma unroll
        for (int b = 0; b < 2; ++b)
#pragma unroll
            for (int m = 0; m < 4; ++m)
#pragma unroll
                for (int n = 0; n < 2; ++n) acc[a][b][m][n] = (f32x4){0.f, 0.f, 0.f, 0.f};
    bf16x8 At[4][2], B0[2][2], B1[2][2];
    const char* cA = (const char*)g.A + (GATHER ? (size_t)0 : S.a_off(cur, g.lda)); const char* cB = (const char*)g.Bt + S.b_off(cur, K);
    unsigned vC[2][2], vN[2][2];
    int rN[2][2];
    if constexpr (GATHER) { int rC[2][2]; PG8_LOADR(rC, cur); Unit n1; if (S.next(1, n1)) PG8_LOADR(rN, n1); PG8_CONV(vC, rC); }
    S.a_ready(cur);
    if constexpr (SP2) {
        PG8_STAGE(PG8_SB(0, 0), cB, voffB); PG8_STAGE(PG8_SB(0, 1), cB + hstepB, voffB); PG8_STAGE_A(PG8_SA(0, 0), cA, 0, false); PG8_STAGE_A(PG8_SA(0, 1), cA, 1, false);
        if (wr == 1) PG8_BAR;
        PG8_WAIT_V(2); PG8_BAR;
        PG8_STAGE(PG8_SB(1, 0), cB + kstep, voffB); PG8_STAGE_A(PG8_SA(1, 0), cA + kstep, 0, false); PG8_STAGE(PG8_SB(1, 1), cB + hstepB + kstep, voffB);
        PG8_WAIT_V(6); PG8_BAR;
    } else {
        PG8_STAGE(PG8_SB(0, 0), cB, voffB); PG8_STAGE_A(PG8_SA(0, 0), cA, 0, false); PG8_STAGE(PG8_SB(0, 1), cB + hstepB, voffB); PG8_STAGE_A(PG8_SA(0, 1), cA, 1, false);
        if (wr == 1) PG8_BAR;
        PG8_WAIT_V(4); PG8_BAR;
        PG8_STAGE(PG8_SB(1, 0), cB + kstep, voffB); PG8_STAGE_A(PG8_SA(1, 0), cA + kstep, 0, false); PG8_STAGE(PG8_SB(1, 1), cB + hstepB + kstep, voffB);
        PG8_WAIT_V(6); PG8_BAR;
    }
    for (;;) {
        const bool has_next = S.next(ui + 1, nxt);
        const char* nA = has_next ? (const char*)g.A + (GATHER ? (size_t)0 : S.a_off(nxt, g.lda)) : cA; const char* nB = has_next ? (const char*)g.Bt + S.b_off(nxt, K) : cB;
        if constexpr (GATHER) { if (has_next) PG8_CONV(vN, rN); else { vN[0][0] = vC[0][0]; vN[0][1] = vC[0][1]; vN[1][0] = vC[1][0]; vN[1][1] = vC[1][1]; }
            Unit n2; if (S.next(ui + 2, n2)) PG8_LOADR(rN, n2); }
        for (int t = 0; t < nt; t += 2) {
            const bool last = (t == nt - 2);
            const char* a1 = cA + (size_t)(t + 1) * kstep;
            const char* a2 = last ? nA : cA + (size_t)(t + 2) * kstep; const char* b2 = last ? nB : cB + (size_t)(t + 2) * kstep;
            const char* a3 = a2 + kstep; const char* b3 = b2 + kstep;
            if (last && has_next) S.a_ready(nxt);
            if constexpr (SP2) {
            PG8_LDB(B0, 0, 0); PG8_LDB(B1, 0, 1); PG8_SCHED; PG8_LDA(At, 0, 0); PG8_STAGE_A(PG8_SA(1, 1), a1, 1, false);
            PG8_WAIT_V(8); PG8_WAIT_L(0); PG8_BAR; PG8_MMA(0, 0, At, B0); PG8_MMA(0, 1, At, B1); PG8_BAR; PG8_SCHED;
            PG8_LDA(At, 0, 1); PG8_STAGE(PG8_SB(0, 0), b2, voffB); PG8_STAGE(PG8_SB(0, 1), b2 + hstepB, voffB); PG8_STAGE_A(PG8_SA(0, 0), a2, 0, last);
            PG8_WAIT_V(8); PG8_WAIT_L(0); PG8_BAR; PG8_MMA(1, 0, At, B0); PG8_MMA(1, 1, At, B1); PG8_BAR; PG8_SCHED;
            PG8_LDB(B0, 1, 0); PG8_LDB(B1, 1, 1); PG8_SCHED; PG8_LDA(At, 1, 0); PG8_STAGE_A(PG8_SA(0, 1), a2, 1, last);
            PG8_WAIT_V(8); PG8_WAIT_L(0); PG8_BAR; PG8_MMA(0, 0, At, B0); PG8_MMA(0, 1, At, B1); PG8_BAR; PG8_SCHED;
            PG8_LDA(At, 1, 1); PG8_STAGE(PG8_SB(1, 0), b3, voffB); PG8_STAGE(PG8_SB(1, 1), b3 + hstepB, voffB); PG8_STAGE_A(PG8_SA(1, 0), a3, 0, last);
            PG8_WAIT_V(8); PG8_WAIT_L(0); PG8_BAR; PG8_MMA(1, 0, At, B0); PG8_MMA(1, 1, At, B1); PG8_BAR; PG8_SCHED;
            } else {
            PG8_LDB(B0, 0, 0); PG8_SCHED; PG8_LDA(At, 0, 0); PG8_STAGE_A(PG8_SA(1, 1), a1, 1, false);
            PG8_WAIT_L(8); PG8_BAR; PG8_WAIT_L(0); PG8_MMA(0, 0, At, B0); PG8_BAR; PG8_SCHED;
            PG8_LDB(B1, 0, 1); PG8_STAGE(PG8_SB(0, 0), b2, voffB);
            PG8_BAR; PG8_WAIT_L(0); PG8_MMA(0, 1, At, B1); PG8_BAR;
            PG8_LDA(At, 0, 1); PG8_STAGE_A(PG8_SA(0, 0), a2, 0, last);
            PG8_BAR; PG8_WAIT_L(0); PG8_MMA(1, 0, At, B0); PG8_BAR; PG8_SCHED;
            PG8_STAGE(PG8_SB(0, 1), b2 + hstepB, voffB);
            PG8_WAIT_V(6); PG8_BAR; PG8_MMA(1, 1, At, B1); PG8_BAR;
            PG8_LDB(B0, 1, 0); PG8_SCHED; PG8_LDA(At, 1, 0); PG8_STAGE_A(PG8_SA(0, 1), a2, 1, last);
            PG8_WAIT_L(8); PG8_BAR; PG8_WAIT_L(0); PG8_MMA(0, 0, At, B0); PG8_BAR; PG8_SCHED;
            PG8_LDB(B1, 1, 1); PG8_STAGE(PG8_SB(1, 0), b3, voffB);
            PG8_BAR; PG8_WAIT_L(0); PG8_MMA(0, 1, At, B1); PG8_BAR;
            PG8_LDA(At, 1, 1); PG8_STAGE_A(PG8_SA(1, 0), a3, 0, last);
            PG8_BAR; PG8_WAIT_L(0); PG8_MMA(1, 0, At, B0); PG8_BAR; PG8_SCHED;
            PG8_STAGE(PG8_SB(1, 1), b3 + hstepB, voffB);
            PG8_WAIT_V(6); PG8_BAR; PG8_MMA(1, 1, At, B1); PG8_BAR;
            }
            if constexpr (Epi::MID) { if (((t + 2) & 7) == 0 && t + 2 < nt) E.mid(acc, cur, (t + 2) >> 3, wr, wc, fr, fq); }
        }
        if constexpr (ALIGN_EPI) { if (wr == 0) PG8_BAR; }
        if constexpr (!Epi::AFTER_DRAIN) { E(acc, cur, wr, wc, fr, fq); S.done(cur); }
        if (!has_next) break;
#pragma unroll
        for (int a = 0; a < 2; ++a)
#pragma unroll
            for (int b = 0; b < 2; ++b)
#pragma unroll
                for (int m = 0; m < 4; ++m)
#pragma unroll
                    for (int n = 0; n < 2; ++n) acc[a][b][m][n] = (f32x4){0.f, 0.f, 0.f, 0.f};
        cur = nxt; cA = nA; cB = nB; ++ui;
        if constexpr (GATHER) { vC[0][0] = vN[0][0]; vC[0][1] = vN[0][1]; vC[1][0] = vN[1][0]; vC[1][1] = vN[1][1]; }
        if constexpr (ALIGN_EPI) { if (wr == 1) PG8_BAR; }
    }
    PG8_WAIT_V(0);
    if constexpr (!ALIGN_EPI) { if (wr == 0) PG8_BAR; }
    PG8_BAR;
    if constexpr (Epi::AFTER_DRAIN) { E.fused(acc, cur, wr, wc, fr, fq, lds, wid, lane); S.done(cur); }
#undef PG8_SA
#undef PG8_SB
#undef PG8_STAGE
#undef PG8_STAGE_A
#undef PG8_LOADR
#undef PG8_CONV
#undef PG8_LDA
#undef PG8_LDB
#undef PG8_MMA
#undef PG8_WAIT_V
#undef PG8_WAIT_L
#undef PG8_BAR
#undef PG8_SCHED
}
}
namespace mk {
#define GAS __attribute__((address_space(1)))
#define LAS __attribute__((address_space(3)))
typedef unsigned short bf16;
typedef unsigned v4u __attribute__((ext_vector_type(4)));
typedef GAS unsigned gu32;
typedef GAS unsigned long long gu64;
#define RLX_AGENT __ATOMIC_RELAXED, __HIP_MEMORY_SCOPE_AGENT
#define LDS_WAIT() asm volatile("s_waitcnt lgkmcnt(0)" ::: "memory")
#define VM_WAIT() asm volatile("s_waitcnt vmcnt(0)" ::: "memory")
__device__ __forceinline__ unsigned long long rt() { return __builtin_amdgcn_s_memrealtime(); }
__device__ __forceinline__ unsigned f2bf(float f) { unsigned u = __builtin_bit_cast(unsigned, f); return (u + 0x7fffu + ((u >> 16) & 1u)) >> 16; }
__device__ __forceinline__ unsigned pk2(float lo, float hi) { return f2bf(lo) | (f2bf(hi) << 16); }

#define XB_TMO      128
#define XB_XCNT(j)  (256  + 64 * (j))
#define XB_XSUB(j)  (1280 + 64 * (j))
#define XB_XGEN(j)  (2304 + 64 * (j))
#define XB_TOP      3328
#define XB_TOPGEN   3392
#define XCD_BAR_WORDS 3456
#define XB_SPIN_CAP (1u << 20)

__device__ __forceinline__ unsigned xb_ld(unsigned* p)              { return __hip_atomic_load(p, __ATOMIC_RELAXED, __HIP_MEMORY_SCOPE_AGENT); }
__device__ __forceinline__ unsigned xb_add(unsigned* p, unsigned v) { return __hip_atomic_fetch_add(p, v, __ATOMIC_RELAXED, __HIP_MEMORY_SCOPE_AGENT); }
__device__ __forceinline__ unsigned xb_xcc_id() { return (unsigned)__builtin_amdgcn_s_getreg((3 << 11) | 20) & 0xFu; }
#define XB_SPIN(cond, bar) do { unsigned _sp = 0; while (cond) { __builtin_amdgcn_s_sleep(1); \
    if ((++_sp & 255u) == 0u) { if (xb_ld(&(bar)[XB_TMO])) break; if (_sp > XB_SPIN_CAP) { atomicAdd(&(bar)[XB_TMO], 1u); break; } } } } while (0)

struct XcdBarrier {
    unsigned* bar; unsigned x;
    volatile LAS unsigned* st;
};

__device__ __forceinline__ XcdBarrier xcd_barrier_post(unsigned* bar, volatile LAS unsigned* st) {
    XcdBarrier b; b.bar = bar; b.x = xb_xcc_id(); b.st = st;
    if (threadIdx.x == 0) (void)xb_add(&bar[XB_XCNT(b.x)], 1u);
    return b;
}
__device__ __forceinline__ void xcd_barrier_complete(unsigned* bar, unsigned x, unsigned& nloc, unsigned& nx) {
    const unsigned G = gridDim.x * gridDim.y * gridDim.z;
    unsigned sum, cnt, mine, sp = 0u;
    for (;;) {
        sum = 0u; cnt = 0u; mine = 0u;
#pragma unroll
        for (unsigned j = 0; j < 16; ++j) { const unsigned c = xb_ld(&bar[XB_XCNT(j)]); sum += c; cnt += (c > 0u) ? 1u : 0u; mine = (j == x) ? c : mine; }
        if (sum == G) break;
        __builtin_amdgcn_s_sleep(1);
        if ((++sp & 255u) == 0u) { if (xb_ld(&bar[XB_TMO])) break; if (sp > XB_SPIN_CAP) { atomicAdd(&bar[XB_TMO], 1u); break; } }
    }
    nloc = mine > 0u ? mine : 1u; nx = cnt > 0u ? cnt : 1u;
}

__device__ __forceinline__ void xcd_barrier(const XcdBarrier& b) {
    asm volatile("s_waitcnt vmcnt(0)" ::: "memory");
    __syncthreads();
    if (threadIdx.x == 0) {
        unsigned* bar = b.bar;
        __builtin_amdgcn_s_waitcnt(0);
        unsigned nloc = b.st[0], nx = b.st[1];
        if (nloc == 0u) { xcd_barrier_complete(bar, b.x, nloc, nx); b.st[0] = nloc; b.st[1] = nx; }
        const unsigned old = xb_add(&bar[XB_XSUB(b.x)], 1u);
        const unsigned gen = old / nloc;
        if (old + 1u == (gen + 1u) * nloc) {
            __builtin_amdgcn_fence(__ATOMIC_RELEASE, "agent");
            asm volatile("s_waitcnt vmcnt(0)" ::: "memory");
            const unsigned og = xb_add(&bar[XB_TOP], 1u);
            const unsigned tg = og / nx;
            if (og + 1u == (tg + 1u) * nx) xb_add(&bar[XB_TOPGEN], 1u);
            else XB_SPIN(xb_ld(&bar[XB_TOPGEN]) == tg, bar);
            __builtin_amdgcn_fence(__ATOMIC_ACQUIRE, "agent");
            xb_add(&bar[XB_XGEN(b.x)], 1u);
            asm volatile("s_waitcnt vmcnt(0)" ::: "memory");
        } else {
            XB_SPIN(xb_ld(&bar[XB_XGEN(b.x)]) == gen, bar);
            __builtin_amdgcn_fence(__ATOMIC_ACQUIRE, "agent");
            asm volatile("s_waitcnt vmcnt(0)" ::: "memory");
        }
    }
    __syncthreads();
}

}
namespace mk {
using pg8::bf16_t; using pg8::f32x2; using pg8::f32x4; using pg8::u32x4; using pg8::bf2f; using pg8::sigm; using pg8::sigm2; using pg8::cvt_pk_bf16; using pg8::f32x2c_t;
typedef unsigned u32x2 __attribute__((ext_vector_type(2)));
constexpr int NB = 16, SEQ = 4096, CTX = 256, D = 1024, DEPTH = 4, LPB = SEQ + CTX, T = NB * LPB, NTILE = T / 256;
constexpr int NIN = 9760, FFN = 3584, NEXP = 8;
constexpr int LDP = 2560, LDMG = 3072, LDYS = 1536;
constexpr float ALPHA = 1.681792830507429f;
constexpr float LN_EPS = 1e-5f, RMS_EPS = 1e-6f, L2_EPS = 1e-6f;
constexpr float LOG2E = 1.4426950408889634f, LN2 = 0.6931471805599453f;
constexpr int NWAVES = 8, NTHR = 512;

constexpr size_t MiB = 1u << 20;
constexpr size_t WS_CTL = 0, CTL_ZERO_BYTES = 1 * MiB;
constexpr size_t WS_MOD = 1 * MiB;
constexpr int TP = T + 2048;
constexpr size_t WS_ZSTAT = 128 * 1024;
constexpr size_t WS_STAT = 3 * MiB;
constexpr size_t WS_OML = 3 * MiB + 800 * 1024;
constexpr size_t WS_LNID = 3 * MiB + 768 * 1024;
constexpr size_t WS_TOP = 4 * MiB;
constexpr size_t WS_PERM = 5 * MiB + 128 * 1024;
constexpr size_t WS_PERMW = 5 * MiB + 768 * 1024;
constexpr size_t WS_PERMID = 6 * MiB + 384 * 1024;
constexpr size_t WS_SC = 7 * MiB;
constexpr size_t WS_W = 16 * MiB;
constexpr size_t LW_BYTES = 29 * MiB, LW_WB = 20 * MiB, LW_WO = 23 * MiB;
constexpr size_t WS_WFFN = WS_W + 4 * LW_BYTES;
constexpr size_t FFNW_BYTES = 21 * MiB, FFNW_WD = 14 * MiB;
constexpr size_t WS_XS = WS_WFFN + 2 * FFNW_BYTES;
constexpr size_t WS_H = WS_XS + 272 * MiB;
constexpr size_t WS_YS = WS_H + 136 * MiB;
constexpr size_t WS_BIG = WS_YS + 204 * MiB;
constexpr size_t WS_O = WS_BIG + 340 * MiB;
constexpr size_t WS_END = WS_BIG + 490 * MiB;
static_assert(WS_MOD + (size_t)4 * 17 * 6144 * 4 <= WS_STAT && WS_STAT + (size_t)T * 8 <= WS_LNID && WS_ZSTAT + (size_t)T * 8 <= CTL_ZERO_BYTES && (size_t)(4096 + 3456) * 4 <= WS_ZSTAT, "small buffers");
static_assert((size_t)TP * 3584 * 2 <= 490 * MiB && WS_XS == 174 * MiB && (size_t)T * 2560 * 2 == 340 * MiB && (size_t)T * 3584 * 2 == 476 * MiB && (size_t)T * 1024 * 4 == 272 * MiB, "ws map");
constexpr int CW_MOE = 2048;
constexpr int CW_BAR = 4096;

constexpr int RING_BYTES = 131072, LDS_BYTES = 163840, LDSCTL_OFF = LDS_BYTES - 1024;


struct Args { const float* in[24]; float* out; unsigned char* ws; int ph_lo, ph_hi; };
typedef const __attribute__((address_space(4))) Args* KArgs;
__device__ __forceinline__ KArgs fresh_args(KArgs a) { asm volatile("" : "+s"(a)); return a; }
enum { I_X = 0, I_C, I_CTX, I_CCTX, I_WADA, I_BADA, I_WIN, I_CONVW, I_LBRAW, I_MGB, I_ALOG, I_DTB, I_MIXN, I_WBR, I_WOUT, I_LNG, I_LNB, I_FG, I_FU, I_FD, I_ROUTER, I_MG, I_MU, I_MD };

__device__ __forceinline__ int opaque_tid() { int t = threadIdx.x; asm volatile("" : "+v"(t)); return t; }
__device__ __forceinline__ float wave_sum(float v) {
    v += __builtin_bit_cast(float, __builtin_amdgcn_mov_dpp(__builtin_bit_cast(int, v), 0xB1, 0xf, 0xf, false)); v += __builtin_bit_cast(float, __builtin_amdgcn_mov_dpp(__builtin_bit_cast(int, v), 0x4E, 0xf, 0xf, false));
    v += __builtin_bit_cast(float, __builtin_amdgcn_mov_dpp(__builtin_bit_cast(int, v), 0x141, 0xf, 0xf, false)); v += __builtin_bit_cast(float, __builtin_amdgcn_mov_dpp(__builtin_bit_cast(int, v), 0x140, 0xf, 0xf, false));
    const int vi = __builtin_bit_cast(int, v);
    return (__builtin_bit_cast(float, __builtin_amdgcn_readlane(vi, 0)) + __builtin_bit_cast(float, __builtin_amdgcn_readlane(vi, 16))) + (__builtin_bit_cast(float, __builtin_amdgcn_readlane(vi, 32)) + __builtin_bit_cast(float, __builtin_amdgcn_readlane(vi, 48)));
}
__device__ __forceinline__ float silu_f(float x) { return x * sigm(x); }

typedef short v4i16c_t __attribute__((ext_vector_type(4)));
__device__ __forceinline__ void tr_item(const float* colp4, size_t ldw, bf16_t* dst, size_t ldd, LAS unsigned char* scr, int lane, float scale = 1.0f) {
    const int kr = lane >> 3, pc = lane & 7;
    pg8::f32x4 v[8];
#pragma unroll
    for (int j = 0; j < 8; ++j) v[j] = *(const pg8::f32x4*)(colp4 + (size_t)(kr + 8 * j) * ldw);
#pragma unroll
    for (int j = 0; j < 8; ++j) { const pg8::f32x4 x = v[j] * scale; u32x2 w; w.x = cvt_pk_bf16(x[0], x[1]); w.y = cvt_pk_bf16(x[2], x[3]); *(LAS u32x2*)(scr + (kr + 8 * j) * 64 + pc * 8) = w; }
    asm volatile("" ::: "memory");
    const int i = lane & 15, gq = lane >> 4, nh = gq & 1;
    const LAS unsigned char* rb = scr + (i >> 2) * 64 + nh * 32 + (i & 3) * 8;
#pragma unroll
    for (int j = 0; j < 4; ++j) { const int c = (gq >> 1) + 2 * j;
        const v4i16c_t lo = __builtin_amdgcn_ds_read_tr16_b64_v4i16((LAS v4i16c_t*)(rb + (8 * c) * 64)), hi = __builtin_amdgcn_ds_read_tr16_b64_v4i16((LAS v4i16c_t*)(rb + (8 * c + 4) * 64));
        v4u o; o.x = (unsigned)(unsigned short)lo[0] | ((unsigned)(unsigned short)lo[1] << 16); o.y = (unsigned)(unsigned short)lo[2] | ((unsigned)(unsigned short)lo[3] << 16);
        o.z = (unsigned)(unsigned short)hi[0] | ((unsigned)(unsigned short)hi[1] << 16); o.w = (unsigned)(unsigned short)hi[2] | ((unsigned)(unsigned short)hi[3] << 16);
        *(v4u*)(dst + (size_t)(16 * nh + i) * ldd + 8 * c) = o; }
    asm volatile("" ::: "memory");
}
__device__ __forceinline__ int win_col(int r) {
    if (r < 4608) return r;
    if (r < 4864) { const int rr = r - 4608; return rr < 16 ? 4608 + rr : (rr < 32 ? 6672 + (rr - 16) : -1); }
    if (r < 6912) return 4624 + (r - 4864);
    return 6688 + (r - 6912);
}
constexpr int IT_WIN = 16 * 312, IT_WB = 3 * 8 * 32, IT_WO = 16 * 32, IT_LAYER = IT_WIN + IT_WB + IT_WO;
constexpr int IT_GU = 16 * 224, IT_DN = 56 * 32, IT_FFN = IT_GU + IT_DN;
__device__ __forceinline__ void conv_ffn_item(const float* wg, const float* wu, const float* wd, bf16_t* gu_t, bf16_t* dn_t, int r, LAS unsigned char* scr, int lane) {
    const int ln = 4 * (lane & 7);
    if (r < IT_GU) { const int kb = r / 224, nb = r % 224, k0 = 64 * kb, r0 = 32 * nb, tile = r0 >> 8, within = r0 & 255;
        const float* src = (within < 128) ? wg + (size_t)k0 * FFN + tile * 128 + within + ln : wu + (size_t)k0 * FFN + tile * 128 + (within - 128) + ln;
        tr_item(src, FFN, gu_t + (size_t)r0 * D + k0, D, scr, lane, within < 128 ? LOG2E : LN2); return; }
    r -= IT_GU;
    { const int kb = r / 32, nb = r % 32, k0 = 64 * kb, n0 = 32 * nb;
        tr_item(wd + (size_t)k0 * D + n0 + ln, D, dn_t + (size_t)n0 * FFN + k0, FFN, scr, lane); }
}
__device__ __forceinline__ void conv_layer_item(KArgs a, int l, int r, LAS unsigned char* scr, int lane) {
    a = fresh_args(a);
    unsigned char* lw = a->ws + WS_W + (size_t)l * LW_BYTES; const int ln = 4 * (lane & 7);
    if (r < IT_WIN) { const int kb = r / 312, nb = r % 312, k0 = 64 * kb, col = win_col((nb >> 3) * 256 + 64 * (nb & 3) + 32 * ((nb >> 2) & 1) + ln);
        const float* src = a->in[I_WIN] + ((size_t)l * D + k0) * NIN + (col >= 0 ? col : 0);
        const int lc = (nb >> 3) * 256 + 64 * (nb & 3) + 32 * ((nb >> 2) & 1);
        tr_item(src, NIN, (bf16_t*)lw + (size_t)(32 * nb) * D + k0, D, scr, lane, col < 0 ? 0.0f : (((lc >= 512 && lc < 1536) || lc >= 6912) ? LOG2E : 1.0f)); return; }
    r -= IT_WIN;
    if (r < IT_WB) { const int n = r / 256, rem = r % 256, kb = rem / 32, nb = rem % 32, k0 = 64 * kb, n0 = 32 * nb;
        const int lc0 = (nb >> 3) * 256 + 64 * (nb & 3) + 32 * ((nb >> 2) & 1);
        tr_item(a->in[I_WBR] + ((size_t)(l * 3 + n) * 512 + k0) * D + lc0 + ln, D, (bf16_t*)(lw + LW_WB) + (size_t)n0 * 1536 + n * 512 + k0, 1536, scr, lane); return; }
    r -= IT_WB;
    { const int kb = r / 32, nb = r % 32, k0 = 64 * kb, n0 = 32 * nb;
        tr_item(a->in[I_WOUT] + ((size_t)l * D + k0) * D + n0 + ln, D, (bf16_t*)(lw + LW_WO) + (size_t)n0 * D + k0, D, scr, lane); }
}

__device__ __forceinline__ void pro_a(KArgs a, LAS unsigned char* lds) {
    a = fresh_args(a);
    const int tid = opaque_tid(), lane = tid & 63, wave = __builtin_amdgcn_readfirstlane(tid >> 6), G = gridDim.x;
    LAS float* s_lds = (LAS float*)lds;
    LAS float* red = s_lds + 17 * 1024;
    for (int i = tid; i < 17 * 1024; i += NTHR) { const int mi = i >> 10, k = i & 1023; const float c = mi < 16 ? a->in[I_C][mi * 1024 + k] : a->in[I_CCTX][k]; s_lds[i] = silu_f(c); }
    __syncthreads();
    float* MOD = (float*)(a->ws + WS_MOD);
    { int* pid = (int*)(a->ws + WS_PERMID); for (int i = blockIdx.x * NTHR + tid; i < T; i += G * NTHR) pid[i] = i; }
    if (blockIdx.x == 1) { float* om = (float*)(a->ws + WS_OML); const float* lr = a->in[I_LBRAW];
        for (int cc = tid; cc < 512; cc += NTHR) { const float r0 = lr[cc], r1 = lr[512 + cc], r2 = lr[1024 + cc], r3 = lr[1536 + cc]; const float mx = fmaxf(fmaxf(r0, r1), fmaxf(r2, r3));
            const float e0 = __expf(r0 - mx), e1 = __expf(r1 - mx), e2 = __expf(r2 - mx), e3 = __expf(r3 - mx), inv = 1.0f / (e0 + e1 + e2 + e3);
            om[cc] = 1.0f; om[512 + cc] = 1.0f - e1 * inv; om[1024 + cc] = 1.0f - (e1 + e2) * inv; om[1536 + cc] = 1.0f - (e1 + e2 + e3) * inv; } }
    if (blockIdx.x == 0) { float* id = (float*)(a->ws + WS_LNID); for (int i = tid; i < 2048; i += NTHR) id[i] = i < 1024 ? 1.0f : 0.0f; }
    for (int it = blockIdx.x; it < DEPTH * 96; it += G) {
        const int l = it / 96, jg = it % 96;
        const float* wp = a->in[I_WADA] + ((size_t)l * D + wave * 128) * 6144 + jg * 64 + lane;
        float acc[17];
#pragma unroll
        for (int mi = 0; mi < 17; ++mi) acc[mi] = 0.f;
        for (int k = 0; k < 128; k += 4) {
            const float w0 = wp[(size_t)(k + 0) * 6144], w1 = wp[(size_t)(k + 1) * 6144], w2 = wp[(size_t)(k + 2) * 6144], w3 = wp[(size_t)(k + 3) * 6144];
#pragma unroll
            for (int mi = 0; mi < 17; ++mi) { const f32x4 sv = *(const LAS f32x4*)(s_lds + mi * 1024 + wave * 128 + k); acc[mi] += sv[0] * w0 + sv[1] * w1 + sv[2] * w2 + sv[3] * w3; }
        }
#pragma unroll
        for (int mi = 0; mi < 17; ++mi) red[(wave * 17 + mi) * 64 + lane] = acc[mi];
        __syncthreads();
        for (int i = tid; i < 17 * 64; i += NTHR) { const int mi = i >> 6, ln = i & 63; float s = a->in[I_BADA][l * 6144 + jg * 64 + ln];
#pragma unroll
            for (int w = 0; w < 8; ++w) s += red[(w * 17 + mi) * 64 + ln];
            MOD[(size_t)(l * 17 + mi) * 6144 + jg * 64 + ln] = s; }
        __syncthreads();
    }
    __syncthreads();
    LAS unsigned char* scr = lds + wave * 16384;
    const int gw = blockIdx.x * NWAVES + wave, NGW = G * NWAVES;
    constexpr int NITEMS = DEPTH * IT_LAYER + 2 * IT_FFN;
    for (int it = gw; it < NITEMS; it += NGW) {
        if (it < DEPTH * IT_LAYER) { conv_layer_item(a, it / IT_LAYER, it % IT_LAYER, scr, lane); continue; }
        const int r = it - DEPTH * IT_LAYER, i = r / IT_FFN;
        unsigned char* fw = a->ws + WS_WFFN + (size_t)i * FFNW_BYTES;
        conv_ffn_item(a->in[I_FG] + (size_t)i * D * FFN, a->in[I_FU] + (size_t)i * D * FFN, a->in[I_FD] + (size_t)i * FFN * D, (bf16_t*)fw, (bf16_t*)(fw + FFNW_WD), r % IT_FFN, scr, lane);
    }
}
__device__ __forceinline__ void conv_moe(KArgs a, int i, LAS unsigned char* lds) {
    a = fresh_args(a);
    const int tid = opaque_tid(), lane = tid & 63, wave = __builtin_amdgcn_readfirstlane(tid >> 6), G = gridDim.x;
    LAS unsigned char* scr = lds + wave * 16384;
    const int gw = blockIdx.x * NWAVES + wave, NGW = G * NWAVES;
    for (int it = gw; it < NEXP * IT_FFN; it += NGW) {
        const int e = it / IT_FFN; const size_t eo = (size_t)(i * NEXP + e) * D * FFN;
        unsigned char* fw = a->ws + WS_YS + (size_t)e * FFNW_BYTES;
        conv_ffn_item(a->in[I_MG] + eo, a->in[I_MU] + eo, a->in[I_MD] + eo, (bf16_t*)fw, (bf16_t*)(fw + FFNW_WD), it % IT_FFN, scr, lane);
    }
}

template <int MODE> __device__ __forceinline__ void rowpass(KArgs a, int l, LAS unsigned char* lds, int part = 0, int wg0 = 0, int lim = 0) {
    a = fresh_args(a);
    const int tid = opaque_tid(), lane = tid & 63, wave = __builtin_amdgcn_readfirstlane(tid >> 6), G = gridDim.x;
    const float* MOD = (const float*)(a->ws + WS_MOD);
    float* XS = (float*)(a->ws + WS_XS); bf16_t* H = (bf16_t*)(a->ws + WS_H); float* TOP = (float*)(a->ws + WS_TOP);
    LAS float* wr = (LAS float*)lds;
    LAS unsigned* hist = (LAS unsigned*)(lds + 32768);
    const bool moe = (MODE == 1) && (l & 1);
    if (moe) { const float* r = a->in[I_ROUTER] + (size_t)(l >> 1) * D * NEXP;
        for (int i = tid; i < D * NEXP; i += NTHR) { const int k = i >> 3, e = i & 7; wr[e * 1024 + k] = r[i]; }
        if (tid < 16) hist[tid] = 0u;
        __syncthreads(); }
    const int gw = ((int)blockIdx.x - wg0) * NWAVES + wave, NGW = (G - wg0) * NWAVES;
    const int lh = (MODE == 2) ? l + 1 : l, si = (MODE == 1) ? 3 : 0;
    pg8::StaticOrder SO; SO.init(T, D, G, 0);
    f32x4 lng4[4], lnb4[4];
    if (MODE != 0) { const float* gp0 = a->in[I_LNG] + (size_t)(l * 2 + (MODE - 1)) * D; const float* bp0 = a->in[I_LNB] + (size_t)(l * 2 + (MODE - 1)) * D;
#pragma unroll
        for (int j = 0; j < 4; ++j) { lng4[j] = ((const f32x4*)gp0)[lane + 64 * j]; lnb4[j] = ((const f32x4*)bp0)[lane + 64 * j]; } }
    auto accepted = [&](int row_) -> bool {
        if (part) { const int pm = row_ >> 8; const bool late = SO.pos_of(pm, 0) >= lim || SO.pos_of(pm, 1) >= lim || SO.pos_of(pm, 2) >= lim || SO.pos_of(pm, 3) >= lim; if (late != (part == 2)) return false; }
        if (MODE != 0 && l == DEPTH - 1 && (row_ % LPB) < CTX) return false;
        return true; };
    auto row_src = [&](int row_) -> const float* { const int b_ = row_ / LPB, p_ = row_ - b_ * LPB;
        return (MODE == 0) ? (p_ < CTX ? a->in[I_CTX] + ((size_t)b_ * CTX + p_) * D : a->in[I_X] + ((size_t)b_ * SEQ + (p_ - CTX)) * D) : XS + (size_t)row_ * D; };
    int nrow = gw; while (nrow < T && !accepted(nrow)) nrow += NGW;
    f32x4 vn[4];
    if (nrow < T) { const float* s0 = row_src(nrow);
#pragma unroll
        for (int j = 0; j < 4; ++j) vn[j] = ((const f32x4*)s0)[lane + 64 * j]; }
    while (nrow < T) {
        const int row = nrow;
        const int b = row / LPB, p = row - b * LPB; const bool isctx = p < CTX; const int mi = isctx ? 16 : b;
        f32x4 v[4], sc4[4], sh4[4];
        { const float* shp = MOD + (size_t)(lh * 17 + mi) * 6144 + si * 1024; const float* scp = shp + 1024;
#pragma unroll
            for (int j = 0; j < 4; ++j) { sc4[j] = ((const f32x4*)scp)[lane + 64 * j]; sh4[j] = ((const f32x4*)shp)[lane + 64 * j]; } }
#pragma unroll
        for (int j = 0; j < 4; ++j) v[j] = vn[j];
        nrow += NGW; while (nrow < T && !accepted(nrow)) nrow += NGW;
        if (nrow < T) { const float* s1 = row_src(nrow);
#pragma unroll
            for (int j = 0; j < 4; ++j) vn[j] = ((const f32x4*)s1)[lane + 64 * j]; }
        if (MODE != 0) {
            float s = 0.f;
#pragma unroll
            for (int j = 0; j < 4; ++j) s += (v[j][0] + v[j][1]) + (v[j][2] + v[j][3]);
            const float mean = wave_sum(s) * (1.f / D); float s2 = 0.f;
#pragma unroll
            for (int j = 0; j < 4; ++j) { v[j] = v[j] - mean; s2 += (v[j][0] * v[j][0] + v[j][1] * v[j][1]) + (v[j][2] * v[j][2] + v[j][3] * v[j][3]); }
            const float rstd = 1.0f / sqrtf(wave_sum(s2) * (1.f / D) + LN_EPS);
            if (lane == 0 && !(MODE == 2 && l == DEPTH - 1)) *(f32x2*)((float*)(a->ws + WS_STAT) + (size_t)row * 2) = (f32x2){mean, rstd - 1.0f};
#pragma unroll
            for (int j = 0; j < 4; ++j) v[j] = v[j] * rstd * lng4[j] + lnb4[j];
        }
        if (MODE == 2 && l == DEPTH - 1) {
            if (!isctx) { f32x4* o = (f32x4*)(a->out + ((size_t)b * SEQ + (p - CTX)) * D);
#pragma unroll
                for (int j = 0; j < 4; ++j) o[lane + 64 * j] = v[j]; }
            continue;
        }
        float s = 0.f;
#pragma unroll
        for (int j = 0; j < 4; ++j) s += (v[j][0] + v[j][1]) + (v[j][2] + v[j][3]);
        const float mean = wave_sum(s) * (1.f / D); float s2 = 0.f;
#pragma unroll
        for (int j = 0; j < 4; ++j) { v[j] = v[j] - mean; s2 += (v[j][0] * v[j][0] + v[j][1] * v[j][1]) + (v[j][2] * v[j][2] + v[j][3] * v[j][3]); }
        const float rstd = 1.0f / sqrtf(wave_sum(s2) * (1.f / D) + LN_EPS);
#pragma unroll
        for (int j = 0; j < 4; ++j) { const f32x4 sc = sc4[j], sh = sh4[j];
            v[j] = v[j] * rstd * (sc + 1.0f) + sh;
            u32x2 w; w.x = cvt_pk_bf16(v[j][0], v[j][1]); w.y = cvt_pk_bf16(v[j][2], v[j][3]);
            ((u32x2*)(H + (size_t)row * D))[lane + 64 * j] = w; }
        if (moe) {
            float lg[8];
#pragma unroll
            for (int e = 0; e < 8; ++e) { float t = 0.f;
#pragma unroll
                for (int j = 0; j < 4; ++j) { const f32x4 w4 = *(const LAS f32x4*)(wr + e * 1024 + 4 * (lane + 64 * j)); t += v[j][0] * w4[0] + v[j][1] * w4[1] + v[j][2] * w4[2] + v[j][3] * w4[3]; }
                lg[e] = wave_sum(t); }
            int i1 = 0; float v1 = lg[0];
#pragma unroll
            for (int e = 1; e < 8; ++e) if (lg[e] > v1) { v1 = lg[e]; i1 = e; }
            int i2 = -1; float v2 = -3.0e38f;
#pragma unroll
            for (int e = 0; e < 8; ++e) if (e != i1 && lg[e] > v2) { v2 = lg[e]; i2 = e; }
            const float p1 = 1.0f / (1.0f + __expf(v2 - v1)), p2 = 1.0f - p1;
            if (lane == 0) { TOP[(size_t)row * 4 + 0] = p1; TOP[(size_t)row * 4 + 1] = p2; TOP[(size_t)row * 4 + 2] = __uint_as_float((unsigned)i1 | ((unsigned)i2 << 8));
                __hip_atomic_fetch_add(hist + i1, 1u, __ATOMIC_RELAXED, __HIP_MEMORY_SCOPE_WORKGROUP); __hip_atomic_fetch_add(hist + 8 + i2, 1u, __ATOMIC_RELAXED, __HIP_MEMORY_SCOPE_WORKGROUP); }
        }
    }
    if (moe) { __syncthreads(); if (tid < 16) { const unsigned hv = hist[tid]; if (hv) __hip_atomic_fetch_add((unsigned*)(a->ws + WS_CTL) + CW_MOE + 32 * (l >> 1) + tid, hv, __ATOMIC_RELAXED, __HIP_MEMORY_SCOPE_AGENT); } }
}

__device__ __forceinline__ void moe_tile_starts(KArgs a, int i, int s, int (&ts)[9]) {
    const unsigned* cnt = (const unsigned*)(a->ws + WS_CTL) + CW_MOE + 32 * i + 8 * s; int acc = 0;
#pragma unroll
    for (int e = 0; e < 8; ++e) { ts[e] = acc; acc += (int)((__hip_atomic_load(cnt + e, __ATOMIC_RELAXED, __HIP_MEMORY_SCOPE_AGENT) + 255u) >> 8); }
    ts[8] = acc;
}
__device__ __forceinline__ void moe_fill(KArgs a, int i, int skipctx) {
    a = fresh_args(a);
    const int tid = opaque_tid(), lane = tid & 63, wave = __builtin_amdgcn_readfirstlane(tid >> 6), G = gridDim.x;
    unsigned* ctl = (unsigned*)(a->ws + WS_CTL) + CW_MOE + 32 * i;
    const float* TOP = (const float*)(a->ws + WS_TOP); int* PERM = (int*)(a->ws + WS_PERM); float* PERMW = (float*)(a->ws + WS_PERMW);
    int ts0[9], ts1[9]; moe_tile_starts(a, i, 0, ts0); moe_tile_starts(a, i, 1, ts1);
    const int gw = blockIdx.x * NWAVES + wave, NGW = G * NWAVES;
    for (int base = gw * 64; base < T; base += NGW * 64) {
        const int row = base + lane; const unsigned bits = __float_as_uint(TOP[(size_t)row * 4 + 2]);
        const float p1 = TOP[(size_t)row * 4 + 0], p2 = TOP[(size_t)row * 4 + 1];
        const bool dead = skipctx && (row % LPB) < CTX;
        const int mine0 = dead ? -1 : (int)(bits & 255u), mine1 = dead ? -1 : (int)(bits >> 8) & 255;
        unsigned long long m[16]; unsigned cntj = 0u;
#pragma unroll
        for (int j = 0; j < 16; ++j) { m[j] = __ballot((j < 8 ? mine0 : mine1) == (j & 7)); if (lane == j) cntj = (unsigned)__popcll(m[j]); }
        unsigned b0j = 0u;
        if (lane < 16 && cntj) b0j = __hip_atomic_fetch_add(ctl + 16 + lane, cntj, __ATOMIC_RELAXED, __HIP_MEMORY_SCOPE_AGENT);
        const unsigned long long below = (1ull << lane) - 1ull;
        int pos0 = 0, pos1 = 0;
#pragma unroll
        for (int j = 0; j < 16; ++j) { const int bj = __builtin_amdgcn_readlane((int)b0j, j), pj = (j < 8 ? ts0[j & 7] : ts1[j & 7]) * 256 + bj + __popcll(m[j] & below);
            if (j < 8) { if (mine0 == j) pos0 = pj; } else { if (mine1 == (j & 7)) pos1 = pj; } }
        if (!dead) { PERM[pos0] = row; PERMW[pos0] = p1; PERM[(size_t)TP + pos1] = row; PERMW[(size_t)TP + pos1] = p2; }
    }
    if (blockIdx.x < 16) { const int s = blockIdx.x >> 3, e = blockIdx.x & 7;
        const int cnt = (int)__hip_atomic_load(ctl + 8 * s + e, __ATOMIC_RELAXED, __HIP_MEMORY_SCOPE_AGENT), pad = ((cnt + 255) & ~255); int t0 = 0;
#pragma unroll
        for (int j = 0; j < 8; ++j) if (j == e) t0 = (s ? ts1[j] : ts0[j]) * 256;
        for (int p = cnt + tid; p < pad; p += NTHR) { PERM[(size_t)s * TP + t0 + p] = -1; PERMW[(size_t)s * TP + t0 + p] = 0.f; } }
}

__device__ __forceinline__ int pos_of_step(int st, int dir, bool colmajor) {
    if (st < CTX) return dir ? (CTX - 1 - st) : st;
    int u = st - CTX; if (dir) u = SEQ - 1 - u;
    if (colmajor) u = (u & 63) * 64 + (u >> 6);
    return CTX + u;
}
template <int CTRL> __device__ __forceinline__ float dpp_f(float v) { return __builtin_bit_cast(float, __builtin_amdgcn_mov_dpp(__builtin_bit_cast(int, v), CTRL, 0xf, 0xf, false)); }
__device__ __forceinline__ float red8(float v) { v += dpp_f<0xB1>(v); v += dpp_f<0x4E>(v); v += dpp_f<0x141>(v); return v; }
__device__ __forceinline__ float red16(float v) { v = red8(v); v += dpp_f<0x140>(v); return v; }
template <int CTRL, int RMASK> __device__ __forceinline__ float dpp_upd(float idv, float v) { return __builtin_bit_cast(float, __builtin_amdgcn_update_dpp(__builtin_bit_cast(int, idv), __builtin_bit_cast(int, v), CTRL, RMASK, 0xf, false)); }
__device__ __forceinline__ float wave_scan_add(float v) {
    v += dpp_upd<0x111, 0xf>(0.f, v); v += dpp_upd<0x112, 0xf>(0.f, v); v += dpp_upd<0x114, 0xf>(0.f, v); v += dpp_upd<0x118, 0xf>(0.f, v); v += dpp_upd<0x142, 0xa>(0.f, v); v += dpp_upd<0x143, 0xc>(0.f, v); return v; }
__device__ __forceinline__ float wave_scan_max(float v) { const float ni = -__builtin_inff();
    v = fmaxf(v, dpp_upd<0x111, 0xf>(ni, v)); v = fmaxf(v, dpp_upd<0x112, 0xf>(ni, v)); v = fmaxf(v, dpp_upd<0x114, 0xf>(ni, v)); v = fmaxf(v, dpp_upd<0x118, 0xf>(ni, v)); v = fmaxf(v, dpp_upd<0x142, 0xa>(ni, v)); v = fmaxf(v, dpp_upd<0x143, 0xc>(ni, v)); return v; }
__device__ __forceinline__ float lane63(float v) { return __builtin_bit_cast(float, __builtin_amdgcn_readlane(__builtin_bit_cast(int, v), 63)); }
__device__ __forceinline__ f32x4 ld_bf16x4(const bf16_t* p) { const u32x2 w = *(const u32x2*)p; return (f32x4){__uint_as_float(w.x << 16), __uint_as_float(w.x & 0xffff0000u), __uint_as_float(w.y << 16), __uint_as_float(w.y & 0xffff0000u)}; }

__device__ __forceinline__ void lds_barrier() { asm volatile("s_waitcnt lgkmcnt(0)" ::: "memory"); __builtin_amdgcn_s_barrier(); asm volatile("" ::: "memory"); }
typedef short bf16x8_t __attribute__((ext_vector_type(8)));
#define MFMA16(a, b, c) __builtin_amdgcn_mfma_f32_16x16x32_bf16((a), (b), (c), 0, 0, 0)
__device__ __forceinline__ bf16x8_t ldfrag(const LAS unsigned char* base, int stride, int row, int col) { return *(const LAS bf16x8_t*)(base + row * stride + col * 2); }
__device__ __forceinline__ unsigned short f2bf16(float f) { return (unsigned short)(cvt_pk_bf16(f, 0.f) & 0xffffu); }
constexpr int RS = 272, TS = 144;
constexpr int NCHUNK = LPB / 64;

constexpr int SCW_PITCH = 2064;
__device__ __forceinline__ void sc_stage_w(const bf16_t* W32, LAS unsigned char* lds, int tid) {
    for (int i = tid; i < 32 * 128; i += NTHR) { const int n = i >> 7, c16 = i & 127; *(LAS u32x4*)(lds + n * SCW_PITCH + c16 * 16) = *(const u32x4*)(W32 + (size_t)n * D + c16 * 8); }
}
__device__ __forceinline__ void sc_unit(const bf16_t* Hm, const LAS unsigned char* wl, float* SCo, int u, int wave, int lane) {
    const int r = lane & 15, q = lane >> 4;
    const bf16_t* ap = Hm + (size_t)(u * 256 + wave * 32 + r) * D + q * 8;
    const LAS unsigned char* bl = wl + r * SCW_PITCH + q * 16;
    f32x4 acc[2][2];
#pragma unroll
    for (int i = 0; i < 2; ++i)
#pragma unroll
        for (int j = 0; j < 2; ++j) acc[i][j] = (f32x4){0.f, 0.f, 0.f, 0.f};
    bf16x8_t an[8];
#pragma unroll
    for (int j = 0; j < 4; ++j) { an[2 * j] = *(const bf16x8_t*)(ap + j * 32); an[2 * j + 1] = *(const bf16x8_t*)(ap + (size_t)16 * D + j * 32); }
#pragma unroll 1
    for (int kb = 0; kb < 8; ++kb) {
        bf16x8_t ac[8];
#pragma unroll
        for (int j = 0; j < 8; ++j) ac[j] = an[j];
        if (kb + 1 < 8) {
#pragma unroll
            for (int j = 0; j < 4; ++j) { an[2 * j] = *(const bf16x8_t*)(ap + (kb + 1) * 128 + j * 32); an[2 * j + 1] = *(const bf16x8_t*)(ap + (size_t)16 * D + (kb + 1) * 128 + j * 32); } }
#pragma unroll
        for (int j = 0; j < 4; ++j) { const int ks = kb * 4 + j;
            const bf16x8_t b0 = *(const LAS bf16x8_t*)(bl + ks * 64), b1 = *(const LAS bf16x8_t*)(bl + 16 * SCW_PITCH + ks * 64);
            acc[0][0] = MFMA16(b0, ac[2 * j], acc[0][0]); acc[0][1] = MFMA16(b1, ac[2 * j], acc[0][1]); acc[1][0] = MFMA16(b0, ac[2 * j + 1], acc[1][0]); acc[1][1] = MFMA16(b1, ac[2 * j + 1], acc[1][1]); }
    }
#pragma unroll
    for (int rt = 0; rt < 2; ++rt)
#pragma unroll
        for (int ct = 0; ct < 2; ++ct) *(f32x4*)(SCo + (size_t)(u * 256 + wave * 32 + 16 * rt + r) * 32 + 16 * ct + 4 * q) = acc[rt][ct];
}

constexpr int RK = 336;
constexpr int SA_QTG = 0, SA_KT = SA_QTG + 128 * 336, SA_KD = SA_KT + 128 * 336, SA_VT = SA_KD + 128 * TS, SA_AB = SA_VT + 64 * RK, SA_SB = SA_AB + 64 * TS, SA_TOT = SA_SB + 64 * RS, SA_DL = SA_TOT + 2048, SA_END = SA_DL + 512;
static_assert(SA_END <= LDSCTL_OFF, "scan A images vs LDS");
typedef short v4i16_t __attribute__((ext_vector_type(4)));
__device__ __forceinline__ v4i16_t tr4(const LAS unsigned char* base, int pitch, int row0, int col0, int r) {
    return __builtin_amdgcn_ds_read_tr16_b64_v4i16((LAS v4i16_t*)(base + (row0 + (r >> 2)) * pitch + (col0 + 4 * (r & 3)) * 2)); }
__device__ __forceinline__ bf16x8_t trfrag(const LAS unsigned char* base, int pitch, int col0, int ch0, int r, int q) {
    const v4i16_t lo = tr4(base, pitch, ch0 + 8 * q, col0, r), hi = tr4(base, pitch, ch0 + 8 * q + 4, col0, r);
    return (bf16x8_t){lo[0], lo[1], lo[2], lo[3], hi[0], hi[1], hi[2], hi[3]}; }
__device__ __forceinline__ void scanA_mfma(KArgs a, int l, LAS unsigned char* lds) {
    a = fresh_args(a);
    const int tid = opaque_tid(), lane = tid & 63, w = __builtin_amdgcn_readfirstlane(tid >> 6), r = lane & 15, q = lane >> 4;
    const bf16_t* P = (const bf16_t*)(a->ws + WS_BIG); bf16_t* O = (bf16_t*)(a->ws + WS_O);
    const int c = tid & 127, sb = __builtin_amdgcn_readfirstlane(tid >> 7);
    const int vtok = tid >> 3, v8 = (tid & 7) * 8;
    LAS float* TOT = (LAS float*)(lds + SA_TOT); LAS float* DL = (LAS float*)(lds + SA_DL);
    const int kbase = (sb == 0) ? 0 : (sb == 1 ? 16 : (sb == 2 ? 48 : 96));
    for (int it = blockIdx.x; it < 256; it += gridDim.x) {
        const int vh = it & 1, dir = (it >> 1) & 1, h = (it >> 2) & 3, b = it >> 4;
        __syncthreads();
        for (int i = tid; i < (SA_TOT - SA_AB) / 4; i += NTHR) ((LAS unsigned*)(lds + SA_AB))[i] = 0u;
        f32x4 Sacc[4];
#pragma unroll
        for (int i = 0; i < 4; ++i) Sacc[i] = (f32x4){0.f, 0.f, 0.f, 0.f};
        u32x4 qst[2], fst[2], vraw;
#define SA_LOAD(n) do { _Pragma("unroll") for (int k = 0; k < 2; ++k) { const int pi = tid + 512 * k; const bf16_t* pr = P + (size_t)(b * LPB + pos_of_step((n) * 64 + (pi >> 4), dir, false)) * LDP + h * 128 + 8 * (pi & 15); \
                qst[k] = *(const u32x4*)pr; fst[k] = *(const u32x4*)(pr + (1 + dir) * 512); } \
            vraw = *(const u32x4*)(P + (size_t)(b * LPB + pos_of_step((n) * 64 + vtok, dir, false)) * LDP + 1536 + h * 128 + vh * 64 + v8); } while (0)
#define SA_STAGE() do { _Pragma("unroll") for (int k = 0; k < 2; ++k) { const int pi = tid + 512 * k; LAS unsigned char* sp_ = lds + SA_KT + (pi >> 4) * RK + (pi & 15) * 16; \
                *(LAS u32x4*)sp_ = qst[k]; *(LAS u32x4*)(sp_ + 64 * RK) = fst[k]; } } while (0)
        SA_LOAD(0);
        SA_STAGE();
        lds_barrier();
        for (int n = 0; n < NCHUNK; ++n) {
            float cp[16], sp[16], kk[16], qv[16], fv[16]; float run = 1.f;
            unsigned short qraw[16], fraw[16];
#pragma unroll
            for (int g4 = 0; g4 < 4; ++g4) { const v4i16_t qq = tr4(lds + SA_KT, RK, sb * 16 + 4 * g4, c & ~15, lane & 15), ff = tr4(lds + SA_KT + 64 * RK, RK, sb * 16 + 4 * g4, c & ~15, lane & 15);
#pragma unroll
                for (int j = 0; j < 4; ++j) { qraw[4 * g4 + j] = (unsigned short)qq[j]; fraw[4 * g4 + j] = (unsigned short)ff[j]; } }
#pragma unroll
            for (int tt = 0; tt < 16; tt += 2) { const float k0 = bf2f(fraw[tt]), k1 = bf2f(fraw[tt + 1]);
                const float f0 = fmaxf(1.0f - k0, 1e-30f), f1 = fmaxf(1.0f - k1, 1e-30f);
                run *= f0; cp[tt] = run; kk[tt] = k0; fv[tt] = f0; qv[tt] = bf2f(qraw[tt]); run *= f1; cp[tt + 1] = run; kk[tt + 1] = k1; fv[tt + 1] = f1; qv[tt + 1] = bf2f(qraw[tt + 1]); }
            { float suf = 1.f;
#pragma unroll
                for (int tt = 15; tt >= 0; --tt) { sp[tt] = suf; suf *= fv[tt]; } }
            TOT[sb * 128 + c] = run;
            *(LAS u32x4*)(lds + SA_VT + vtok * RK + v8 * 2) = vraw;
            lds_barrier();
            const float t0 = TOT[c], t1 = TOT[128 + c], t2 = TOT[256 + c], t3 = TOT[384 + c];
            const float egref = (sb >= 1 ? t0 : 1.f) * (sb >= 2 ? t1 : 1.f) * (sb >= 3 ? t2 : 1.f);
            const float ekd = (sb <= 0 ? t1 : 1.f) * (sb <= 1 ? t2 : 1.f) * (sb <= 2 ? t3 : 1.f);
            const float f1 = 1.0f, f2 = (sb == 0 ? t1 : (sb == 1 ? t2 : 1.f)), f3 = (sb == 0 ? t1 * t2 : 1.f);
            if (sb == 0) DL[c] = (t0 * t1) * (t2 * t3);
            if (n + 1 < NCHUNK) SA_LOAD(n + 1);
            { unsigned qtp[8], qgp[8], kop[8], bap[8], b2p[8], b3p[8], kdp[8]; const float rrun = fminf(__builtin_amdgcn_rcpf(run), 5.5e34f);
#pragma unroll
                for (int tp = 0; tp < 8; ++tp) { const int t0 = 2 * tp;
                    const f32x2c_t cpv = {cp[t0], cp[t0 + 1]}, kkv = {kk[t0], kk[t0 + 1]}, spv = {sp[t0], sp[t0 + 1]}, qvv = {qv[t0], qv[t0 + 1]};
                    const f32x2c_t icp = spv * rrun;
                    const f32x2c_t qt = qvv * cpv, qg = qt * egref, kown = kkv * icp, base = kkv * spv, kd = base * ekd;
                    qtp[tp] = cvt_pk_bf16(qt[0], qt[1]); qgp[tp] = cvt_pk_bf16(qg[0], qg[1]); kop[tp] = cvt_pk_bf16(kown[0], kown[1]); kdp[tp] = cvt_pk_bf16(kd[0], kd[1]);
                    if (sb <= 2) bap[tp] = cvt_pk_bf16(base[0], base[1]);
                    if (sb <= 1) { const f32x2c_t b2 = base * f2; b2p[tp] = cvt_pk_bf16(b2[0], b2[1]); }
                    if (sb == 0) { const f32x2c_t b3 = base * f3; b3p[tp] = cvt_pk_bf16(b3[0], b3[1]); }
                }
#define ST16(addr_, x_) do { LAS u32x4* p_ = (LAS u32x4*)(addr_); p_[0] = (u32x4){x_[0], x_[1], x_[2], x_[3]}; p_[1] = (u32x4){x_[4], x_[5], x_[6], x_[7]}; } while (0)
                LAS unsigned char* rq = lds + SA_QTG + c * 336; LAS unsigned char* rk = lds + SA_KT + c * 336;
                ST16(rq + sb * 32, qtp); ST16(rq + 128 + sb * 32, qgp); ST16(rk + (kbase + sb * 16) * 2, kop);
                if (sb == 0) { ST16(rk + 16 * 2, bap); ST16(rk + 48 * 2, b2p); ST16(rk + 96 * 2, b3p); }
                if (sb == 1) { ST16(rk + (48 + 16) * 2, bap); ST16(rk + (96 + 16) * 2, b2p); }
                if (sb == 2) { ST16(rk + (96 + 32) * 2, bap); }
                ST16(lds + SA_KD + c * TS + sb * 32, kdp);
#undef ST16
            }
            lds_barrier();
            for (int ti = w; ti < 10; ti += 8) {
                const int bi = ti < 1 ? 0 : (ti < 3 ? 1 : (ti < 6 ? 2 : 3)), bj = ti - (bi * (bi + 1)) / 2;
                const int kb = bi == 0 ? 0 : (bi == 1 ? 16 : (bi == 2 ? 48 : 96));
                f32x4 acc = (f32x4){0.f, 0.f, 0.f, 0.f};
#pragma unroll
                for (int ks = 0; ks < 4; ++ks) acc = MFMA16(trfrag(lds + SA_KT, 336, kb + bj * 16, ks * 32, r, q), trfrag(lds + SA_QTG, 336, bi * 16, ks * 32, r, q), acc);
#pragma unroll
                for (int jj = 0; jj < 4; ++jj) if (bi == bj && 4 * q + jj > r) acc[jj] = 0.f;
                u32x2 aw; aw.x = cvt_pk_bf16(acc[0], acc[1]); aw.y = cvt_pk_bf16(acc[2], acc[3]);
                *(LAS u32x2*)(lds + SA_AB + (bi * 16 + r) * TS + (bj * 16 + 4 * q) * 2) = aw;
            }
            const int tb = w >> 1, vb0 = 2 * (w & 1);
            f32x4 oacc[2] = {(f32x4){0.f, 0.f, 0.f, 0.f}, (f32x4){0.f, 0.f, 0.f, 0.f}};
#pragma unroll
            for (int ks = 0; ks < 4; ++ks) { const bf16x8_t af = trfrag(lds + SA_QTG, 336, 64 + tb * 16, ks * 32, r, q);
#pragma unroll
                for (int u = 0; u < 2; ++u) oacc[u] = MFMA16(ldfrag(lds + SA_SB, RS, (vb0 + u) * 16 + r, ks * 32 + q * 8), af, oacc[u]); }
            lds_barrier();
            for (int ks = 0; ks <= (tb >> 1); ++ks) { const bf16x8_t af = ldfrag(lds + SA_AB, TS, tb * 16 + r, ks * 32 + q * 8);
#pragma unroll
                for (int u = 0; u < 2; ++u) oacc[u] = MFMA16(trfrag(lds + SA_VT, RK, (vb0 + u) * 16, ks * 32, r, q), af, oacc[u]); }
            { const int row = b * LPB + pos_of_step(n * 64 + tb * 16 + r, dir, false);
                bf16_t* op = O + ((size_t)dir * T + row) * 512 + h * 128 + vh * 64 + vb0 * 16 + 4 * q;
#pragma unroll
                for (int u = 0; u < 2; ++u) { u32x2 ow; ow.x = cvt_pk_bf16(oacc[u][0], oacc[u][1]); ow.y = cvt_pk_bf16(oacc[u][2], oacc[u][3]); *(u32x2*)(op + 16 * u) = ow; } }
            { const int kh = w >> 2, vq = w & 3;
                const bf16x8_t vf0 = trfrag(lds + SA_VT, RK, vq * 16, 0, r, q), vf1 = trfrag(lds + SA_VT, RK, vq * 16, 32, r, q);
#pragma unroll
                for (int kt = 0; kt < 4; ++kt) { const f32x4 dl = *(const LAS f32x4*)(DL + kh * 64 + kt * 16 + 4 * q);
                    f32x4 s = Sacc[kt] * dl;
                    s = MFMA16(ldfrag(lds + SA_KD, TS, kh * 64 + kt * 16 + r, q * 8), vf0, s); s = MFMA16(ldfrag(lds + SA_KD, TS, kh * 64 + kt * 16 + r, 32 + q * 8), vf1, s);
                    Sacc[kt] = s;
                    u32x2 pk; pk.x = cvt_pk_bf16(s[0], s[1]); pk.y = cvt_pk_bf16(s[2], s[3]);
                    *(LAS u32x2*)(lds + SA_SB + (vq * 16 + r) * RS + (kh * 64 + kt * 16 + 4 * q) * 2) = pk; } }
            if (n + 1 < NCHUNK) SA_STAGE();
            lds_barrier();
        }
#undef SA_LOAD
#undef SA_STAGE
    }
}


constexpr int SB_Q = 0, SB_K = SB_Q + 64 * RS, SB_KW = SB_K + 64 * RS, SB_VT = SB_KW + 128 * TS, SB_AB = SB_VT + 64 * RK, SB_CB = SB_AB + 64 * TS, SB_DENP = SB_CB + 64 * RS,
              SB_NP = SB_DENP + 4096, SB_N = SB_NP + 2048, SB_QN = SB_N + 512, SB_AS = SB_QN + 256, SB_MS = SB_AS + 256, SB_IN = SB_MS + 256, SB_EN = SB_IN + 256, SB_WS = SB_EN + 256, SB_DC = SB_WS + 256, SB_END = SB_DC + 16;
static_assert(SB_END <= 131072, "scan B images vs LDS");
__device__ __forceinline__ void scanB_mfma(KArgs a, int l, LAS unsigned char* lds) {
    a = fresh_args(a);
    const int tid = opaque_tid(), lane = tid & 63, w = __builtin_amdgcn_readfirstlane(tid >> 6), r = lane & 15, q = lane >> 4;
    const bf16_t* P = (const bf16_t*)(a->ws + WS_BIG); bf16_t* O = (bf16_t*)(a->ws + WS_O); const float* SC = (const float*)(a->ws + WS_SC);
    const int c = tid & 127, sb = __builtin_amdgcn_readfirstlane(tid >> 7);
    const int stok = tid >> 3, sp = tid & 7;
    LAS float* DENP = (LAS float*)(lds + SB_DENP); LAS float* NP = (LAS float*)(lds + SB_NP); LAS float* NV = (LAS float*)(lds + SB_N); LAS float* QN = (LAS float*)(lds + SB_QN);
    LAS float* AS = (LAS float*)(lds + SB_AS); LAS float* MS = (LAS float*)(lds + SB_MS); LAS float* IN = (LAS float*)(lds + SB_IN); LAS float* EN = (LAS float*)(lds + SB_EN); LAS float* WS = (LAS float*)(lds + SB_WS); LAS float* DC = (LAS float*)(lds + SB_DC);
    constexpr float KSCALE = 0.08838834764831845f;
    for (int it = blockIdx.x; it < 256; it += gridDim.x) {
        const int vh = it & 1, dir = (it >> 1) & 1, h = (it >> 2) & 3, b = it >> 4;
        const float bi = a->in[I_MGB][l * 16 + dir * 4 + h], bfg = a->in[I_MGB][l * 16 + (2 + dir) * 4 + h];
        __syncthreads();
        for (int i = tid; i < (SB_N + 512 - SB_AB) / 4; i += NTHR) ((LAS unsigned*)(lds + SB_AB))[i] = 0u;
        f32x4 Cacc[4];
#pragma unroll
        for (int i = 0; i < 4; ++i) Cacc[i] = (f32x4){0.f, 0.f, 0.f, 0.f};
        float m_run = 0.f;
        u32x4 qraw[2], kraw[2], vraw;
#define SB_LOAD(n) do { const bf16_t* pr = P + (size_t)(b * LPB + pos_of_step((n) * 64 + stok, dir, true)) * LDP + h * 128; \
            qraw[0] = *(const u32x4*)(pr + sp * 16); qraw[1] = *(const u32x4*)(pr + sp * 16 + 8); kraw[0] = *(const u32x4*)(pr + 512 + sp * 16); kraw[1] = *(const u32x4*)(pr + 512 + sp * 16 + 8); \
            vraw = *(const u32x4*)(pr + 1024 + vh * 64 + sp * 8); \
            if (w == 0) { const size_t srow = (size_t)(b * LPB + pos_of_step((n) * 64 + lane, dir, true)); igpre = SC[srow * 32 + dir * 4 + h]; fgpre = SC[srow * 32 + (2 + dir) * 4 + h]; } } while (0)
        float igpre = 0.f, fgpre = 0.f;
        SB_LOAD(0);
        for (int n = 0; n < NCHUNK; ++n) {
            *(LAS u32x4*)(lds + SB_Q + stok * RS + sp * 32) = qraw[0]; *(LAS u32x4*)(lds + SB_Q + stok * RS + sp * 32 + 16) = qraw[1];
            *(LAS u32x4*)(lds + SB_K + stok * RS + sp * 32) = kraw[0]; *(LAS u32x4*)(lds + SB_K + stok * RS + sp * 32 + 16) = kraw[1];
            *(LAS u32x4*)(lds + SB_VT + stok * RK + sp * 16) = vraw;
            if (w == 0) {
                const float ig = igpre + bi, fg = fgpre + bfg;
                float bb = fminf(fg, 0.f) - log1pf(__expf(-fabsf(fg)));
                bb = wave_scan_add(bb);
                const float av = ig - bb; float pm = av;
                pm = wave_scan_max(pm);
                const float M = fmaxf(pm, m_run), M63 = lane63(M), bb63 = lane63(bb);
                AS[lane] = av; MS[lane] = M; IN[lane] = __expf(m_run - M); EN[lane] = __expf(-(bb + M)); WS[lane] = __expf(av - M63) * KSCALE;
                if (lane == 0) DC[0] = __expf(m_run - M63);
                m_run = bb63 + M63;
            }
            lds_barrier();
            if (n + 1 < NCHUNK) SB_LOAD(n + 1);
            { float np = 0.f; unsigned kwp[8];
#pragma unroll
                for (int g4 = 0; g4 < 4; ++g4) { const v4i16_t kq = tr4(lds + SB_K, RS, sb * 16 + 4 * g4, c & ~15, lane & 15); const f32x4 wv = *(const LAS f32x4*)(WS + sb * 16 + 4 * g4);
                    const float k0 = bf2f((unsigned short)kq[0]) * wv[0], k1 = bf2f((unsigned short)kq[1]) * wv[1], k2 = bf2f((unsigned short)kq[2]) * wv[2], k3 = bf2f((unsigned short)kq[3]) * wv[3];
                    np += (k0 + k1) + (k2 + k3); kwp[2 * g4] = cvt_pk_bf16(k0, k1); kwp[2 * g4 + 1] = cvt_pk_bf16(k2, k3); }
                LAS u32x4* pkw = (LAS u32x4*)(lds + SB_KW + c * TS + sb * 32);
                pkw[0] = (u32x4){kwp[0], kwp[1], kwp[2], kwp[3]}; pkw[1] = (u32x4){kwp[4], kwp[5], kwp[6], kwp[7]};
                NP[sb * 128 + c] = np; }
            { const u32x4 q0 = *(const LAS u32x4*)(lds + SB_Q + stok * RS + sp * 32), q1 = *(const LAS u32x4*)(lds + SB_Q + stok * RS + sp * 32 + 16); float s = 0.f;
#pragma unroll
                for (int j = 0; j < 4; ++j) { const f32x4 n0 = *(const LAS f32x4*)(NV + sp * 16 + 4 * j);
                    const unsigned u0 = j < 2 ? q0[2 * j] : q1[2 * j - 4], u1 = j < 2 ? q0[2 * j + 1] : q1[2 * j - 3];
                    s += __uint_as_float(u0 << 16) * n0[0] + __uint_as_float(u0 & 0xffff0000u) * n0[1] + __uint_as_float(u1 << 16) * n0[2] + __uint_as_float(u1 & 0xffff0000u) * n0[3]; }
                s = red8(s);
                if (sp == 0) QN[stok] = s; }
            for (int ti = w; ti < 10; ti += 8) {
                const int tbi = ti < 1 ? 0 : (ti < 3 ? 1 : (ti < 6 ? 2 : 3)), tbj = ti - (tbi * (tbi + 1)) / 2;
                f32x4 acc = (f32x4){0.f, 0.f, 0.f, 0.f};
#pragma unroll
                for (int ks = 0; ks < 4; ++ks) acc = MFMA16(ldfrag(lds + SB_K, RS, tbj * 16 + r, ks * 32 + q * 8), ldfrag(lds + SB_Q, RS, tbi * 16 + r, ks * 32 + q * 8), acc);
                const f32x4 as4 = *(const LAS f32x4*)(AS + tbj * 16 + 4 * q); const float mt = MS[tbi * 16 + r];
#pragma unroll
                for (int jj = 0; jj < 4; ++jj) { acc[jj] *= KSCALE * __expf(as4[jj] - mt); if (tbi == tbj && 4 * q + jj > r) acc[jj] = 0.f; }
                u32x2 aw; aw.x = cvt_pk_bf16(acc[0], acc[1]); aw.y = cvt_pk_bf16(acc[2], acc[3]);
                *(LAS u32x2*)(lds + SB_AB + (tbi * 16 + r) * TS + (tbj * 16 + 4 * q) * 2) = aw;
                DENP[(tbi * 16 + r) * 16 + tbj * 4 + q] = (acc[0] + acc[1]) + (acc[2] + acc[3]);
            }
            const int tb = w >> 1, vb0 = 2 * (w & 1);
            f32x4 oacc[2] = {(f32x4){0.f, 0.f, 0.f, 0.f}, (f32x4){0.f, 0.f, 0.f, 0.f}};
#pragma unroll
            for (int ks = 0; ks < 4; ++ks) { const bf16x8_t af = ldfrag(lds + SB_Q, RS, tb * 16 + r, ks * 32 + q * 8);
#pragma unroll
                for (int u = 0; u < 2; ++u) oacc[u] = MFMA16(ldfrag(lds + SB_CB, RS, (vb0 + u) * 16 + r, ks * 32 + q * 8), af, oacc[u]); }
            lds_barrier();
            { const int t1 = tb * 16 + r; const float inr = IN[t1]; oacc[0] *= inr; oacc[1] *= inr;
                for (int ks = 0; ks <= (tb >> 1); ++ks) { const bf16x8_t af = ldfrag(lds + SB_AB, TS, tb * 16 + r, ks * 32 + q * 8);
#pragma unroll
                    for (int u = 0; u < 2; ++u) oacc[u] = MFMA16(trfrag(lds + SB_VT, RK, (vb0 + u) * 16, ks * 32, r, q), af, oacc[u]); }
                const f32x4 dp0 = *(const LAS f32x4*)(DENP + t1 * 16), dp1 = *(const LAS f32x4*)(DENP + t1 * 16 + 4), dp2 = *(const LAS f32x4*)(DENP + t1 * 16 + 8), dp3 = *(const LAS f32x4*)(DENP + t1 * 16 + 12);
                const f32x4 dps = (dp0 + dp1) + (dp2 + dp3);
                const float den = (dps[0] + dps[1]) + (dps[2] + dps[3]) + inr * QN[t1]; const float dn = 1.0f / fmaxf(fabsf(den), EN[t1]);
                const int row = b * LPB + pos_of_step(n * 64 + t1, dir, true);
                bf16_t* op = O + ((size_t)dir * T + row) * 512 + h * 128 + vh * 64 + vb0 * 16 + 4 * q;
#pragma unroll
                for (int u = 0; u < 2; ++u) { u32x2 ow; ow.x = cvt_pk_bf16(oacc[u][0] * dn, oacc[u][1] * dn); ow.y = cvt_pk_bf16(oacc[u][2] * dn, oacc[u][3] * dn); *(u32x2*)(op + 16 * u) = ow; } }
            { const int kh = w >> 2, vq = w & 3; const float dc = DC[0];
                const bf16x8_t vf0 = trfrag(lds + SB_VT, RK, vq * 16, 0, r, q), vf1 = trfrag(lds + SB_VT, RK, vq * 16, 32, r, q);
#pragma unroll
                for (int kt = 0; kt < 4; ++kt) { f32x4 s = Cacc[kt] * dc;
                    s = MFMA16(ldfrag(lds + SB_KW, TS, kh * 64 + kt * 16 + r, q * 8), vf0, s); s = MFMA16(ldfrag(lds + SB_KW, TS, kh * 64 + kt * 16 + r, 32 + q * 8), vf1, s);
                    Cacc[kt] = s;
                    u32x2 pk; pk.x = cvt_pk_bf16(s[0], s[1]); pk.y = cvt_pk_bf16(s[2], s[3]);
                    *(LAS u32x2*)(lds + SB_CB + (vq * 16 + r) * RS + (kh * 64 + kt * 16 + 4 * q) * 2) = pk; }
                if (tid < 128) NV[tid] = dc * NV[tid] + ((NP[tid] + NP[128 + tid]) + (NP[256 + tid] + NP[384 + tid])); }
            lds_barrier();
        }
#undef SB_LOAD
    }
}


__device__ __forceinline__ void prepC_phase(KArgs a, int l, LAS unsigned char* lds) {
    a = fresh_args(a);
    const int tid = opaque_tid(), lane = tid & 63, wave = __builtin_amdgcn_readfirstlane(tid >> 6), G = gridDim.x;
    const bf16_t* P = (const bf16_t*)(a->ws + WS_BIG); bf16_t* QP = (bf16_t*)(a->ws + WS_YS);
    LAS float* CW = (LAS float*)lds;
    { const float* cw = a->in[I_CONVW] + (size_t)l * 3 * 1536; for (int i = tid; i < 3 * 1536; i += NTHR) CW[i] = cw[i]; }
    __syncthreads();
    const int gw = blockIdx.x * NWAVES + wave, NGW = G * NWAVES;
    u32x4 nx[3][3];
#define PC_LOAD(r_) do { const int b_ = (r_) / LPB, p_ = (r_) - b_ * LPB; const bool ic_ = p_ < CTX; const int lp_ = ic_ ? p_ : p_ - CTX, Ls_ = ic_ ? CTX : SEQ; \
        const bf16_t* pr_ = P + (size_t)(r_) * LDP + lane * 8; const u32x4 z4_ = (u32x4){0u, 0u, 0u, 0u}; \
        _Pragma("unroll") for (int part_ = 0; part_ < 3; ++part_) { nx[part_][1] = *(const u32x4*)(pr_ + part_ * 512); nx[part_][0] = lp_ > 0 ? *(const u32x4*)(pr_ + part_ * 512 - LDP) : z4_; nx[part_][2] = lp_ < Ls_ - 1 ? *(const u32x4*)(pr_ + part_ * 512 + LDP) : z4_; } } while (0)
    if (gw < T) PC_LOAD(gw);
    for (int row = gw; row < T; row += NGW) {
        u32x4 cx[3][3];
#pragma unroll
        for (int i_ = 0; i_ < 3; ++i_)
#pragma unroll
            for (int j_ = 0; j_ < 3; ++j_) cx[i_][j_] = nx[i_][j_];
        if (row + NGW < T) PC_LOAD(row + NGW);
#pragma unroll
        for (int part = 0; part < 3; ++part) {
            const u32x4 x0 = cx[part][0], x1 = cx[part][1], x2 = cx[part][2];
            float y[8];
#pragma unroll
            for (int g4 = 0; g4 < 2; ++g4) { const f32x4 w0 = *(const LAS f32x4*)(CW + part * 512 + lane * 8 + 4 * g4), w1 = *(const LAS f32x4*)(CW + 1536 + part * 512 + lane * 8 + 4 * g4), w2 = *(const LAS f32x4*)(CW + 3072 + part * 512 + lane * 8 + 4 * g4);
#pragma unroll
                for (int h2 = 0; h2 < 2; ++h2) { const unsigned u0 = x0[2 * g4 + h2], u1 = x1[2 * g4 + h2], u2 = x2[2 * g4 + h2];
                    const float lo = __uint_as_float(u0 << 16) * w0[2 * h2] + __uint_as_float(u1 << 16) * w1[2 * h2] + __uint_as_float(u2 << 16) * w2[2 * h2];
                    const float hi = __uint_as_float(u0 & 0xffff0000u) * w0[2 * h2 + 1] + __uint_as_float(u1 & 0xffff0000u) * w1[2 * h2 + 1] + __uint_as_float(u2 & 0xffff0000u) * w2[2 * h2 + 1];
                    float s0, s1; sigm2(lo, hi, s0, s1); y[4 * g4 + 2 * h2] = lo * s0; y[4 * g4 + 2 * h2 + 1] = hi * s1; } }
            if (part < 2) { float ss = 0.f;
#pragma unroll
                for (int j = 0; j < 8; ++j) ss += y[j] * y[j];
                ss = red16(ss);
                const float rn = (part == 0 ? 0.08838834764831845f : 1.0f) / sqrtf(ss + L2_EPS);
#pragma unroll
                for (int j = 0; j < 8; ++j) y[j] *= rn; }
            u32x4 o; o.x = cvt_pk_bf16(y[0], y[1]); o.y = cvt_pk_bf16(y[2], y[3]); o.z = cvt_pk_bf16(y[4], y[5]); o.w = cvt_pk_bf16(y[6], y[7]);
            *(u32x4*)(QP + (size_t)row * 1536 + part * 512 + lane * 8) = o;
        }
    }
#undef PC_LOAD
}

constexpr int SC_Q = 0, SC_K = SC_Q + 64 * RS, SC_P0N = 0, SC_P0T = 64 * TS, SC_W = 0, SC_KT = SC_K + 64 * RS, SC_VT = SC_KT + 128 * TS, SC_QKM = SC_VT + 64 * TS,
              SC_A = SC_QKM + 64 * TS, SC_AT = SC_A + 64 * TS, SC_TB = SC_A, SC_TBG = SC_AT, SC_TX = SC_AT + 64 * TS, SC_TY = SC_TX + 64 * TS, SC_VN2 = SC_TX, SC_VNT = SC_TY, SC_SB = SC_TY + 64 * TS,
              SC_BG = SC_SB + 64 * RS, SC_KGS = SC_BG + 256, SC_EG = SC_KGS + 256, SC_GAM = SC_EG + 256, SC_BT = SC_GAM + 256, SC_GL = SC_BT + 256, SC_END = SC_GL + 16;
static_assert(SC_END <= LDSCTL_OFF && 2 * 64 * TS <= 64 * RS + 64 * RS && 64 * RS <= 2 * 64 * RS, "scan C images vs LDS");
__device__ __forceinline__ f32x4 ld_bf16x4_lds(const LAS unsigned char* p) { const u32x2 wv = *(const LAS u32x2*)p; return (f32x4){__uint_as_float(wv.x << 16), __uint_as_float(wv.x & 0xffff0000u), __uint_as_float(wv.y << 16), __uint_as_float(wv.y & 0xffff0000u)}; }
__device__ __forceinline__ f32x4 tile64(const LAS unsigned char* lds, int xi, int yi, int bx, int by, int lts, f32x4 acc) {
#pragma unroll
    for (int ks = 0; ks < 2; ++ks) acc = MFMA16(*(const LAS bf16x8_t*)(lds + xi + bx * 16 * TS + ks * 64 + lts), *(const LAS bf16x8_t*)(lds + yi + by * 16 * TS + ks * 64 + lts), acc);
    return acc;
}
__device__ __forceinline__ void st4(LAS unsigned char* lds, int img, int bx, int by, int ltt, f32x4 v) {
    u32x2 pk; pk.x = cvt_pk_bf16(v[0], v[1]); pk.y = cvt_pk_bf16(v[2], v[3]); *(LAS u32x2*)(lds + img + by * 16 * TS + bx * 32 + ltt) = pk;
}
constexpr int TC_ITEMS = NB * 4 * 2 * NCHUNK; constexpr size_t TQ_ITEM = 16384;
static_assert((size_t)TC_ITEMS * TQ_ITEM <= (size_t)2 * T * 512 * 2 && TC_ITEMS % 2 == 0, "TQ fits the O region");
constexpr int TQ_Q = 0, TQ_K = TQ_Q + 64 * RS, TQ_P0N = 0, TQ_P0T = 64 * TS, TQ_A = TQ_K + 64 * RS, TQ_AT = TQ_A + 64 * TS, TQ_TB = TQ_A, TQ_TX = TQ_AT + 64 * TS, TQ_TY = TQ_TX + 64 * TS, TQ_QKM = TQ_TY + 64 * TS,
              TQ_GAM = TQ_QKM + 64 * TS, TQ_BT = TQ_GAM + 256, TQ_SUB = TQ_BT + 256;
static_assert(2 * TQ_SUB <= LDSCTL_OFF && 2 * 64 * TS <= 2 * 64 * RS, "two transform pipelines vs LDS");
__device__ __forceinline__ void tcC_phase(KArgs a, int l, LAS unsigned char* lds0) {
    a = fresh_args(a);
    const int tid = opaque_tid(), w = __builtin_amdgcn_readfirstlane(tid >> 6), sub = w >> 2, w4 = w & 3;
    const bf16_t* QP = (const bf16_t*)(a->ws + WS_YS); unsigned char* TQ = a->ws + WS_O; const float* SC = (const float*)(a->ws + WS_SC);
    LAS unsigned char* lds = lds0 + sub * TQ_SUB;
    LAS float* GAM = (LAS float*)(lds + TQ_GAM); LAS float* BT = (LAS float*)(lds + TQ_BT);
    u32x4 rq[4], rk[4]; float gpre = 0.f, bpre = 0.f;
#define TC_LOAD(item) do { const int n_ = (item) % NCHUNK, rest_ = (item) / NCHUNK, dir_ = rest_ & 1, h_ = (rest_ >> 1) & 3, b_ = rest_ >> 3; \
        const bf16_t* pr = QP + (size_t)(b_ * LPB + pos_of_step(n_ * 64 + stok, dir_, false)) * 1536 + h_ * 128 + sp * 32; \
        _Pragma("unroll") for (int j_ = 0; j_ < 4; ++j_) { rq[j_] = *(const u32x4*)(pr + 8 * j_); rk[j_] = *(const u32x4*)(pr + 512 + 8 * j_); } \
        if (w4 == 0) { const size_t row = (size_t)(b_ * LPB + pos_of_step(n_ * 64 + (tid & 63), dir_, false)); gpre = SC[row * 32 + 16 + dir_ * 4 + h_]; bpre = SC[row * 32 + 16 + (2 + dir_) * 4 + h_]; } } while (0)
    { const int stok = (tid & 255) >> 2, sp = tid & 3; if (2 * (int)blockIdx.x + sub < TC_ITEMS) TC_LOAD(2 * (int)blockIdx.x + sub); }
    __syncthreads();
    for (int pr_ = blockIdx.x; 2 * pr_ < TC_ITEMS; pr_ += gridDim.x) {
        const int it = 2 * pr_ + sub;
        const int rest = it / NCHUNK, dir = rest & 1, h = (rest >> 1) & 3;
        const float nalog = -__expf(a->in[I_ALOG][l * 8 + dir * 4 + h]), dtb = a->in[I_DTB][l * 8 + dir * 4 + h];
        int oz = 0; asm volatile("" : "+v"(oz));
        const int t2 = tid + oz, lane = t2 & 63, r = lane & 15, q = lane >> 4, stok = (t2 & 255) >> 2, sp = t2 & 3;
        const int lrs = r * RS + q * 16 + oz, lts = r * TS + q * 16 + oz, ltt = r * TS + 8 * q + oz;
        { const int sto = stok * RS + sp * 64 + oz;
#pragma unroll
            for (int j = 0; j < 4; ++j) { *(LAS u32x4*)(lds + TQ_Q + 16 * j + sto) = rq[j]; *(LAS u32x4*)(lds + TQ_K + 16 * j + sto) = rk[j]; } }
        if (w4 == 0) {
            const float ap = gpre + dtb;
            float gm = nalog * (fmaxf(ap, 0.f) + log1pf(__expf(-fabsf(ap))));
            gm = wave_scan_add(gm);
            GAM[lane] = gm; BT[lane] = sigm(bpre);
        }
        lds_barrier();
        if (2 * (pr_ + (int)gridDim.x) < TC_ITEMS) TC_LOAD(2 * (pr_ + (int)gridDim.x) + sub);
        { const int by = w4; bf16x8_t fyk[4], fyq[4];
#pragma unroll
            for (int ks = 0; ks < 4; ++ks) { fyk[ks] = *(const LAS bf16x8_t*)(lds + TQ_K + by * 16 * RS + ks * 64 + lrs); fyq[ks] = *(const LAS bf16x8_t*)(lds + TQ_Q + by * 16 * RS + ks * 64 + lrs); }
            const int n_ = by * 16 + r; const float gn = GAM[n_], bn = BT[n_];
#pragma unroll
            for (int bx = 0; bx < 4; ++bx) { const int m0 = bx * 16 + 4 * q;
                f32x4 akk = (f32x4){0.f, 0.f, 0.f, 0.f}, aqk = (f32x4){0.f, 0.f, 0.f, 0.f};
#pragma unroll
                for (int ks = 0; ks < 4; ++ks) { const bf16x8_t fk = *(const LAS bf16x8_t*)(lds + TQ_K + bx * 16 * RS + ks * 64 + lrs); akk = MFMA16(fk, fyk[ks], akk); aqk = MFMA16(fk, fyq[ks], aqk); }
                const f32x4 gmv = *(const LAS f32x4*)(GAM + m0); f32x4 vq, va, v1;
#pragma unroll
                for (int jj = 0; jj < 4; ++jj) { const int m_ = m0 + jj; const float dec = __expf(-fabsf(gn - gmv[jj]));
                    vq[jj] = (m_ <= n_) ? aqk[jj] * dec : 0.f;
                    va[jj] = (m_ < n_) ? akk[jj] * dec * bn : 0.f;
                    v1[jj] = (m_ == n_ ? 1.0f : 0.f) - va[jj]; }
                st4(lds, TQ_QKM, bx, by, ltt, vq); st4(lds, TQ_A, bx, by, ltt, va); st4(lds, TQ_TX, bx, by, ltt, v1); }
        }
        lds_barrier();
#pragma unroll 1
        for (int rd = 1; rd <= 6; ++rd) {
            const int pn = (rd & 1) ? TQ_A : TQ_P0N, dn = (rd & 1) ? TQ_P0N : TQ_A, tsrc = (rd & 1) ? TQ_TY : TQ_TX, tdst = (rd & 1) ? TQ_TX : TQ_TY;
            { const int by = w4; bf16x8_t ypn[2], yts[2];
#pragma unroll
                for (int ks = 0; ks < 2; ++ks) { ypn[ks] = *(const LAS bf16x8_t*)(lds + pn + by * 16 * TS + ks * 64 + lts); yts[ks] = *(const LAS bf16x8_t*)(lds + tsrc + by * 16 * TS + ks * 64 + lts); }
                f32x4 rpn[4], rt[4];
#pragma unroll
                for (int bx = 0; bx < 4; ++bx) { rpn[bx] = (f32x4){0.f, 0.f, 0.f, 0.f}; rt[bx] = ld_bf16x4_lds(lds + tsrc + by * 16 * TS + bx * 32 + ltt);
#pragma unroll
                    for (int ks = 0; ks < 2; ++ks) { const bf16x8_t xpc = trfrag(lds + pn, TS, 16 * bx, 32 * ks, r, q);
                        rpn[bx] = MFMA16(xpc, ypn[ks], rpn[bx]);
                        rt[bx] = MFMA16(xpc, yts[ks], rt[bx]); } }
#pragma unroll
                for (int bx = 0; bx < 4; ++bx) {
                    if (rd < 6) st4(lds, dn, bx, by, ltt, rpn[bx]);
                    if (rd > 1) { if (rd < 6) st4(lds, tdst, bx, by, ltt, rt[bx]);
                        else { const f32x4 bs = *(const LAS f32x4*)(BT + bx * 16 + 4 * q); st4(lds, TQ_TB, bx, by, ltt, rt[bx] * bs); } } }
            }
            lds_barrier();
        }
        { unsigned char* dst = TQ + (size_t)it * TQ_ITEM + stok * 128 + sp * 32;
#pragma unroll
            for (int j = 0; j < 2; ++j) { *(u32x4*)(dst + 16 * j) = *(const LAS u32x4*)(lds + TQ_TB + stok * TS + sp * 32 + 16 * j + oz); *(u32x4*)(dst + 8192 + 16 * j) = *(const LAS u32x4*)(lds + TQ_QKM + stok * TS + sp * 32 + 16 * j + oz); } }
        lds_barrier();
    }
#undef TC_LOAD
}

constexpr int S3_Q = 0, S3_W = 0, S3_K = S3_Q + 64 * RS, S3_KT = S3_K + 64 * RS, S3_KTG = S3_KT + 128 * TS, S3_VT = S3_KTG + 128 * TS, S3_QKM = S3_VT + 64 * RK, S3_TB = S3_QKM + 64 * TS,
              S3_VNT = S3_TB + 64 * TS, S3_VN2 = S3_VNT + 64 * TS, S3_SB = S3_VN2 + 64 * TS, S3_EG = S3_SB + 64 * RS, S3_KGS = S3_EG + 256, S3_GL = S3_KGS + 256, S3_END = S3_GL + 16;
static_assert(S3_END <= LDSCTL_OFF, "scan C images vs LDS");
__device__ __forceinline__ void scanC_mfma(KArgs a, int l, LAS unsigned char* lds) {
    a = fresh_args(a);
    const int tid = opaque_tid(), w = __builtin_amdgcn_readfirstlane(tid >> 6);
    const bf16_t* QP = (const bf16_t*)(a->ws + WS_YS); const unsigned char* TQ = a->ws + WS_O; bf16_t* OP = (bf16_t*)(a->ws + WS_BIG); const float* SC = (const float*)(a->ws + WS_SC);
    LAS float* KGS = (LAS float*)(lds + S3_KGS); LAS float* EG = (LAS float*)(lds + S3_EG); LAS float* GL = (LAS float*)(lds + S3_GL);
    for (int it = blockIdx.x; it < 256; it += gridDim.x) {
        const int vh = it & 1, dir = (it >> 1) & 1, h = (it >> 2) & 3, b = it >> 4;
        const float nalog = -__expf(a->in[I_ALOG][l * 8 + dir * 4 + h]), dtb = a->in[I_DTB][l * 8 + dir * 4 + h];
        const unsigned char* tqb = TQ + (size_t)(((b * 4 + h) * 2 + dir) * NCHUNK) * TQ_ITEM;
        __syncthreads();
        for (int i = tid; i < 64 * RS / 4; i += NTHR) ((LAS unsigned*)(lds + S3_SB))[i] = 0u;
        __syncthreads();
        f32x4 Sacc[4];
#pragma unroll
        for (int i = 0; i < 4; ++i) Sacc[i] = (f32x4){0.f, 0.f, 0.f, 0.f};
        u32x4 rq[2], rk[2], rv, rtb, rqk; float gpre = 0.f;
#define SC_LOAD(n) do { const bf16_t* pr = QP + (size_t)(b * LPB + pos_of_step((n) * 64 + stok, dir, false)) * 1536 + h * 128; \
            rq[0] = *(const u32x4*)(pr + sp * 16); rq[1] = *(const u32x4*)(pr + sp * 16 + 8); rk[0] = *(const u32x4*)(pr + 512 + sp * 16); rk[1] = *(const u32x4*)(pr + 512 + sp * 16 + 8); rv = *(const u32x4*)(pr + 1024 + vh * 64 + sp * 8); \
            rtb = *(const u32x4*)(tqb + (size_t)(n) * TQ_ITEM + stok * 128 + sp * 16); rqk = *(const u32x4*)(tqb + (size_t)(n) * TQ_ITEM + 8192 + stok * 128 + sp * 16); \
            if (w == 0) { const size_t row = (size_t)(b * LPB + pos_of_step((n) * 64 + (tid & 63), dir, false)); gpre = SC[row * 32 + 16 + dir * 4 + h]; } } while (0)
        { const int stok = tid >> 3, sp = tid & 7; SC_LOAD(0); }
        for (int n = 0; n < NCHUNK; ++n) {
            int oz = 0; asm volatile("" : "+v"(oz));
            const int t2 = tid + oz, lane = t2 & 63, r = lane & 15, q = lane >> 4, c = t2 & 127, sb = w >> 1, stok = t2 >> 3, sp = t2 & 7;
            const int lrs = r * RS + q * 16 + oz, lts = r * TS + q * 16 + oz, ltt = r * TS + 8 * q + oz, lrt = r * RS + 8 * q + oz;
            { const int sto = stok * RS + sp * 32 + oz, tso = stok * TS + sp * 16 + oz;
                *(LAS u32x4*)(lds + S3_Q + sto) = rq[0]; *(LAS u32x4*)(lds + S3_Q + 16 + sto) = rq[1]; *(LAS u32x4*)(lds + S3_K + sto) = rk[0]; *(LAS u32x4*)(lds + S3_K + 16 + sto) = rk[1];
                *(LAS u32x4*)(lds + S3_TB + tso) = rtb; *(LAS u32x4*)(lds + S3_QKM + tso) = rqk;
                *(LAS u32x4*)(lds + S3_VT + stok * RK + sp * 16 + oz) = rv; }
            if (w == 0) {
                const float ap = gpre + dtb;
                float gm = nalog * (fmaxf(ap, 0.f) + log1pf(__expf(-fabsf(ap))));
                gm = wave_scan_add(gm);
                const float g63 = lane63(gm);
                EG[lane] = __expf(gm); KGS[lane] = __expf(g63 - gm);
                if (lane == 0) GL[0] = __expf(g63);
            }
            lds_barrier();
            if (n + 1 < NCHUNK) SC_LOAD(n + 1);
            { unsigned p0[8], p1[8];
#pragma unroll
                for (int g4 = 0; g4 < 4; ++g4) { const v4i16_t kq = tr4(lds + S3_K + oz, RS, sb * 16 + 4 * g4, c & ~15, r); const f32x4 eg4 = *(const LAS f32x4*)(EG + sb * 16 + 4 * g4);
                    const unsigned h0 = (unsigned short)kq[0], h1 = (unsigned short)kq[1], h2 = (unsigned short)kq[2], h3 = (unsigned short)kq[3];
                    p0[2 * g4] = h0 | (h1 << 16); p0[2 * g4 + 1] = h2 | (h3 << 16);
                    p1[2 * g4] = cvt_pk_bf16(__uint_as_float(h0 << 16) * eg4[0], __uint_as_float(h1 << 16) * eg4[1]); p1[2 * g4 + 1] = cvt_pk_bf16(__uint_as_float(h2 << 16) * eg4[2], __uint_as_float(h3 << 16) * eg4[3]); }
                LAS u32x4* d0 = (LAS u32x4*)(lds + S3_KT + c * TS + sb * 32 + oz); d0[0] = (u32x4){p0[0], p0[1], p0[2], p0[3]}; d0[1] = (u32x4){p0[4], p0[5], p0[6], p0[7]};
                LAS u32x4* d1 = (LAS u32x4*)(lds + S3_KTG + c * TS + sb * 32 + oz); d1[0] = (u32x4){p1[0], p1[1], p1[2], p1[3]}; d1[1] = (u32x4){p1[4], p1[5], p1[6], p1[7]}; }
            const int tb = w >> 1, vb0 = 2 * (w & 1);
            f32x4 oacc[2] = {(f32x4){0.f, 0.f, 0.f, 0.f}, (f32x4){0.f, 0.f, 0.f, 0.f}};
#pragma unroll
            for (int ks = 0; ks < 4; ++ks) { const bf16x8_t af = *(const LAS bf16x8_t*)(lds + S3_Q + tb * 16 * RS + ks * 64 + lrs);
#pragma unroll
                for (int u = 0; u < 2; ++u) oacc[u] = MFMA16(*(const LAS bf16x8_t*)(lds + S3_SB + (vb0 + u) * 16 * RS + ks * 64 + lrs), af, oacc[u]); }
            lds_barrier();
            f32x4 uacc[2];
#pragma unroll
            for (int u = 0; u < 2; ++u) uacc[u] = (f32x4){0.f, 0.f, 0.f, 0.f};
#pragma unroll
            for (int ks = 0; ks < 2; ++ks) { const bf16x8_t xf = *(const LAS bf16x8_t*)(lds + S3_TB + tb * 16 * TS + ks * 64 + lts);
#pragma unroll
                for (int u = 0; u < 2; ++u) uacc[u] = MFMA16(xf, trfrag(lds + S3_VT + oz, RK, (vb0 + u) * 16, ks * 32, r, q), uacc[u]); }
            { const int by = w & 3; bf16x8_t ytb[2], xkt[4][2];
#pragma unroll
                for (int ks = 0; ks < 2; ++ks) { ytb[ks] = *(const LAS bf16x8_t*)(lds + S3_TB + by * 16 * TS + ks * 64 + lts);
#pragma unroll
                    for (int jx = 0; jx < 4; ++jx) xkt[jx][ks] = *(const LAS bf16x8_t*)(lds + S3_KTG + ((w >> 2) + 2 * jx) * 16 * TS + ks * 64 + lts); }
#pragma unroll
                for (int jx = 0; jx < 4; ++jx) { const int kb = (w >> 2) + 2 * jx; f32x4 wv = (f32x4){0.f, 0.f, 0.f, 0.f};
#pragma unroll
                    for (int ks = 0; ks < 2; ++ks) wv = MFMA16(xkt[jx][ks], ytb[ks], wv);
                    u32x2 pk; pk.x = cvt_pk_bf16(wv[0], wv[1]); pk.y = cvt_pk_bf16(wv[2], wv[3]); *(LAS u32x2*)(lds + S3_W + by * 16 * RS + kb * 32 + lrt) = pk; } }
            lds_barrier();
            { const f32x4 kg = *(const LAS f32x4*)(KGS + tb * 16 + 4 * q);
                f32x4 ws[2] = {(f32x4){0.f, 0.f, 0.f, 0.f}, (f32x4){0.f, 0.f, 0.f, 0.f}};
#pragma unroll
                for (int ks = 0; ks < 4; ++ks) { const bf16x8_t xf = *(const LAS bf16x8_t*)(lds + S3_W + tb * 16 * RS + ks * 64 + lrs);
#pragma unroll
                    for (int u = 0; u < 2; ++u) ws[u] = MFMA16(xf, *(const LAS bf16x8_t*)(lds + S3_SB + (vb0 + u) * 16 * RS + ks * 64 + lrs), ws[u]); }
#pragma unroll
                for (int u = 0; u < 2; ++u) { const f32x4 vn = uacc[u] - ws[u]; st4(lds, S3_VNT, tb, vb0 + u, ltt, vn); st4(lds, S3_VN2, tb, vb0 + u, ltt, vn * kg); } }
            lds_barrier();
            { const float egt = EG[tb * 16 + r];
#pragma unroll
                for (int u = 0; u < 2; ++u) oacc[u] *= egt;
#pragma unroll
                for (int ks = 0; ks < 2; ++ks) { const bf16x8_t xf = *(const LAS bf16x8_t*)(lds + S3_QKM + tb * 16 * TS + ks * 64 + lts);
#pragma unroll
                    for (int u = 0; u < 2; ++u) oacc[u] = MFMA16(*(const LAS bf16x8_t*)(lds + S3_VNT + (vb0 + u) * 16 * TS + ks * 64 + lts), xf, oacc[u]); }
                const int row = b * LPB + pos_of_step(n * 64 + tb * 16 + r, dir, false);
                bf16_t* op = OP + (size_t)row * LDP + dir * 512 + h * 128 + vh * 64 + vb0 * 16 + 4 * q;
#pragma unroll
                for (int u = 0; u < 2; ++u) { u32x2 ow; ow.x = cvt_pk_bf16(oacc[u][0], oacc[u][1]); ow.y = cvt_pk_bf16(oacc[u][2], oacc[u][3]); *(u32x2*)(op + 16 * u) = ow; } }
            { const int kh = w >> 2, vq = w & 3; const float gl = GL[0];
                bf16x8_t yv[2];
#pragma unroll
                for (int ks = 0; ks < 2; ++ks) yv[ks] = *(const LAS bf16x8_t*)(lds + S3_VN2 + vq * 16 * TS + ks * 64 + lts);
#pragma unroll
                for (int kt = 0; kt < 4; ++kt) { f32x4 s = Sacc[kt] * gl;
#pragma unroll
                    for (int ks = 0; ks < 2; ++ks) s = MFMA16(*(const LAS bf16x8_t*)(lds + S3_KT + (kh * 4 + kt) * 16 * TS + ks * 64 + lts), yv[ks], s);
                    Sacc[kt] = s;
                    u32x2 pk; pk.x = cvt_pk_bf16(s[0], s[1]); pk.y = cvt_pk_bf16(s[2], s[3]);
                    *(LAS u32x2*)(lds + S3_SB + vq * 16 * RS + (kh * 64 + kt * 16) * 2 + lrt) = pk; } }
            lds_barrier();
        }
#undef SC_LOAD
    }
}

__device__ __forceinline__ void finalize_phase(KArgs a, int l, int mx, LAS unsigned char* lds) {
    a = fresh_args(a);
    const int tid = opaque_tid(), lane = tid & 63, wave = __builtin_amdgcn_readfirstlane(tid >> 6), G = gridDim.x;
    const bf16_t* P = (const bf16_t*)(a->ws + WS_BIG); const bf16_t* O = (const bf16_t*)(a->ws + WS_O); bf16_t* YS = (bf16_t*)(a->ws + WS_YS);
    const int gate_off = (mx == 0) ? 2048 : 1536, c8 = lane * 8;
    const float* gn = a->in[I_MIXN] + (size_t)(l * 3 + mx) * 512 + c8;
    const f32x4 g0 = *(const f32x4*)gn, g1 = *(const f32x4*)(gn + 4);
    const int gw = blockIdx.x * NWAVES + wave, NGW = G * NWAVES;
    for (int row = gw; row < T; row += NGW) {
        const u32x4 of = (mx == 2) ? *(const u32x4*)(P + (size_t)row * LDP + c8) : *(const u32x4*)(O + (size_t)row * 512 + c8);
        const u32x4 ob = (mx == 2) ? *(const u32x4*)(P + (size_t)row * LDP + 512 + c8) : *(const u32x4*)(O + ((size_t)T + row) * 512 + c8), gt = *(const u32x4*)(P + (size_t)row * LDP + gate_off + c8);
        float o[8], g[8];
#pragma unroll
        for (int j = 0; j < 4; ++j) { o[2 * j] = __uint_as_float(of[j] << 16) + __uint_as_float(ob[j] << 16); o[2 * j + 1] = __uint_as_float(of[j] & 0xffff0000u) + __uint_as_float(ob[j] & 0xffff0000u);
            g[2 * j] = __uint_as_float(gt[j] << 16); g[2 * j + 1] = __uint_as_float(gt[j] & 0xffff0000u); }
        float ss = 0.f;
#pragma unroll
        for (int j = 0; j < 8; ++j) ss += o[j] * o[j];
        ss = red16(ss);
        const float r = 1.0f / sqrtf(ss * (1.0f / 128.0f) + RMS_EPS);
        float y[8];
#pragma unroll
        for (int j = 0; j < 8; j += 2) { float s0, s1; sigm2(g[j], g[j + 1], s0, s1); const float a0 = (mx == 1) ? s0 : g[j] * s0, a1 = (mx == 1) ? s1 : g[j + 1] * s1;
            y[j] = o[j] * r * (j < 4 ? g0[j & 3] : g1[j & 3]) * a0; y[j + 1] = o[j + 1] * r * (j + 1 < 4 ? g0[(j + 1) & 3] : g1[(j + 1) & 3]) * a1; }
        u32x4 w; w.x = cvt_pk_bf16(y[0], y[1]); w.y = cvt_pk_bf16(y[2], y[3]); w.z = cvt_pk_bf16(y[4], y[5]); w.w = cvt_pk_bf16(y[6], y[7]);
        *(u32x4*)(YS + (size_t)row * LDYS + mx * 512 + c8) = w;
    }
}

#ifdef NO_SCANS
#define SCAN_CALL(x)
#else
#define SCAN_CALL(x) x
#endif
#ifdef NO_ROWS
#define ROW_CALL(x)
#else
#define ROW_CALL(x) x
#endif
#ifndef SITES
#define SITES 0xff
#endif
#define GEMM_SITE(i) if ((SITES >> (i)) & 1)
#ifndef MK_ONE_LAUNCH
#define MK_ONE_LAUNCH 1
#endif
constexpr int PH_TOTAL = 2 + 2 * (15 + 3 + 1) + 2 * (15 + 1 + 4 + 1);

__global__ void __launch_bounds__(NTHR, 2) mk_fwd(Args a_by_value) {
    (void)a_by_value; KArgs a = (KArgs)__builtin_amdgcn_kernarg_segment_ptr();
    extern __shared__ __attribute__((aligned(16))) unsigned char lds_raw[];
    LAS unsigned char* lds = (LAS unsigned char*)lds_raw;
    const int tid = opaque_tid(), G = gridDim.x;
    for (int u = tid; u < (LDS_BYTES - LDSCTL_OFF) / 4; u += NTHR) ((LAS unsigned*)(lds + LDSCTL_OFF))[u] = 0u;
    __syncthreads();
    volatile LAS unsigned* MISC = (volatile LAS unsigned*)(lds + LDSCTL_OFF + 320);
    unsigned* ctl = (unsigned*)(a->ws + WS_CTL);
    const int lo = a->ph_lo, hi = a->ph_hi;
    XcdBarrier bar; bar.bar = ctl + CW_BAR; bar.x = 0; bar.st = nullptr;
    if (hi - lo > 1) bar = xcd_barrier_post(ctl + CW_BAR, MISC + 8);
    int ph = 0;
#define RUN (ph >= lo && ph < hi)
#define NEXT() do { if (RUN && ph + 1 < hi) xcd_barrier(bar); ++ph; } while (0)
    bf16_t* H = (bf16_t*)(a->ws + WS_H); bf16_t* YS = (bf16_t*)(a->ws + WS_YS); bf16_t* BIG = (bf16_t*)(a->ws + WS_BIG);
    float* XS = (float*)(a->ws + WS_XS); float* SC = (float*)(a->ws + WS_SC); const float* MOD = (const float*)(a->ws + WS_MOD);

    if (RUN) { ROW_CALL(pro_a(a, lds)); }
    NEXT();
    if (RUN) { ROW_CALL(rowpass<0>(a, 0, lds)); }
    NEXT();
    for (int l = 0; l < DEPTH; ++l) {
        unsigned char* lw = a->ws + WS_W + (size_t)l * LW_BYTES;
        const bf16_t* WinT = (const bf16_t*)lw; const bf16_t* WbT = (const bf16_t*)(lw + LW_WB); const bf16_t* WoT = (const bf16_t*)(lw + LW_WO);
        if (RUN) { pg8::Gemm g{H, WinT + (size_t)4864 * D, D, D, nullptr}; pg8::StaticOrder S; S.init(T, 2048, G, (int)blockIdx.x); pg8::EpiP E{BIG, LDP, nullptr, -1, 0, 0, nullptr, 0, 0};
            { const int rr = (NTILE * 8) % G, first = rr, nw = G - first, tq_ = opaque_tid(), wv = __builtin_amdgcn_readfirstlane(tq_ >> 6), ln = tq_ & 63;
                if ((int)blockIdx.x >= first) { sc_stage_w(WinT + (size_t)4608 * D, lds, tq_); __syncthreads(); for (int u = (int)blockIdx.x - first; u < NTILE; u += nw) sc_unit(H, lds, SC, u, wv, ln); __syncthreads(); } }
            GEMM_SITE(2) pg8::gemm_phase<pg8::EpiP, pg8::StaticOrder, true, true>(lds, g, S, E); }
        NEXT();
        if (RUN) { ROW_CALL(prepC_phase(a, l, lds)); }
        NEXT();
        if (RUN) { SCAN_CALL(tcC_phase(a, l, lds)); }
        NEXT();
        if (RUN) { SCAN_CALL(scanC_mfma(a, l, lds)); }
        NEXT();
        if (RUN) { ROW_CALL(finalize_phase(a, l, 2, lds)); }
        NEXT();
        if (RUN) { pg8::Gemm g{H, WinT, D, D, nullptr}; pg8::StaticOrder S; S.init(T, 2560, G, (int)blockIdx.x); pg8::EpiP E{BIG, LDP, nullptr, -1, 0, 0, (const float*)(a->ws + WS_OML) + l * 512, 2, 6};
            GEMM_SITE(0) pg8::gemm_phase<pg8::EpiP, pg8::StaticOrder, true, true>(lds, g, S, E); }
        NEXT();
        if (RUN) { SCAN_CALL(scanA_mfma(a, l, lds)); }
        NEXT();
        if (RUN) { ROW_CALL(finalize_phase(a, l, 0, lds)); }
        NEXT();
        if (RUN) { pg8::Gemm g{H, WinT + (size_t)2560 * D, D, D, nullptr}; pg8::StaticOrder S; S.init(T, 2048, G, (int)blockIdx.x); pg8::EpiP E{BIG, LDP, nullptr, -1, 0, 0, nullptr, 0, 0};
            GEMM_SITE(1) pg8::gemm_phase<pg8::EpiP, pg8::StaticOrder, true, true>(lds, g, S, E); }
        NEXT();
        if (RUN) { SCAN_CALL(scanB_mfma(a, l, lds)); }
        NEXT();
        if (RUN) { ROW_CALL(finalize_phase(a, l, 1, lds)); }
        NEXT();
        if (RUN) { pg8::Gemm g{H, WinT + (size_t)6912 * D, D, D, nullptr}; pg8::StaticOrder S; S.init(l == DEPTH - 1 ? NB * SEQ : T, 3072, G, (int)blockIdx.x); S.lat = (l == DEPTH - 1); pg8::EpiP E{BIG, LDMG, nullptr, -1, 1, 0, nullptr, 0, 0};
            GEMM_SITE(3) pg8::gemm_phase<pg8::EpiP, pg8::StaticOrder, true, true>(lds, g, S, E); }
        NEXT();
        if (RUN) { pg8::Gemm g{YS, WbT, LDYS, 1536, nullptr}; pg8::StaticOrder S; S.init(l == DEPTH - 1 ? NB * SEQ : T, 1024, G, (int)blockIdx.x); S.lat = (l == DEPTH - 1); pg8::EpiMixed E{BIG, H};
            GEMM_SITE(4) pg8::gemm_phase<pg8::EpiMixed, pg8::StaticOrder, true, true>(lds, g, S, E); }
        NEXT();
        if (RUN) { pg8::Gemm g{H, WoT, D, D, nullptr}; pg8::StaticOrder S; S.init(l == DEPTH - 1 ? NB * SEQ : T, 1024, G, (int)blockIdx.x); S.lat = (l == DEPTH - 1); const float* lnid = (const float*)(a->ws + WS_LNID);
            pg8::EpiRes E{XS, MOD + (size_t)l * 17 * 6144 + 2 * 1024, (const float*)(a->ws + (l ? WS_STAT : WS_ZSTAT)), l ? a->in[I_LNG] + (size_t)(l * 2 - 1) * D : lnid, l ? a->in[I_LNB] + (size_t)(l * 2 - 1) * D : lnid + 1024, a->in[I_X], a->in[I_CTX], ALPHA, l == 0};
            GEMM_SITE(5) pg8::gemm_phase<pg8::EpiRes, pg8::StaticOrder, true, true>(lds, g, S, E); }
        NEXT();
        const bool moe = (l & 1) != 0; const int ns = moe ? 2 : 1;
        const int dlim = (NTILE * (D / 256) / G) * G, nleft = NTILE * (D / 256) - dlim;
        if (RUN) { ROW_CALL(rowpass<1>(a, l, lds)); if (moe) { __syncthreads(); ROW_CALL(conv_moe(a, l >> 1, lds)); } }
        NEXT();
        if (moe) { if (RUN) moe_fill(a, l >> 1, l == DEPTH - 1); NEXT(); }
        for (int s = 0; s < ns; ++s) {
            const unsigned char* fw = moe ? a->ws + WS_YS : a->ws + WS_WFFN + (size_t)(l >> 1) * FFNW_BYTES;
            const int* perm = moe ? (const int*)(a->ws + WS_PERM) + (size_t)s * TP : (const int*)(a->ws + WS_PERMID);
            const float* permw = moe ? (const float*)(a->ws + WS_PERMW) + (size_t)s * TP : nullptr;
            if (RUN) { int ts[9]; if (moe) moe_tile_starts(a, l >> 1, s, ts); else {
#pragma unroll
                    for (int e = 0; e < 9; ++e) ts[e] = e ? NTILE : 0; }
                pg8::Gemm g{H, (const bf16_t*)fw, D, D, perm}; pg8::MoeOrder S; S.init2(ts[8], 2 * FFN / 256, G, (int)blockIdx.x);
                S.ts1 = ts[1]; S.ts2 = ts[2]; S.ts3 = ts[3]; S.ts4 = ts[4]; S.ts5 = ts[5]; S.ts6 = ts[6]; S.ts7 = ts[7]; S.estride = FFNW_BYTES;
                pg8::EpiSwiglu E{BIG, FFN};
                GEMM_SITE(6) pg8::gemm_phase<pg8::EpiSwiglu, pg8::MoeOrder, true, true, true>(lds, g, S, E); }
            NEXT();
            if (RUN) { int ts[9]; if (moe) moe_tile_starts(a, l >> 1, s, ts); else {
#pragma unroll
                    for (int e = 0; e < 9; ++e) ts[e] = e ? NTILE : 0; }
                pg8::Gemm g{BIG, (const bf16_t*)(fw + FFNW_WD), FFN, FFN, nullptr}; pg8::MoeOrder S; S.init2(ts[8], D / 256, G, (int)blockIdx.x);
                S.ts1 = ts[1]; S.ts2 = ts[2]; S.ts3 = ts[3]; S.ts4 = ts[4]; S.ts5 = ts[5]; S.ts6 = ts[6]; S.ts7 = ts[7]; S.estride = FFNW_BYTES;
                const float* lnid = (const float*)(a->ws + WS_LNID);
                pg8::EpiScatter E{XS, MOD + (size_t)l * 17 * 6144 + 5 * 1024, perm, permw, (const float*)(a->ws + (s == 0 ? WS_STAT : WS_ZSTAT)), s == 0 ? a->in[I_LNG] + (size_t)(l * 2) * D : lnid, s == 0 ? a->in[I_LNB] + (size_t)(l * 2) * D : lnid + 1024, s == 0 ? ALPHA : 1.0f};
                if (!moe && nleft > 0) S.lim = dlim;
                GEMM_SITE(7) pg8::gemm_phase<pg8::EpiScatter, pg8::MoeOrder, true, true, false>(lds, g, S, E); }
            NEXT();
        }
        if (!moe && nleft > 0) {
            if (RUN) {
                if ((int)blockIdx.x < nleft) {
                    const unsigned char* fw = a->ws + WS_WFFN + (size_t)(l >> 1) * FFNW_BYTES;
                    pg8::Gemm g{BIG, (const bf16_t*)(fw + FFNW_WD), FFN, FFN, nullptr}; pg8::MoeOrder S; S.init2(NTILE, D / 256, G, (int)blockIdx.x); S.L0 = dlim;
                    S.ts1 = NTILE; S.ts2 = NTILE; S.ts3 = NTILE; S.ts4 = NTILE; S.ts5 = NTILE; S.ts6 = NTILE; S.ts7 = NTILE; S.estride = FFNW_BYTES;
                    pg8::EpiScatter E{XS, MOD + (size_t)l * 17 * 6144 + 5 * 1024, (const int*)(a->ws + WS_PERMID), nullptr, (const float*)(a->ws + WS_STAT), a->in[I_LNG] + (size_t)(l * 2) * D, a->in[I_LNB] + (size_t)(l * 2) * D, ALPHA};
                    GEMM_SITE(7) pg8::gemm_phase<pg8::EpiScatter, pg8::MoeOrder, true, true, false>(lds, g, S, E);
                } else { ROW_CALL(rowpass<2>(a, l, lds, 1, nleft, dlim)); } }
            NEXT();
            if (RUN) { ROW_CALL(rowpass<2>(a, l, lds, 2, 0, dlim)); }
            NEXT();
        } else {
        if (RUN) { ROW_CALL(rowpass<2>(a, l, lds)); }
        NEXT();
        }
    }
#undef RUN
#undef NEXT
}
}

extern "C" void kernel_launch(void* const* d_in, const int* in_sizes, int n_in, void* d_out, int out_size, void* d_ws, size_t ws_size, hipStream_t stream) {
    using namespace mk;
    static int grid = 0;
    if (grid == 0) {
        if (n_in != 24 || in_sizes[0] != NB * SEQ * D || out_size != NB * SEQ * D || ws_size < WS_END) {
            fprintf(stderr, "kernel_launch: unexpected shapes or workspace (n_in %d, in0 %d, out %d, ws %zu, need %zu); nothing launched\n", n_in, n_in > 0 ? in_sizes[0] : -1, out_size, ws_size, (size_t)WS_END); grid = -1; return; }
        int dev = 0, cus = 0, per_cu = 0;
        if (hipGetDevice(&dev) != hipSuccess || hipDeviceGetAttribute(&cus, hipDeviceAttributeMultiprocessorCount, dev) != hipSuccess) { grid = -1; return; }
        if (hipFuncSetAttribute((const void*)mk_fwd, hipFuncAttributeMaxDynamicSharedMemorySize, LDS_BYTES) != hipSuccess) { fprintf(stderr, "kernel_launch: hipFuncSetAttribute failed\n"); grid = -1; return; }
        if (hipOccupancyMaxActiveBlocksPerMultiprocessor(&per_cu, (const void*)mk_fwd, NTHR, LDS_BYTES) != hipSuccess || per_cu < 1) { fprintf(stderr, "kernel_launch: occupancy query reports %d\n", per_cu); }
        (void)hipGetLastError();
        grid = cus;
    }
    if (grid < 0) return;
    if (hipMemsetAsync((char*)d_ws + WS_CTL, 0, CTL_ZERO_BYTES, stream) != hipSuccess) return;
    Args a{};
    for (int i = 0; i < 24; ++i) a.in[i] = (const float*)d_in[i];
    a.out = (float*)d_out; a.ws = (unsigned char*)d_ws;
#if MK_ONE_LAUNCH
    a.ph_lo = 0; a.ph_hi = PH_TOTAL;
    hipLaunchKernelGGL(mk_fwd, dim3(grid), dim3(NTHR), LDS_BYTES, stream, a);
#else
    for (int p = 0; p < PH_TOTAL; ++p) { a.ph_lo = p; a.ph_hi = p + 1; hipLaunchKernelGGL(mk_fwd, dim3(grid), dim3(NTHR), LDS_BYTES, stream, a); }
#endif
}
```

```cpp
#include <hip/hip_runtime.h>
#include <cstdio>
#include <cstdint>
namespace pg8 {
#define PG8_LAS __attribute__((address_space(3)))
typedef unsigned short bf16_t;
typedef short bf16x8 __attribute__((ext_vector_type(8)));
typedef float f32x4 __attribute__((ext_vector_type(4)));
typedef unsigned u32x4 __attribute__((ext_vector_type(4)));
constexpr int BM = 256, BK = 64, HALF = 128, HTB = HALF * BK * 2  , STAGE_BYTES = 8 * HTB, NXCD = 8, WGM = 4;

__host__ __device__ __forceinline__ int lds_byte(int r, int c) { const int st = (r >> 4) * 2 + (c >> 5), rr = r & 15, cc = c & 31, ob = rr * 64 + cc * 2; return st * 1024 + (ob ^ (((ob >> 9) & 1) << 5)); }
__host__ __device__ __forceinline__ void stage_rc(int b, int& R, int& C) { const int st = b / 1024, sb = b % 1024, swz = sb ^ (((sb >> 9) & 1) << 5); R = (st >> 1) * 16 + swz / 64; C = (st & 1) * 32 + (swz % 64) / 2; }
__host__ __device__ __forceinline__ int perm32(int rho) { const int n = rho >> 4, i = rho & 15; return 8 * (i >> 2) + 4 * n + (i & 3); }

struct Unit { int pm, pn; };
struct Gemm { const bf16_t* A; const bf16_t* Bt; int lda, K; const int* perm; };

struct StaticOrder {
    int nM, nN, nwg, G, c, lat;
    int L0, lim;
    int gap0, gaplen;
    __host__ __device__ void init(int M, int N, int G_, int c_) { nM = M / BM; nN = N / BM; nwg = nM * nN; G = G_; c = c_; lat = 0; L0 = 0; lim = nwg; gap0 = 0x7fffffff; gaplen = 0; }
    __host__ __device__ bool next(int i, Unit& u) const {
        const long Lp = (long)i * G + c + L0; if (Lp >= lim) return false;
        const long L = Lp + (Lp >= gap0 ? gaplen : 0);
        int wgid = (int)L; { const int q = nwg / NXCD, r = nwg % NXCD, xcd = wgid % NXCD, off = wgid / NXCD; wgid = (xcd < r ? xcd * (q + 1) : r * (q + 1) + (xcd - r) * q) + off; }
        const int nig = WGM * nN, gid = wgid / nig, fm = gid * WGM, gsz = (nM - fm) < WGM ? (nM - fm) : WGM;
        u.pm = fm + ((wgid % nig) % gsz); u.pn = (wgid % nig) / gsz; if (lat) u.pm += u.pm / 16 + 1; return true;
    }
    __host__ __device__ int pos_of(int pm, int pn) const {
        const int fm = (pm / WGM) * WGM, gsz = (nM - fm) < WGM ? (nM - fm) : WGM, wgid = (pm / WGM) * (WGM * nN) + pn * gsz + (pm - fm);
        const int q = nwg / NXCD, r = nwg % NXCD; int xcd, off;
        if (wgid < r * (q + 1)) { xcd = wgid / (q + 1); off = wgid % (q + 1); } else { const int w2 = wgid - r * (q + 1); xcd = r + w2 / q; off = w2 % q; }
        return off * NXCD + xcd; }
    __device__ __forceinline__ void a_ready(const Unit&) const {}
    __device__ __forceinline__ void done(const Unit&) const {}
    __device__ __forceinline__ size_t a_off(const Unit& u, int lda) const { return (size_t)u.pm * BM * lda * 2; }
    __device__ __forceinline__ size_t b_off(const Unit& u, int K) const { return (size_t)u.pn * BM * K * 2; }
};

typedef float f32x2c_t __attribute__((ext_vector_type(2)));
typedef __bf16 bf16x2c_t __attribute__((ext_vector_type(2)));
__device__ __forceinline__ unsigned cvt_pk_bf16(float lo, float hi) { const f32x2c_t v = {lo, hi}; return __builtin_bit_cast(unsigned, __builtin_convertvector(v, bf16x2c_t)); }
typedef float f32x2 __attribute__((ext_vector_type(2)));
__device__ __forceinline__ float bf2f(unsigned short b) { return __uint_as_float(((unsigned)b) << 16); }
__device__ __forceinline__ float sigm(float x) { return 1.0f / (1.0f + __expf(-x)); }
__device__ __forceinline__ void sigm2(float a, float b, float& sa, float& sb) { const float da = 1.0f + __expf(fminf(-a, 40.0f)), db = 1.0f + __expf(fminf(-b, 40.0f)); const float r = __builtin_amdgcn_rcpf(da * db); sa = r * db; sb = r * da; }
__device__ __forceinline__ int mi_of_pm(int pm) { const int b = pm / 17, j = pm - b * 17; return j == 0 ? 16 : b; }

template <int BANKS> __device__ __forceinline__ unsigned dpp_ror8_upd(unsigned old, unsigned v) { return (unsigned)__builtin_amdgcn_update_dpp((int)old, (int)v, 0x128, 0xf, BANKS, false); }
__device__ __forceinline__ void store_pair_lines(bf16_t* p, int ldc, int fr, u32x4 w0, u32x4 w1) {
    u32x4 s1, s2;
#pragma unroll
    for (int j = 0; j < 4; ++j) { s1[j] = dpp_ror8_upd<0xC>(w0[j], w1[j]); s2[j] = dpp_ror8_upd<0x3>(w1[j], w0[j]); }
    bf16_t* q = p + (fr < 8 ? 0 : 32);
    *(u32x4*)q = s1; *(u32x4*)(q + (size_t)8 * ldc) = s2;
}
struct EpiP {
    static constexpr bool PERM = true, AFTER_DRAIN = false, MID = false;
    bf16_t* O; int ldc; float* SC; int sc_pn; int act; int pn_shift;
    const float* oml; int fg_lo, fg_hi;
    __device__ __forceinline__ void operator()(const f32x4 (&acc)[2][2][4][2], const Unit& u, int wr, int wc, int fr, int fq) const {
        const int row0 = u.pm * BM + wr * 64 + fr;
        if (u.pn == sc_pn) {
            if (wc == 0) {
#pragma unroll
                for (int ai = 0; ai < 2; ++ai)
#pragma unroll
                    for (int m = 0; m < 4; ++m) { float* rp = SC + (size_t)(row0 + ai * HALF + m * 16) * 32 + 8 * fq;
#pragma unroll
                        for (int n = 0; n < 2; ++n) *(f32x4*)(rp + 4 * n) = acc[ai][0][m][n]; }
            }
            return;
        }
        const int col0 = (u.pn - pn_shift) * BM + wc * 64 + 8 * fq;
        const bool fg = u.pn >= fg_lo && u.pn < fg_hi;
        f32x4 om[2][2];
        if (fg) {
#pragma unroll
            for (int bj = 0; bj < 2; ++bj)
#pragma unroll
                for (int n = 0; n < 2; ++n) om[bj][n] = *(const f32x4*)(oml + ((col0 + 32 * bj + 4 * n) & 511)); }
#pragma unroll
        for (int ai = 0; ai < 2; ++ai)
#pragma unroll
            for (int m = 0; m < 4; ++m) { bf16_t* rowp = O + (size_t)(u.pm * BM + wr * 64 + ai * HALF + m * 16 + (fr & 7)) * ldc + col0;
                u32x4 w[2];
#pragma unroll
                for (int bj = 0; bj < 2; ++bj) { f32x4 v0 = acc[ai][bj][m][0], v1 = acc[ai][bj][m][1];
                    if (act) {
#pragma unroll
                        for (int j = 0; j < 4; ++j) { v0[j] = __builtin_amdgcn_rcpf(1.0f + __builtin_amdgcn_exp2f(-v0[j])); v1[j] = __builtin_amdgcn_rcpf(1.0f + __builtin_amdgcn_exp2f(-v1[j])); } }
                    if (fg) {
#pragma unroll
                        for (int j = 0; j < 4; ++j) { v0[j] = om[bj][0][j] * __builtin_amdgcn_rcpf(1.0f + __builtin_amdgcn_exp2f(v0[j])); v1[j] = om[bj][1][j] * __builtin_amdgcn_rcpf(1.0f + __builtin_amdgcn_exp2f(v1[j])); } }
                    w[bj].x = cvt_pk_bf16(v0[0], v0[1]); w[bj].y = cvt_pk_bf16(v0[2], v0[3]); w[bj].z = cvt_pk_bf16(v1[0], v1[1]); w[bj].w = cvt_pk_bf16(v1[2], v1[3]); }
                store_pair_lines(rowp, ldc, fr, w[0], w[1]); }
    }
};
struct EpiMixed {
    static constexpr bool PERM = true, AFTER_DRAIN = false, MID = true;
    const bf16_t* G; bf16_t* O;
    __device__ __forceinline__ void mid(f32x4 (&acc)[2][2][4][2], const Unit& u, int seg, int wr, int wc, int fr, int fq) const {
        int row0 = u.pm * BM + wr * 64 + fr, col0 = u.pn * BM + wc * 64 + 8 * fq; asm volatile("" : "+v"(row0), "+v"(col0));
        u32x4 ga[2][2], gb[2][2];
#define MIX_LOAD(g_, buf_) do { const bf16_t* gp_ = G + (size_t)(row0 + ((g_) >> 2) * HALF + ((g_) & 3) * 16) * 3072 + (seg - 1) * 1024 + col0; \
            ga[buf_][0] = *(const u32x4*)gp_; gb[buf_][0] = *(const u32x4*)(gp_ + 1024); ga[buf_][1] = *(const u32x4*)(gp_ + 32); gb[buf_][1] = *(const u32x4*)(gp_ + 1024 + 32); } while (0)
        MIX_LOAD(0, 0);
#pragma unroll
        for (int g = 0; g < 8; ++g) { const int ai = g >> 2, m = g & 3, cb = g & 1;
            if (g + 1 < 8) MIX_LOAD(g + 1, cb ^ 1);
#pragma unroll
            for (int bj = 0; bj < 2; ++bj) { const u32x4 xa = ga[cb][bj], xb = gb[cb][bj];
                f32x4 r0, r1;
#pragma unroll
                for (int j = 0; j < 2; ++j) {
                    r0[2 * j] = __uint_as_float(xa[j] << 16) * __builtin_amdgcn_rcpf(fmaxf(__uint_as_float(xb[j] << 16), 1e-30f)); r0[2 * j + 1] = __uint_as_float(xa[j] & 0xffff0000u) * __builtin_amdgcn_rcpf(fmaxf(__uint_as_float(xb[j] & 0xffff0000u), 1e-30f));
                    r1[2 * j] = __uint_as_float(xa[2 + j] << 16) * __builtin_amdgcn_rcpf(fmaxf(__uint_as_float(xb[2 + j] << 16), 1e-30f)); r1[2 * j + 1] = __uint_as_float(xa[2 + j] & 0xffff0000u) * __builtin_amdgcn_rcpf(fmaxf(__uint_as_float(xb[2 + j] & 0xffff0000u), 1e-30f)); }
                acc[ai][bj][m][0] *= r0; acc[ai][bj][m][1] *= r1; }
            asm volatile("" ::: "memory"); __builtin_amdgcn_sched_barrier(0); }
#undef MIX_LOAD
    }
    __device__ __forceinline__ void operator()(const f32x4 (&acc)[2][2][4][2], const Unit& u, int wr, int wc, int fr, int fq) const {
        const int row0 = u.pm * BM + wr * 64, col0 = u.pn * BM + wc * 64 + 8 * fq;
#pragma unroll
        for (int ai = 0; ai < 2; ++ai)
#pragma unroll
            for (int m = 0; m < 4; ++m) { const size_t rowb = (size_t)(row0 + ai * HALF + m * 16); const bf16_t* gp = G + (rowb + fr) * 3072 + 2048 + col0;
                u32x4 w[2];
#pragma unroll
                for (int bj = 0; bj < 2; ++bj) { const f32x4 v0 = acc[ai][bj][m][0], v1 = acc[ai][bj][m][1]; const u32x4 g = *(const u32x4*)(gp + bj * 32);
                    w[bj].x = cvt_pk_bf16(v0[0] * __uint_as_float(g.x << 16), v0[1] * __uint_as_float(g.x & 0xffff0000u));
                    w[bj].y = cvt_pk_bf16(v0[2] * __uint_as_float(g.y << 16), v0[3] * __uint_as_float(g.y & 0xffff0000u));
                    w[bj].z = cvt_pk_bf16(v1[0] * __uint_as_float(g.z << 16), v1[1] * __uint_as_float(g.z & 0xffff0000u));
                    w[bj].w = cvt_pk_bf16(v1[2] * __uint_as_float(g.w << 16), v1[3] * __uint_as_float(g.w & 0xffff0000u)); }
                store_pair_lines(O + (rowb + (fr & 7)) * 1024 + col0, 1024, fr, w[0], w[1]); }
    }
};
struct EpiSwiglu {
    static constexpr bool PERM = true, AFTER_DRAIN = false, MID = false;
    bf16_t* O; int ldc;
    __device__ __forceinline__ void operator()(const f32x4 (&acc)[2][2][4][2], const Unit& u, int wr, int wc, int fr, int fq) const {
        const int row0 = u.pm * BM + wr * 64 + fr, col0 = u.pn * HALF + wc * 32 + 8 * fq;
#pragma unroll
        for (int ai = 0; ai < 2; ++ai)
#pragma unroll
            for (int m = 0; m < 4; ++m) { bf16_t* rowp = O + (size_t)(row0 + ai * HALF + m * 16) * ldc + col0;
                f32x4 v0, v1;
#pragma unroll
                for (int j = 0; j < 4; ++j) { const float g0 = acc[ai][0][m][0][j], g1 = acc[ai][0][m][1][j];
                    v0[j] = g0 * __builtin_amdgcn_rcpf(1.0f + __builtin_amdgcn_exp2f(-g0)) * acc[ai][1][m][0][j]; v1[j] = g1 * __builtin_amdgcn_rcpf(1.0f + __builtin_amdgcn_exp2f(-g1)) * acc[ai][1][m][1][j]; }
                u32x4 w; w.x = cvt_pk_bf16(v0[0], v0[1]); w.y = cvt_pk_bf16(v0[2], v0[3]); w.z = cvt_pk_bf16(v1[0], v1[1]); w.w = cvt_pk_bf16(v1[2], v1[3]);
                *(u32x4*)rowp = w; }
    }
};
struct EpiRes {
    static constexpr bool PERM = false, AFTER_DRAIN = false, MID = false;
    float* X; const float* mod; const float* stat; const float* lng; const float* lnb;
    const float* inx; const float* inc; float alpha; int first;
    __device__ __forceinline__ void operator()(const f32x4 (&acc)[2][2][4][2], const Unit& u, int wr, int wc, int fr, int fq) const {
        const int row0 = u.pm * BM + wr * 64 + fr, col0 = u.pn * BM + wc * 32 + 4 * fq;
        const float* mp = mod + (size_t)mi_of_pm(u.pm) * 6144 + col0;
        const int ib = u.pm / 17, ij = u.pm - ib * 17;
        const unsigned long long a_x = (unsigned long long)X + (unsigned long long)(u.pm * BM) * 4096ull, a_c = (unsigned long long)inc + (unsigned long long)(ib * 256) * 4096ull, a_i = (unsigned long long)inx + (unsigned long long)(ib * 4096 + (ij - 1) * 256) * 4096ull;
        const unsigned long long a_sel = first ? (ij == 0 ? a_c : a_i) : a_x;
        const __attribute__((address_space(1))) float* rsrc = (const __attribute__((address_space(1))) float*)(a_sel + (unsigned long long)((wr * 64 + fr) * 1024 + col0) * 4ull);
        f32x4 gv[2][2], lg[2][2], lb[2][2];
#pragma unroll
        for (int bj = 0; bj < 2; ++bj)
#pragma unroll
            for (int n = 0; n < 2; ++n) { gv[bj][n] = *(const f32x4*)(mp + bj * HALF + n * 16); lg[bj][n] = *(const f32x4*)(lng + col0 + bj * HALF + n * 16); lb[bj][n] = *(const f32x4*)(lnb + col0 + bj * HALF + n * 16); }
#pragma unroll
        for (int bj = 0; bj < 2; ++bj)
#pragma unroll
            for (int n = 0; n < 2; ++n) lb[bj][n] *= alpha;
#pragma unroll
        for (int ai = 0; ai < 2; ++ai)
#pragma unroll
            for (int m = 0; m < 4; ++m) { const int row = row0 + ai * HALF + m * 16; float* rowp = X + (size_t)row * 1024 + col0;
                const f32x2 st = *(const f32x2*)(stat + (size_t)row * 2); const float ar = alpha * (st.y + 1.0f), br = -st.x * ar;
#pragma unroll
                for (int bj = 0; bj < 2; ++bj)
#pragma unroll
                    for (int n = 0; n < 2; ++n) { const f32x4 x = *(const __attribute__((address_space(1))) f32x4*)(rsrc + (size_t)(ai * HALF + m * 16) * 1024 + bj * HALF + n * 16);
                        *(f32x4*)(rowp + bj * HALF + n * 16) = lg[bj][n] * (x * ar + br) + lb[bj][n] + gv[bj][n] * acc[ai][bj][m][n]; } }
    }
};
struct EpiScatter {
    static constexpr bool PERM = false, AFTER_DRAIN = false, MID = false;
    float* X; const float* mod; const int* perm; const float* permw; const float* stat; const float* lng; const float* lnb; float alpha;
    __device__ __forceinline__ void operator()(const f32x4 (&acc)[2][2][4][2], const Unit& u, int wr, int wc, int fr, int fq) const {
        const int row0 = u.pm * BM + wr * 64 + fr, col0 = u.pn * BM + wc * 32 + 4 * fq;
        f32x4 lg[2][2], lb[2][2];
#pragma unroll
        for (int bj = 0; bj < 2; ++bj)
#pragma unroll
            for (int n = 0; n < 2; ++n) { lg[bj][n] = *(const f32x4*)(lng + col0 + bj * HALF + n * 16); lb[bj][n] = *(const f32x4*)(lnb + col0 + bj * HALF + n * 16); }
#pragma unroll
        for (int bj = 0; bj < 2; ++bj)
#pragma unroll
            for (int n = 0; n < 2; ++n) lb[bj][n] *= alpha;
#pragma unroll
        for (int ai = 0; ai < 2; ++ai)
#pragma unroll
            for (int m = 0; m < 4; ++m) { const int r = row0 + ai * HALF + m * 16; const int tok = perm[r];
                if (tok >= 0) { const float w = permw ? permw[r] : 1.0f; const int b = tok / 4352, p = tok - b * 4352; const int mi = p < 256 ? 16 : b;
                    const float* mp = mod + (size_t)mi * 6144 + col0; float* rowp = X + (size_t)tok * 1024 + col0;
                    const f32x2 st = *(const f32x2*)(stat + (size_t)tok * 2); const float ar = alpha * (st.y + 1.0f), br = -st.x * ar;
#pragma unroll
                    for (int bj = 0; bj < 2; ++bj)
#pragma unroll
                        for (int n = 0; n < 2; ++n) { const f32x4 gv = *(const f32x4*)(mp + bj * HALF + n * 16); const f32x4 x = *(const f32x4*)(rowp + bj * HALF + n * 16);
                            *(f32x4*)(rowp + bj * HALF + n * 16) = lg[bj][n] * (x * ar + br) + lb[bj][n] + (gv * w) * acc[ai][bj][m][n]; } } }
    }
};
struct MoeOrder : StaticOrder {
    int ts1, ts2, ts3, ts4, ts5, ts6, ts7; size_t estride;
    __device__ __forceinline__ void init2(int nM_, int nN_, int G_, int c_) { nM = nM_; nN = nN_; nwg = nM * nN; G = G_; c = c_; lat = 0; L0 = 0; lim = nwg; gap0 = 0x7fffffff; gaplen = 0; }
    __device__ __forceinline__ size_t b_off(const Unit& u, int K) const {
        const int e = (u.pm >= ts1) + (u.pm >= ts2) + (u.pm >= ts3) + (u.pm >= ts4) + (u.pm >= ts5) + (u.pm >= ts6) + (u.pm >= ts7);
        return (size_t)e * estride + (size_t)u.pn * BM * K * 2; }
};

template <class Epi, class Sched, bool ALIGN_EPI = false, bool SP2 = false, bool GATHER = false>
__device__ __forceinline__ void gemm_phase(PG8_LAS unsigned char* lds, const Gemm g, const Sched& S, const Epi& E) {
    int tid_ = threadIdx.x; asm volatile("" : "+v"(tid_));
    const int tid = tid_, wid = __builtin_amdgcn_readfirstlane(tid >> 6), lane = tid & 63, wr = wid >> 2, wc = wid & 3, fr = lane & 15, fq = lane >> 4;
    const int K = g.K, nt = K / BK;
    unsigned voffA[2], voffB[2];
#pragma unroll
    for (int i = 0; i < 2; ++i) { int R, C; stage_rc(tid * 16 + i * 8192, R, C); const int Rb = Epi::PERM ? ((R & ~31) + perm32(R & 31)) : R;
        voffA[i] = (unsigned)(R * g.lda + C) * 2u; voffB[i] = (unsigned)(Rb * K + C) * 2u; }
    const size_t kstep = (size_t)(BK * 2);
    const size_t hstepA = (size_t)HALF * g.lda * 2, hstepB = (size_t)HALF * K * 2;
    const unsigned ldsw = (unsigned)wid * 1024u;
    const int aoff = lds_byte(wr * 64 + fr, fq * 8), boff = lds_byte(wc * 32 + fr, fq * 8);
#define PG8_SA(b, h) (((b) * 2 + (h)) * HTB)
#define PG8_SB(b, h) ((4 + (b) * 2 + (h)) * HTB)
#define PG8_STAGE(bufoff, gbase, voff) do { _Pragma("unroll") for (int _i = 0; _i < 2; ++_i) \
        __builtin_amdgcn_global_load_lds((const unsigned*)((const char*)(gbase) + (voff)[_i]), (PG8_LAS unsigned*)(lds + (bufoff) + ldsw + _i * 8192), 16, 0, 0); } while (0)
#define PG8_STAGE_A(bufoff, kptr, h, nx) do { if constexpr (GATHER) { _Pragma("unroll") for (int _i = 0; _i < 2; ++_i) { const unsigned _vo = (nx) ? vN[h][_i] : vC[h][_i]; \
        __builtin_amdgcn_global_load_lds((const unsigned*)((const char*)(kptr) + _vo), (PG8_LAS unsigned*)(lds + (bufoff) + ldsw + _i * 8192), 16, 0, 0); } } \
    else { PG8_STAGE(bufoff, (kptr) + (h) * hstepA, voffA); } } while (0)
#define PG8_LOADR(RW, u) do { _Pragma("unroll") for (int _h = 0; _h < 2; ++_h) _Pragma("unroll") for (int _i = 0; _i < 2; ++_i) { int _R, _C; stage_rc(tid * 16 + _i * 8192, _R, _C); \
        RW[_h][_i] = g.perm[(u).pm * BM + _h * HALF + _R]; } } while (0)
#define PG8_CONV(V, RW) do { _Pragma("unroll") for (int _h = 0; _h < 2; ++_h) _Pragma("unroll") for (int _i = 0; _i < 2; ++_i) { int _R, _C; stage_rc(tid * 16 + _i * 8192, _R, _C); \
        int _ix = RW[_h][_i]; _ix = _ix < 0 ? 0 : _ix; V[_h][_i] = (unsigned)(_ix * g.lda + _C) * 2u; } } while (0)
#define PG8_LDA(dst, b, h) do { _Pragma("unroll") for (int m = 0; m < 4; ++m) _Pragma("unroll") for (int k = 0; k < 2; ++k) dst[m][k] = *(const PG8_LAS bf16x8*)(lds + PG8_SA(b, h) + aoff + m * 2048 + k * 1024); } while (0)
#define PG8_LDB(dst, b, h) do { _Pragma("unroll") for (int n = 0; n < 2; ++n) _Pragma("unroll") for (int k = 0; k < 2; ++k) dst[n][k] = *(const PG8_LAS bf16x8*)(lds + PG8_SB(b, h) + boff + n * 2048 + k * 1024); } while (0)
#define PG8_MMA(ai, bj, At, Bt) do { __builtin_amdgcn_s_setprio(1); _Pragma("unroll") for (int m = 0; m < 4; ++m) _Pragma("unroll") for (int n = 0; n < 2; ++n) _Pragma("unroll") for (int k = 0; k < 2; ++k) \
        acc[ai][bj][m][n] = __builtin_amdgcn_mfma_f32_16x16x32_bf16(Bt[n][k], At[m][k], acc[ai][bj][m][n], 0, 0, 0); __builtin_amdgcn_s_setprio(0); } while (0)
#define PG8_WAIT_V(n) asm volatile("s_waitcnt vmcnt(" #n ")" ::: "memory")
#define PG8_WAIT_L(n) asm volatile("s_waitcnt lgkmcnt(" #n ")" ::: "memory")
#define PG8_BAR __builtin_amdgcn_s_barrier()
#define PG8_SCHED __builtin_amdgcn_sched_barrier(0)
    Unit cur, nxt; int ui = 0;
    if (!S.next(0, cur)) return;
    f32x4 acc[2][2][4][2];
#pragma unroll
    for (int a = 0; a < 2; ++a)
#pragma unroll
        for (int b = 0; b < 2; ++b)
#pragma unroll
            for (int m = 0; m < 4; ++m)
#pragma unroll
                for (int n = 0; n < 2; ++n) acc[a][b][m][n] = (f32x4){0.f, 0.f, 0.f, 0.f};
    bf16x8 At[4][2], B0[2][2], B1[2][2];
    const char* cA = (const char*)g.A + (GATHER ? (size_t)0 : S.a_off(cur, g.lda)); const char* cB = (const char*)g.Bt + S.b_off(cur, K);
    unsigned vC[2][2], vN[2][2];
    int rN[2][2];
    if constexpr (GATHER) { int rC[2][2]; PG8_LOADR(rC, cur); Unit n1; if (S.next(1, n1)) PG8_LOADR(rN, n1); PG8_CONV(vC, rC); }
    S.a_ready(cur);
    if constexpr (SP2) {
        PG8_STAGE(PG8_SB(0, 0), cB, voffB); PG8_STAGE(PG8_SB(0, 1), cB + hstepB, voffB); PG8_STAGE_A(PG8_SA(0, 0), cA, 0, false); PG8_STAGE_A(PG8_SA(0, 1), cA, 1, false);
        if (wr == 1) PG8_BAR;
        PG8_WAIT_V(2); PG8_BAR;
        PG8_STAGE(PG8_SB(1, 0), cB + kstep, voffB); PG8_STAGE_A(PG8_SA(1, 0), cA + kstep, 0, false); PG8_STAGE(PG8_SB(1, 1), cB + hstepB + kstep, voffB);
        PG8_WAIT_V(6); PG8_BAR;
    } else {
        PG8_STAGE(PG8_SB(0, 0), cB, voffB); PG8_STAGE_A(PG8_SA(0, 0), cA, 0, false); PG8_STAGE(PG8_SB(0, 1), cB + hstepB, voffB); PG8_STAGE_A(PG8_SA(0, 1), cA, 1, false);
        if (wr == 1) PG8_BAR;
        PG8_WAIT_V(4); PG8_BAR;
        PG8_STAGE(PG8_SB(1, 0), cB + kstep, voffB); PG8_STAGE_A(PG8_SA(1, 0), cA + kstep, 0, false); PG8_STAGE(PG8_SB(1, 1), cB + hstepB + kstep, voffB);
        PG8_WAIT_V(6); PG8_BAR;
    }
    for (;;) {
        const bool has_next = S.next(ui + 1, nxt);
        const char* nA = has_next ? (const char*)g.A + (GATHER ? (size_t)0 : S.a_off(nxt, g.lda)) : cA; const char* nB = has_next ? (const char*)g.Bt + S.b_off(nxt, K) : cB;
        if constexpr (GATHER) { if (has_next) PG8_CONV(vN, rN); else { vN[0][0] = vC[0][0]; vN[0][1] = vC[0][1]; vN[1][0] = vC[1][0]; vN[1][1] = vC[1][1]; }
            Unit n2; if (S.next(ui + 2, n2)) PG8_LOADR(rN, n2); }
        for (int t = 0; t < nt; t += 2) {
            const bool last = (t == nt - 2);
            const char* a1 = cA + (size_t)(t + 1) * kstep;
            const char* a2 = last ? nA : cA + (size_t)(t + 2) * kstep; const char* b2 = last ? nB : cB + (size_t)(t + 2) * kstep;
            const char* a3 = a2 + kstep; const char* b3 = b2 + kstep;
            if (last && has_next) S.a_ready(nxt);
            if constexpr (SP2) {
            PG8_LDB(B0, 0, 0); PG8_LDB(B1, 0, 1); PG8_SCHED; PG8_LDA(At, 0, 0); PG8_STAGE_A(PG8_SA(1, 1), a1, 1, false);
            PG8_WAIT_V(8); PG8_WAIT_L(0); PG8_BAR; PG8_MMA(0, 0, At, B0); PG8_MMA(0, 1, At, B1); PG8_BAR; PG8_SCHED;
            PG8_LDA(At, 0, 1); PG8_STAGE(PG8_SB(0, 0), b2, voffB); PG8_STAGE(PG8_SB(0, 1), b2 + hstepB, voffB); PG8_STAGE_A(PG8_SA(0, 0), a2, 0, last);
            PG8_WAIT_V(8); PG8_WAIT_L(0); PG8_BAR; PG8_MMA(1, 0, At, B0); PG8_MMA(1, 1, At, B1); PG8_BAR; PG8_SCHED;
            PG8_LDB(B0, 1, 0); PG8_LDB(B1, 1, 1); PG8_SCHED; PG8_LDA(At, 1, 0); PG8_STAGE_A(PG8_SA(0, 1), a2, 1, last);
            PG8_WAIT_V(8); PG8_WAIT_L(0); PG8_BAR; PG8_MMA(0, 0, At, B0); PG8_MMA(0, 1, At, B1); PG8_BAR; PG8_SCHED;
            PG8_LDA(At, 1, 1); PG8_STAGE(PG8_SB(1, 0), b3, voffB); PG8_STAGE(PG8_SB(1, 1), b3 + hstepB, voffB); PG8_STAGE_A(PG8_SA(1, 0), a3, 0, last);
            PG8_WAIT_V(8); PG8_WAIT_L(0); PG8_BAR; PG8_MMA(1, 0, At, B0); PG8_MMA(1, 1, At, B1); PG8_BAR; PG8_SCHED;
            } else {
            PG8_LDB(B0, 0, 0); PG8_SCHED; PG8_LDA(At, 0, 0); PG8_STAGE_A(PG8_SA(1, 1), a1, 1, false);
            PG8_WAIT_L(8); PG8_BAR; PG8_WAIT_L(0); PG8_MMA(0, 0, At, B0); PG8_BAR; PG8_SCHED;
            PG8_LDB(B1, 0, 1); PG8_STAGE(PG8_SB(0, 0), b2, voffB);
            PG8_BAR; PG8_WAIT_L(0); PG8_MMA(0, 1, At, B1); PG8_BAR;
            PG8_LDA(At, 0, 1); PG8_STAGE_A(PG8_SA(0, 0), a2, 0, last);
            PG8_BAR; PG8_WAIT_L(0); PG8_MMA(1, 0, At, B0); PG8_BAR; PG8_SCHED;
            PG8_STAGE(PG8_SB(0, 1), b2 + hstepB, voffB);
            PG8_WAIT_V(6); PG8_BAR; PG8_MMA(1, 1, At, B1); PG8_BAR;
            PG8_LDB(B0, 1, 0); PG8_SCHED; PG8_LDA(At, 1, 0); PG8_STAGE_A(PG8_SA(0, 1), a2, 1, last);
            PG8_WAIT_L(8); PG8_BAR; PG8_WAIT_L(0); PG8_MMA(0, 0, At, B0); PG8_BAR; PG8_SCHED;
            PG8_LDB(B1, 1, 1); PG8_STAGE(PG8_SB(1, 0), b3, voffB);
            PG8_BAR; PG8_WAIT_L(0); PG8_MMA(0, 1, At, B1); PG8_BAR;
            PG8_LDA(At, 1, 1); PG8_STAGE_A(PG8_SA(1, 0), a3, 0, last);
            PG8_BAR; PG8_WAIT_L(0); PG8_MMA(1, 0, At, B0); PG8_BAR; PG8_SCHED;
            PG8_STAGE(PG8_SB(1, 1), b3 + hstepB, voffB);
            PG8_WAIT_V(6); PG8_BAR; PG8_MMA(1, 1, At, B1); PG8_BAR;
            }
            if constexpr (Epi::MID) { if (((t + 2) & 7) == 0 && t + 2 < nt) E.mid(acc, cur, (t + 2) >> 3, wr, wc, fr, fq); }
        }
        if constexpr (ALIGN_EPI) { if (wr == 0) PG8_BAR; }
        if constexpr (!Epi::AFTER_DRAIN) { E(acc, cur, wr, wc, fr, fq); S.done(cur); }
        if (!has_next) break;
#pragma unroll
        for (int a = 0; a < 2; ++a)
#pragma unroll
            for (int b = 0; b < 2; ++b)
#pragma unroll
                for (int m = 0; m < 4; ++m)
#pragma unroll
                    for (int n = 0; n < 2; ++n) acc[a][b][m][n] = (f32x4){0.f, 0.f, 0.f, 0.f};
        cur = nxt; cA = nA; cB = nB; ++ui;
        if constexpr (GATHER) { vC[0][0] = vN[0][0]; vC[0][1] = vN[0][1]; vC[1][0] = vN[1][0]; vC[1][1] = vN[1][1]; }
        if constexpr (ALIGN_EPI) { if (wr == 1) PG8_BAR; }
    }
    PG8_WAIT_V(0);
    if constexpr (!ALIGN_EPI) { if (wr == 0) PG8_BAR; }
    PG8_BAR;
    if constexpr (Epi::AFTER_DRAIN) { E.fused(acc, cur, wr, wc, fr, fq, lds, wid, lane); S.done(cur); }
#undef PG8_SA
#undef PG8_SB
#undef PG8_STAGE
#undef PG8_STAGE_A
#undef PG8_LOADR
#undef PG8_CONV
#undef PG8_LDA
#undef PG8_LDB
#undef PG8_MMA
#undef PG8_WAIT_V
#undef PG8_WAIT_L
#undef PG8_BAR
#undef PG8_SCHED
}
}
namespace mk {
#define GAS __attribute__((address_space(1)))
#define LAS __attribute__((address_space(3)))
typedef unsigned short bf16;
typedef unsigned v4u __attribute__((ext_vector_type(4)));
typedef GAS unsigned gu32;
typedef GAS unsigned long long gu64;
#define RLX_AGENT __ATOMIC_RELAXED, __HIP_MEMORY_SCOPE_AGENT
#define LDS_WAIT() asm volatile("s_waitcnt lgkmcnt(0)" ::: "memory")
#define VM_WAIT() asm volatile("s_waitcnt vmcnt(0)" ::: "memory")
__device__ __forceinline__ unsigned long long rt() { return __builtin_amdgcn_s_memrealtime(); }
__device__ __forceinline__ unsigned f2bf(float f) { unsigned u = __builtin_bit_cast(unsigned, f); return (u + 0x7fffu + ((u >> 16) & 1u)) >> 16; }
__device__ __forceinline__ unsigned pk2(float lo, float hi) { return f2bf(lo) | (f2bf(hi) << 16); }

#define XB_TMO      128
#define XB_XCNT(j)  (256  + 64 * (j))
#define XB_XSUB(j)  (1280 + 64 * (j))
#define XB_XGEN(j)  (2304 + 64 * (j))
#define XB_TOP      3328
#define XB_TOPGEN   3392
#define XCD_BAR_WORDS 3456
#define XB_SPIN_CAP (1u << 20)

__device__ __forceinline__ unsigned xb_ld(unsigned* p)              { return __hip_atomic_load(p, __ATOMIC_RELAXED, __HIP_MEMORY_SCOPE_AGENT); }
__device__ __forceinline__ unsigned xb_add(unsigned* p, unsigned v) { return __hip_atomic_fetch_add(p, v, __ATOMIC_RELAXED, __HIP_MEMORY_SCOPE_AGENT); }
__device__ __forceinline__ unsigned xb_xcc_id() { return (unsigned)__builtin_amdgcn_s_getreg((3 << 11) | 20) & 0xFu; }
#define XB_SPIN(cond, bar) do { unsigned _sp = 0; while (cond) { __builtin_amdgcn_s_sleep(1); \
    if ((++_sp & 255u) == 0u) { if (xb_ld(&(bar)[XB_TMO])) break; if (_sp > XB_SPIN_CAP) { atomicAdd(&(bar)[XB_TMO], 1u); break; } } } } while (0)

struct XcdBarrier {
    unsigned* bar; unsigned x;
    volatile LAS unsigned* st;
};

__device__ __forceinline__ XcdBarrier xcd_barrier_post(unsigned* bar, volatile LAS unsigned* st) {
    XcdBarrier b; b.bar = bar; b.x = xb_xcc_id(); b.st = st;
    if (threadIdx.x == 0) (void)xb_add(&bar[XB_XCNT(b.x)], 1u);
    return b;
}
__device__ __forceinline__ void xcd_barrier_complete(unsigned* bar, unsigned x, unsigned& nloc, unsigned& nx) {
    const unsigned G = gridDim.x * gridDim.y * gridDim.z;
    unsigned sum, cnt, mine, sp = 0u;
    for (;;) {
        sum = 0u; cnt = 0u; mine = 0u;
#pragma unroll
        for (unsigned j = 0; j < 16; ++j) { const unsigned c = xb_ld(&bar[XB_XCNT(j)]); sum += c; cnt += (c > 0u) ? 1u : 0u; mine = (j == x) ? c : mine; }
        if (sum == G) break;
        __builtin_amdgcn_s_sleep(1);
        if ((++sp & 255u) == 0u) { if (xb_ld(&bar[XB_TMO])) break; if (sp > XB_SPIN_CAP) { atomicAdd(&bar[XB_TMO], 1u); break; } }
    }
    nloc = mine > 0u ? mine : 1u; nx = cnt > 0u ? cnt : 1u;
}

__device__ __forceinline__ void xcd_barrier(const XcdBarrier& b) {
    asm volatile("s_waitcnt vmcnt(0)" ::: "memory");
    __syncthreads();
    if (threadIdx.x == 0) {
        unsigned* bar = b.bar;
        __builtin_amdgcn_s_waitcnt(0);
        unsigned nloc = b.st[0], nx = b.st[1];
        if (nloc == 0u) { xcd_barrier_complete(bar, b.x, nloc, nx); b.st[0] = nloc; b.st[1] = nx; }
        const unsigned old = xb_add(&bar[XB_XSUB(b.x)], 1u);
        const unsigned gen = old / nloc;
        if (old + 1u == (gen + 1u) * nloc) {
            __builtin_amdgcn_fence(__ATOMIC_RELEASE, "agent");
            asm volatile("s_waitcnt vmcnt(0)" ::: "memory");
            const unsigned og = xb_add(&bar[XB_TOP], 1u);
            const unsigned tg = og / nx;
            if (og + 1u == (tg + 1u) * nx) xb_add(&bar[XB_TOPGEN], 1u);
            else XB_SPIN(xb_ld(&bar[XB_TOPGEN]) == tg, bar);
            __builtin_amdgcn_fence(__ATOMIC_ACQUIRE, "agent");
            xb_add(&bar[XB_XGEN(b.x)], 1u);
            asm volatile("s_waitcnt vmcnt(0)" ::: "memory");
        } else {
            XB_SPIN(xb_ld(&bar[XB_XGEN(b.x)]) == gen, bar);
            __builtin_amdgcn_fence(__ATOMIC_ACQUIRE, "agent");
            asm volatile("s_waitcnt vmcnt(0)" ::: "memory");
        }
    }
    __syncthreads();
}

}
namespace mk {
using pg8::bf16_t; using pg8::f32x2; using pg8::f32x4; using pg8::u32x4; using pg8::bf2f; using pg8::sigm; using pg8::sigm2; using pg8::cvt_pk_bf16; using pg8::f32x2c_t;
typedef unsigned u32x2 __attribute__((ext_vector_type(2)));
constexpr int NB = 16, SEQ = 4096, CTX = 256, D = 1024, DEPTH = 4, LPB = SEQ + CTX, T = NB * LPB, NTILE = T / 256;
constexpr int NIN = 9760, FFN = 3584, NEXP = 8;
constexpr int LDP = 2560, LDMG = 3072, LDYS = 1536;
constexpr float ALPHA = 1.681792830507429f;
constexpr float LN_EPS = 1e-5f, RMS_EPS = 1e-6f, L2_EPS = 1e-6f;
constexpr float LOG2E = 1.4426950408889634f, LN2 = 0.6931471805599453f;
constexpr int NWAVES = 8, NTHR = 512;

constexpr size_t MiB = 1u << 20;
constexpr size_t WS_CTL = 0, CTL_ZERO_BYTES = 1 * MiB;
constexpr size_t WS_MOD = 1 * MiB;
constexpr int TP = T + 2048;
constexpr size_t WS_ZSTAT = 128 * 1024;
constexpr size_t WS_STAT = 3 * MiB;
constexpr size_t WS_OML = 3 * MiB + 800 * 1024;
constexpr size_t WS_LNID = 3 * MiB + 768 * 1024;
constexpr size_t WS_TOP = 4 * MiB;
constexpr size_t WS_PERM = 5 * MiB + 128 * 1024;
constexpr size_t WS_PERMW = 5 * MiB + 768 * 1024;
constexpr size_t WS_PERMID = 6 * MiB + 384 * 1024;
constexpr size_t WS_SC = 7 * MiB;
constexpr size_t WS_W = 16 * MiB;
constexpr size_t LW_BYTES = 29 * MiB, LW_WB = 20 * MiB, LW_WO = 23 * MiB;
constexpr size_t WS_WFFN = WS_W + 4 * LW_BYTES;
constexpr size_t FFNW_BYTES = 21 * MiB, FFNW_WD = 14 * MiB;
constexpr size_t WS_XS = WS_WFFN + 2 * FFNW_BYTES;
constexpr size_t WS_H = WS_XS + 272 * MiB;
constexpr size_t WS_YS = WS_H + 136 * MiB;
constexpr size_t WS_BIG = WS_YS + 204 * MiB;
constexpr size_t WS_O = WS_BIG + 340 * MiB;
constexpr size_t WS_END = WS_BIG + 490 * MiB;
static_assert(WS_MOD + (size_t)4 * 17 * 6144 * 4 <= WS_STAT && WS_STAT + (size_t)T * 8 <= WS_LNID && WS_ZSTAT + (size_t)T * 8 <= CTL_ZERO_BYTES && (size_t)(4096 + 3456) * 4 <= WS_ZSTAT, "small buffers");
static_assert((size_t)TP * 3584 * 2 <= 490 * MiB && WS_XS == 174 * MiB && (size_t)T * 2560 * 2 == 340 * MiB && (size_t)T * 3584 * 2 == 476 * MiB && (size_t)T * 1024 * 4 == 272 * MiB, "ws map");
constexpr int CW_MOE = 2048;
constexpr int CW_BAR = 4096;

constexpr int RING_BYTES = 131072, LDS_BYTES = 163840, LDSCTL_OFF = LDS_BYTES - 1024;


struct Args { const float* in[24]; float* out; unsigned char* ws; int ph_lo, ph_hi; };
typedef const __attribute__((address_space(4))) Args* KArgs;
__device__ __forceinline__ KArgs fresh_args(KArgs a) { asm volatile("" : "+s"(a)); return a; }
enum { I_X = 0, I_C, I_CTX, I_CCTX, I_WADA, I_BADA, I_WIN, I_CONVW, I_LBRAW, I_MGB, I_ALOG, I_DTB, I_MIXN, I_WBR, I_WOUT, I_LNG, I_LNB, I_FG, I_FU, I_FD, I_ROUTER, I_MG, I_MU, I_MD };

__device__ __forceinline__ int opaque_tid() { int t = threadIdx.x; asm volatile("" : "+v"(t)); return t; }
__device__ __forceinline__ float wave_sum(float v) {
    v += __builtin_bit_cast(float, __builtin_amdgcn_mov_dpp(__builtin_bit_cast(int, v), 0xB1, 0xf, 0xf, false)); v += __builtin_bit_cast(float, __builtin_amdgcn_mov_dpp(__builtin_bit_cast(int, v), 0x4E, 0xf, 0xf, false));
    v += __builtin_bit_cast(float, __builtin_amdgcn_mov_dpp(__builtin_bit_cast(int, v), 0x141, 0xf, 0xf, false)); v += __builtin_bit_cast(float, __builtin_amdgcn_mov_dpp(__builtin_bit_cast(int, v), 0x140, 0xf, 0xf, false));
    const int vi = __builtin_bit_cast(int, v);
    return (__builtin_bit_cast(float, __builtin_amdgcn_readlane(vi, 0)) + __builtin_bit_cast(float, __builtin_amdgcn_readlane(vi, 16))) + (__builtin_bit_cast(float, __builtin_amdgcn_readlane(vi, 32)) + __builtin_bit_cast(float, __builtin_amdgcn_readlane(vi, 48)));
}
__device__ __forceinline__ float silu_f(float x) { return x * sigm(x); }

typedef short v4i16c_t __attribute__((ext_vector_type(4)));
__device__ __forceinline__ void tr_item(const float* colp4, size_t ldw, bf16_t* dst, size_t ldd, LAS unsigned char* scr, int lane, float scale = 1.0f) {
    const int kr = lane >> 3, pc = lane & 7;
    pg8::f32x4 v[8];
#pragma unroll
    for (int j = 0; j < 8; ++j) v[j] = *(const pg8::f32x4*)(colp4 + (size_t)(kr + 8 * j) * ldw);
#pragma unroll
    for (int j = 0; j < 8; ++j) { const pg8::f32x4 x = v[j] * scale; u32x2 w; w.x = cvt_pk_bf16(x[0], x[1]); w.y = cvt_pk_bf16(x[2], x[3]); *(LAS u32x2*)(scr + (kr + 8 * j) * 64 + pc * 8) = w; }
    asm volatile("" ::: "memory");
    const int i = lane & 15, gq = lane >> 4, nh = gq & 1;
    const LAS unsigned char* rb = scr + (i >> 2) * 64 + nh * 32 + (i & 3) * 8;
#pragma unroll
    for (int j = 0; j < 4; ++j) { const int c = (gq >> 1) + 2 * j;
        const v4i16c_t lo = __builtin_amdgcn_ds_read_tr16_b64_v4i16((LAS v4i16c_t*)(rb + (8 * c) * 64)), hi = __builtin_amdgcn_ds_read_tr16_b64_v4i16((LAS v4i16c_t*)(rb + (8 * c + 4) * 64));
        v4u o; o.x = (unsigned)(unsigned short)lo[0] | ((unsigned)(unsigned short)lo[1] << 16); o.y = (unsigned)(unsigned short)lo[2] | ((unsigned)(unsigned short)lo[3] << 16);
        o.z = (unsigned)(unsigned short)hi[0] | ((unsigned)(unsigned short)hi[1] << 16); o.w = (unsigned)(unsigned short)hi[2] | ((unsigned)(unsigned short)hi[3] << 16);
        *(v4u*)(dst + (size_t)(16 * nh + i) * ldd + 8 * c) = o; }
    asm volatile("" ::: "memory");
}
__device__ __forceinline__ int win_col(int r) {
    if (r < 4608) return r;
    if (r < 4864) { const int rr = r - 4608; return rr < 16 ? 4608 + rr : (rr < 32 ? 6672 + (rr - 16) : -1); }
    if (r < 6912) return 4624 + (r - 4864);
    return 6688 + (r - 6912);
}
constexpr int IT_WIN = 16 * 312, IT_WB = 3 * 8 * 32, IT_WO = 16 * 32, IT_LAYER = IT_WIN + IT_WB + IT_WO;
constexpr int IT_GU = 16 * 224, IT_DN = 56 * 32, IT_FFN = IT_GU + IT_DN;
__device__ __forceinline__ void conv_ffn_item(const float* wg, const float* wu, const float* wd, bf16_t* gu_t, bf16_t* dn_t, int r, LAS unsigned char* scr, int lane) {
    const int ln = 4 * (lane & 7);
    if (r < IT_GU) { const int kb = r / 224, nb = r % 224, k0 = 64 * kb, r0 = 32 * nb, tile = r0 >> 8, within = r0 & 255;
        const float* src = (within < 128) ? wg + (size_t)k0 * FFN + tile * 128 + within + ln : wu + (size_t)k0 * FFN + tile * 128 + (within - 128) + ln;
        tr_item(src, FFN, gu_t + (size_t)r0 * D + k0, D, scr, lane, within < 128 ? LOG2E : LN2); return; }
    r -= IT_GU;
    { const int kb = r / 32, nb = r % 32, k0 = 64 * kb, n0 = 32 * nb;
        tr_item(wd + (size_t)k0 * D + n0 + ln, D, dn_t + (size_t)n0 * FFN + k0, FFN, scr, lane); }
}
__device__ __forceinline__ void conv_layer_item(KArgs a, int l, int r, LAS unsigned char* scr, int lane) {
    a = fresh_args(a);
    unsigned char* lw = a->ws + WS_W + (size_t)l * LW_BYTES; const int ln = 4 * (lane & 7);
    if (r < IT_WIN) { const int kb = r / 312, nb = r % 312, k0 = 64 * kb, col = win_col((nb >> 3) * 256 + 64 * (nb & 3) + 32 * ((nb >> 2) & 1) + ln);
        const float* src = a->in[I_WIN] + ((size_t)l * D + k0) * NIN + (col >= 0 ? col : 0);
        const int lc = (nb >> 3) * 256 + 64 * (nb & 3) + 32 * ((nb >> 2) & 1);
        tr_item(src, NIN, (bf16_t*)lw + (size_t)(32 * nb) * D + k0, D, scr, lane, col < 0 ? 0.0f : (((lc >= 512 && lc < 1536) || lc >= 6912) ? LOG2E : 1.0f)); return; }
    r -= IT_WIN;
    if (r < IT_WB) { const int n = r / 256, rem = r % 256, kb = rem / 32, nb = rem % 32, k0 = 64 * kb, n0 = 32 * nb;
        const int lc0 = (nb >> 3) * 256 + 64 * (nb & 3) + 32 * ((nb >> 2) & 1);
        tr_item(a->in[I_WBR] + ((size_t)(l * 3 + n) * 512 + k0) * D + lc0 + ln, D, (bf16_t*)(lw + LW_WB) + (size_t)n0 * 1536 + n * 512 + k0, 1536, scr, lane); return; }
    r -= IT_WB;
    { const int kb = r / 32, nb = r % 32, k0 = 64 * kb, n0 = 32 * nb;
        tr_item(a->in[I_WOUT] + ((size_t)l * D + k0) * D + n0 + ln, D, (bf16_t*)(lw + LW_WO) + (size_t)n0 * D + k0, D, scr, lane); }
}

__device__ __forceinline__ void pro_a(KArgs a, LAS unsigned char* lds) {
    a = fresh_args(a);
    const int tid = opaque_tid(), lane = tid & 63, wave = __builtin_amdgcn_readfirstlane(tid >> 6), G = gridDim.x;
    LAS float* s_lds = (LAS float*)lds;
    LAS float* red = s_lds + 17 * 1024;
    for (int i = tid; i < 17 * 1024; i += NTHR) { const int mi = i >> 10, k = i & 1023; const float c = mi < 16 ? a->in[I_C][mi * 1024 + k] : a->in[I_CCTX][k]; s_lds[i] = silu_f(c); }
    __syncthreads();
    float* MOD = (float*)(a->ws + WS_MOD);
    { int* pid = (int*)(a->ws + WS_PERMID); for (int i = blockIdx.x * NTHR + tid; i < T; i += G * NTHR) pid[i] = i; }
    if (blockIdx.x == 1) { float* om = (float*)(a->ws + WS_OML); const float* lr = a->in[I_LBRAW];
        for (int cc = tid; cc < 512; cc += NTHR) { const float r0 = lr[cc], r1 = lr[512 + cc], r2 = lr[1024 + cc], r3 = lr[1536 + cc]; const float mx = fmaxf(fmaxf(r0, r1), fmaxf(r2, r3));
            const float e0 = __expf(r0 - mx), e1 = __expf(r1 - mx), e2 = __expf(r2 - mx), e3 = __expf(r3 - mx), inv = 1.0f / (e0 + e1 + e2 + e3);
            om[cc] = 1.0f; om[512 + cc] = 1.0f - e1 * inv; om[1024 + cc] = 1.0f - (e1 + e2) * inv; om[1536 + cc] = 1.0f - (e1 + e2 + e3) * inv; } }
    if (blockIdx.x == 0) { float* id = (float*)(a->ws + WS_LNID); for (int i = tid; i < 2048; i += NTHR) id[i] = i < 1024 ? 1.0f : 0.0f; }
    for (int it = blockIdx.x; it < DEPTH * 96; it += G) {
        const int l = it / 96, jg = it % 96;
        const float* wp = a->in[I_WADA] + ((size_t)l * D + wave * 128) * 6144 + jg * 64 + lane;
        float acc[17];
#pragma unroll
        for (int mi = 0; mi < 17; ++mi) acc[mi] = 0.f;
        for (int k = 0; k < 128; k += 4) {
            const float w0 = wp[(size_t)(k + 0) * 6144], w1 = wp[(size_t)(k + 1) * 6144], w2 = wp[(size_t)(k + 2) * 6144], w3 = wp[(size_t)(k + 3) * 6144];
#pragma unroll
            for (int mi = 0; mi < 17; ++mi) { const f32x4 sv = *(const LAS f32x4*)(s_lds + mi * 1024 + wave * 128 + k); acc[mi] += sv[0] * w0 + sv[1] * w1 + sv[2] * w2 + sv[3] * w3; }
        }
#pragma unroll
        for (int mi = 0; mi < 17; ++mi) red[(wave * 17 + mi) * 64 + lane] = acc[mi];
        __syncthreads();
        for (int i = tid; i < 17 * 64; i += NTHR) { const int mi = i >> 6, ln = i & 63; float s = a->in[I_BADA][l * 6144 + jg * 64 + ln];
#pragma unroll
            for (int w = 0; w < 8; ++w) s += red[(w * 17 + mi) * 64 + ln];
            MOD[(size_t)(l * 17 + mi) * 6144 + jg * 64 + ln] = s; }
        __syncthreads();
    }
    __syncthreads();
    LAS unsigned char* scr = lds + wave * 16384;
    const int gw = blockIdx.x * NWAVES + wave, NGW = G * NWAVES;
    constexpr int NITEMS = DEPTH * IT_LAYER + 2 * IT_FFN;
    for (int it = gw; it < NITEMS; it += NGW) {
        if (it < DEPTH * IT_LAYER) { conv_layer_item(a, it / IT_LAYER, it % IT_LAYER, scr, lane); continue; }
        const int r = it - DEPTH * IT_LAYER, i = r / IT_FFN;
        unsigned char* fw = a->ws + WS_WFFN + (size_t)i * FFNW_BYTES;
        conv_ffn_item(a->in[I_FG] + (size_t)i * D * FFN, a->in[I_FU] + (size_t)i * D * FFN, a->in[I_FD] + (size_t)i * FFN * D, (bf16_t*)fw, (bf16_t*)(fw + FFNW_WD), r % IT_FFN, scr, lane);
    }
}
__device__ __forceinline__ void conv_moe(KArgs a, int i, LAS unsigned char* lds) {
    a = fresh_args(a);
    const int tid = opaque_tid(), lane = tid & 63, wave = __builtin_amdgcn_readfirstlane(tid >> 6), G = gridDim.x;
    LAS unsigned char* scr = lds + wave * 16384;
    const int gw = blockIdx.x * NWAVES + wave, NGW = G * NWAVES;
    for (int it = gw; it < NEXP * IT_FFN; it += NGW) {
        const int e = it / IT_FFN; const size_t eo = (size_t)(i * NEXP + e) * D * FFN;
        unsigned char* fw = a->ws + WS_YS + (size_t)e * FFNW_BYTES;
        conv_ffn_item(a->in[I_MG] + eo, a->in[I_MU] + eo, a->in[I_MD] + eo, (bf16_t*)fw, (bf16_t*)(fw + FFNW_WD), it % IT_FFN, scr, lane);
    }
}

template <int MODE> __device__ __forceinline__ void rowpass(KArgs a, int l, LAS unsigned char* lds, int part = 0, int wg0 = 0, int lim = 0) {
    a = fresh_args(a);
    const int tid = opaque_tid(), lane = tid & 63, wave = __builtin_amdgcn_readfirstlane(tid >> 6), G = gridDim.x;
    const float* MOD = (const float*)(a->ws + WS_MOD);
    float* XS = (float*)(a->ws + WS_XS); bf16_t* H = (bf16_t*)(a->ws + WS_H); float* TOP = (float*)(a->ws + WS_TOP);
    LAS float* wr = (LAS float*)lds;
    LAS unsigned* hist = (LAS unsigned*)(lds + 32768);
    const bool moe = (MODE == 1) && (l & 1);
    if (moe) { const float* r = a->in[I_ROUTER] + (size_t)(l >> 1) * D * NEXP;
        for (int i = tid; i < D * NEXP; i += NTHR) { const int k = i >> 3, e = i & 7; wr[e * 1024 + k] = r[i]; }
        if (tid < 16) hist[tid] = 0u;
        __syncthreads(); }
    const int gw = ((int)blockIdx.x - wg0) * NWAVES + wave, NGW = (G - wg0) * NWAVES;
    const int lh = (MODE == 2) ? l + 1 : l, si = (MODE == 1) ? 3 : 0;
    pg8::StaticOrder SO; SO.init(T, D, G, 0);
    f32x4 lng4[4], lnb4[4];
    if (MODE != 0) { const float* gp0 = a->in[I_LNG] + (size_t)(l * 2 + (MODE - 1)) * D; const float* bp0 = a->in[I_LNB] + (size_t)(l * 2 + (MODE - 1)) * D;
#pragma unroll
        for (int j = 0; j < 4; ++j) { lng4[j] = ((const f32x4*)gp0)[lane + 64 * j]; lnb4[j] = ((const f32x4*)bp0)[lane + 64 * j]; } }
    auto accepted = [&](int row_) -> bool {
        if (part) { const int pm = row_ >> 8; const bool late = SO.pos_of(pm, 0) >= lim || SO.pos_of(pm, 1) >= lim || SO.pos_of(pm, 2) >= lim || SO.pos_of(pm, 3) >= lim; if (late != (part == 2)) return false; }
        if (MODE != 0 && l == DEPTH - 1 && (row_ % LPB) < CTX) return false;
        return true; };
    auto row_src = [&](int row_) -> const float* { const int b_ = row_ / LPB, p_ = row_ - b_ * LPB;
        return (MODE == 0) ? (p_ < CTX ? a->in[I_CTX] + ((size_t)b_ * CTX + p_) * D : a->in[I_X] + ((size_t)b_ * SEQ + (p_ - CTX)) * D) : XS + (size_t)row_ * D; };
    int nrow = gw; while (nrow < T && !accepted(nrow)) nrow += NGW;
    f32x4 vn[4];
    if (nrow < T) { const float* s0 = row_src(nrow);
#pragma unroll
        for (int j = 0; j < 4; ++j) vn[j] = ((const f32x4*)s0)[lane + 64 * j]; }
    while (nrow < T) {
        const int row = nrow;
        const int b = row / LPB, p = row - b * LPB; const bool isctx = p < CTX; const int mi = isctx ? 16 : b;
        f32x4 v[4], sc4[4], sh4[4];
        { const float* shp = MOD + (size_t)(lh * 17 + mi) * 6144 + si * 1024; const float* scp = shp + 1024;
#pragma unroll
            for (int j = 0; j < 4; ++j) { sc4[j] = ((const f32x4*)scp)[lane + 64 * j]; sh4[j] = ((const f32x4*)shp)[lane + 64 * j]; } }
#pragma unroll
        for (int j = 0; j < 4; ++j) v[j] = vn[j];
        nrow += NGW; while (nrow < T && !accepted(nrow)) nrow += NGW;
        if (nrow < T) { const float* s1 = row_src(nrow);
#pragma unroll
            for (int j = 0; j < 4; ++j) vn[j] = ((const f32x4*)s1)[lane + 64 * j]; }
        if (MODE != 0) {
            float s = 0.f;
#pragma unroll
            for (int j = 0; j < 4; ++j) s += (v[j][0] + v[j][1]) + (v[j][2] + v[j][3]);
            const float mean = wave_sum(s) * (1.f / D); float s2 = 0.f;
#pragma unroll
            for (int j = 0; j < 4; ++j) { v[j] = v[j] - mean; s2 += (v[j][0] * v[j][0] + v[j][1] * v[j][1]) + (v[j][2] * v[j][2] + v[j][3] * v[j][3]); }
            const float rstd = 1.0f / sqrtf(wave_sum(s2) * (1.f / D) + LN_EPS);
            if (lane == 0 && !(MODE == 2 && l == DEPTH - 1)) *(f32x2*)((float*)(a->ws + WS_STAT) + (size_t)row * 2) = (f32x2){mean, rstd - 1.0f};
#pragma unroll
            for (int j = 0; j < 4; ++j) v[j] = v[j] * rstd * lng4[j] + lnb4[j];
        }
        if (MODE == 2 && l == DEPTH - 1) {
            if (!isctx) { f32x4* o = (f32x4*)(a->out + ((size_t)b * SEQ + (p - CTX)) * D);
#pragma unroll
                for (int j = 0; j < 4; ++j) o[lane + 64 * j] = v[j]; }
            continue;
        }
        float s = 0.f;
#pragma unroll
        for (int j = 0; j < 4; ++j) s += (v[j][0] + v[j][1]) + (v[j][2] + v[j][3]);
        const float mean = wave_sum(s) * (1.f / D); float s2 = 0.f;
#pragma unroll
        for (int j = 0; j < 4; ++j) { v[j] = v[j] - mean; s2 += (v[j][0] * v[j][0] + v[j][1] * v[j][1]) + (v[j][2] * v[j][2] + v[j][3] * v[j][3]); }
        const float rstd = 1.0f / sqrtf(wave_sum(s2) * (1.f / D) + LN_EPS);
#pragma unroll
        for (int j = 0; j < 4; ++j) { const f32x4 sc = sc4[j], sh = sh4[j];
            v[j] = v[j] * rstd * (sc + 1.0f) + sh;
            u32x2 w; w.x = cvt_pk_bf16(v[j][0], v[j][1]); w.y = cvt_pk_bf16(v[j][2], v[j][3]);
            ((u32x2*)(H + (size_t)row * D))[lane + 64 * j] = w; }
        if (moe) {
            float lg[8];
#pragma unroll
            for (int e = 0; e < 8; ++e) { float t = 0.f;
#pragma unroll
                for (int j = 0; j < 4; ++j) { const f32x4 w4 = *(const LAS f32x4*)(wr + e * 1024 + 4 * (lane + 64 * j)); t += v[j][0] * w4[0] + v[j][1] * w4[1] + v[j][2] * w4[2] + v[j][3] * w4[3]; }
                lg[e] = wave_sum(t); }
            int i1 = 0; float v1 = lg[0];
#pragma unroll
            for (int e = 1; e < 8; ++e) if (lg[e] > v1) { v1 = lg[e]; i1 = e; }
            int i2 = -1; float v2 = -3.0e38f;
#pragma unroll
            for (int e = 0; e < 8; ++e) if (e != i1 && lg[e] > v2) { v2 = lg[e]; i2 = e; }
            const float p1 = 1.0f / (1.0f + __expf(v2 - v1)), p2 = 1.0f - p1;
            if (lane == 0) { TOP[(size_t)row * 4 + 0] = p1; TOP[(size_t)row * 4 + 1] = p2; TOP[(size_t)row * 4 + 2] = __uint_as_float((unsigned)i1 | ((unsigned)i2 << 8));
                __hip_atomic_fetch_add(hist + i1, 1u, __ATOMIC_RELAXED, __HIP_MEMORY_SCOPE_WORKGROUP); __hip_atomic_fetch_add(hist + 8 + i2, 1u, __ATOMIC_RELAXED, __HIP_MEMORY_SCOPE_WORKGROUP); }
        }
    }
    if (moe) { __syncthreads(); if (tid < 16) { const unsigned hv = hist[tid]; if (hv) __hip_atomic_fetch_add((unsigned*)(a->ws + WS_CTL) + CW_MOE + 32 * (l >> 1) + tid, hv, __ATOMIC_RELAXED, __HIP_MEMORY_SCOPE_AGENT); } }
}

__device__ __forceinline__ void moe_tile_starts(KArgs a, int i, int s, int (&ts)[9]) {
    const unsigned* cnt = (const unsigned*)(a->ws + WS_CTL) + CW_MOE + 32 * i + 8 * s; int acc = 0;
#pragma unroll
    for (int e = 0; e < 8; ++e) { ts[e] = acc; acc += (int)((__hip_atomic_load(cnt + e, __ATOMIC_RELAXED, __HIP_MEMORY_SCOPE_AGENT) + 255u) >> 8); }
    ts[8] = acc;
}
__device__ __forceinline__ void moe_fill(KArgs a, int i, int skipctx) {
    a = fresh_args(a);
    const int tid = opaque_tid(), lane = tid & 63, wave = __builtin_amdgcn_readfirstlane(tid >> 6), G = gridDim.x;
    unsigned* ctl = (unsigned*)(a->ws + WS_CTL) + CW_MOE + 32 * i;
    const float* TOP = (const float*)(a->ws + WS_TOP); int* PERM = (int*)(a->ws + WS_PERM); float* PERMW = (float*)(a->ws + WS_PERMW);
    int ts0[9], ts1[9]; moe_tile_starts(a, i, 0, ts0); moe_tile_starts(a, i, 1, ts1);
    const int gw = blockIdx.x * NWAVES + wave, NGW = G * NWAVES;
    for (int base = gw * 64; base < T; base += NGW * 64) {
        const int row = base + lane; const unsigned bits = __float_as_uint(TOP[(size_t)row * 4 + 2]);
        const float p1 = TOP[(size_t)row * 4 + 0], p2 = TOP[(size_t)row * 4 + 1];
        const bool dead = skipctx && (row % LPB) < CTX;
        const int mine0 = dead ? -1 : (int)(bits & 255u), mine1 = dead ? -1 : (int)(bits >> 8) & 255;
        unsigned long long m[16]; unsigned cntj = 0u;
#pragma unroll
        for (int j = 0; j < 16; ++j) { m[j] = __ballot((j < 8 ? mine0 : mine1) == (j & 7)); if (lane == j) cntj = (unsigned)__popcll(m[j]); }
        unsigned b0j = 0u;
        if (lane < 16 && cntj) b0j = __hip_atomic_fetch_add(ctl + 16 + lane, cntj, __ATOMIC_RELAXED, __HIP_MEMORY_SCOPE_AGENT);
        const unsigned long long below = (1ull << lane) - 1ull;
        int pos0 = 0, pos1 = 0;
#pragma unroll
        for (int j = 0; j < 16; ++j) { const int bj = __builtin_amdgcn_readlane((int)b0j, j), pj = (j < 8 ? ts0[j & 7] : ts1[j & 7]) * 256 + bj + __popcll(m[j] & below);
            if (j < 8) { if (mine0 == j) pos0 = pj; } else { if (mine1 == (j & 7)) pos1 = pj; } }
        if (!dead) { PERM[pos0] = row; PERMW[pos0] = p1; PERM[(size_t)TP + pos1] = row; PERMW[(size_t)TP + pos1] = p2; }
    }
    if (blockIdx.x < 16) { const int s = blockIdx.x >> 3, e = blockIdx.x & 7;
        const int cnt = (int)__hip_atomic_load(ctl + 8 * s + e, __ATOMIC_RELAXED, __HIP_MEMORY_SCOPE_AGENT), pad = ((cnt + 255) & ~255); int t0 = 0;
#pragma unroll
        for (int j = 0; j < 8; ++j) if (j == e) t0 = (s ? ts1[j] : ts0[j]) * 256;
        for (int p = cnt + tid; p < pad; p += NTHR) { PERM[(size_t)s * TP + t0 + p] = -1; PERMW[(size_t)s * TP + t0 + p] = 0.f; } }
}

__device__ __forceinline__ int pos_of_step(int st, int dir, bool colmajor) {
    if (st < CTX) return dir ? (CTX - 1 - st) : st;
    int u = st - CTX; if (dir) u = SEQ - 1 - u;
    if (colmajor) u = (u & 63) * 64 + (u >> 6);
    return CTX + u;
}
template <int CTRL> __device__ __forceinline__ float dpp_f(float v) { return __builtin_bit_cast(float, __builtin_amdgcn_mov_dpp(__builtin_bit_cast(int, v), CTRL, 0xf, 0xf, false)); }
__device__ __forceinline__ float red8(float v) { v += dpp_f<0xB1>(v); v += dpp_f<0x4E>(v); v += dpp_f<0x141>(v); return v; }
__device__ __forceinline__ float red16(float v) { v = red8(v); v += dpp_f<0x140>(v); return v; }
template <int CTRL, int RMASK> __device__ __forceinline__ float dpp_upd(float idv, float v) { return __builtin_bit_cast(float, __builtin_amdgcn_update_dpp(__builtin_bit_cast(int, idv), __builtin_bit_cast(int, v), CTRL, RMASK, 0xf, false)); }
__device__ __forceinline__ float wave_scan_add(float v) {
    v += dpp_upd<0x111, 0xf>(0.f, v); v += dpp_upd<0x112, 0xf>(0.f, v); v += dpp_upd<0x114, 0xf>(0.f, v); v += dpp_upd<0x118, 0xf>(0.f, v); v += dpp_upd<0x142, 0xa>(0.f, v); v += dpp_upd<0x143, 0xc>(0.f, v); return v; }
__device__ __forceinline__ float wave_scan_max(float v) { const float ni = -__builtin_inff();
    v = fmaxf(v, dpp_upd<0x111, 0xf>(ni, v)); v = fmaxf(v, dpp_upd<0x112, 0xf>(ni, v)); v = fmaxf(v, dpp_upd<0x114, 0xf>(ni, v)); v = fmaxf(v, dpp_upd<0x118, 0xf>(ni, v)); v = fmaxf(v, dpp_upd<0x142, 0xa>(ni, v)); v = fmaxf(v, dpp_upd<0x143, 0xc>(ni, v)); return v; }
__device__ __forceinline__ float lane63(float v) { return __builtin_bit_cast(float, __builtin_amdgcn_readlane(__builtin_bit_cast(int, v), 63)); }
__device__ __forceinline__ f32x4 ld_bf16x4(const bf16_t* p) { const u32x2 w = *(const u32x2*)p; return (f32x4){__uint_as_float(w.x << 16), __uint_as_float(w.x & 0xffff0000u), __uint_as_float(w.y << 16), __uint_as_float(w.y & 0xffff0000u)}; }

__device__ __forceinline__ void lds_barrier() { asm volatile("s_waitcnt lgkmcnt(0)" ::: "memory"); __builtin_amdgcn_s_barrier(); asm volatile("" ::: "memory"); }
typedef short bf16x8_t __attribute__((ext_vector_type(8)));
#define MFMA16(a, b, c) __builtin_amdgcn_mfma_f32_16x16x32_bf16((a), (b), (c), 0, 0, 0)
__device__ __forceinline__ bf16x8_t ldfrag(const LAS unsigned char* base, int stride, int row, int col) { return *(const LAS bf16x8_t*)(base + row * stride + col * 2); }
__device__ __forceinline__ unsigned short f2bf16(float f) { return (unsigned short)(cvt_pk_bf16(f, 0.f) & 0xffffu); }
constexpr int RS = 272, TS = 144;
constexpr int NCHUNK = LPB / 64;

constexpr int SCW_PITCH = 2064;
__device__ __forceinline__ void sc_stage_w(const bf16_t* W32, LAS unsigned char* lds, int tid) {
    for (int i = tid; i < 32 * 128; i += NTHR) { const int n = i >> 7, c16 = i & 127; *(LAS u32x4*)(lds + n * SCW_PITCH + c16 * 16) = *(const u32x4*)(W32 + (size_t)n * D + c16 * 8); }
}
__device__ __forceinline__ void sc_unit(const bf16_t* Hm, const LAS unsigned char* wl, float* SCo, int u, int wave, int lane) {
    const int r = lane & 15, q = lane >> 4;
    const bf16_t* ap = Hm + (size_t)(u * 256 + wave * 32 + r) * D + q * 8;
    const LAS unsigned char* bl = wl + r * SCW_PITCH + q * 16;
    f32x4 acc[2][2];
#pragma unroll
    for (int i = 0; i < 2; ++i)
#pragma unroll
        for (int j = 0; j < 2; ++j) acc[i][j] = (f32x4){0.f, 0.f, 0.f, 0.f};
    bf16x8_t an[8];
#pragma unroll
    for (int j = 0; j < 4; ++j) { an[2 * j] = *(const bf16x8_t*)(ap + j * 32); an[2 * j + 1] = *(const bf16x8_t*)(ap + (size_t)16 * D + j * 32); }
#pragma unroll 1
    for (int kb = 0; kb < 8; ++kb) {
        bf16x8_t ac[8];
#pragma unroll
        for (int j = 0; j < 8; ++j) ac[j] = an[j];
        if (kb + 1 < 8) {
#pragma unroll
            for (int j = 0; j < 4; ++j) { an[2 * j] = *(const bf16x8_t*)(ap + (kb + 1) * 128 + j * 32); an[2 * j + 1] = *(const bf16x8_t*)(ap + (size_t)16 * D + (kb + 1) * 128 + j * 32); } }
#pragma unroll
        for (int j = 0; j < 4; ++j) { const int ks = kb * 4 + j;
            const bf16x8_t b0 = *(const LAS bf16x8_t*)(bl + ks * 64), b1 = *(const LAS bf16x8_t*)(bl + 16 * SCW_PITCH + ks * 64);
            acc[0][0] = MFMA16(b0, ac[2 * j], acc[0][0]); acc[0][1] = MFMA16(b1, ac[2 * j], acc[0][1]); acc[1][0] = MFMA16(b0, ac[2 * j + 1], acc[1][0]); acc[1][1] = MFMA16(b1, ac[2 * j + 1], acc[1][1]); }
    }
#pragma unroll
    for (int rt = 0; rt < 2; ++rt)
#pragma unroll
        for (int ct = 0; ct < 2; ++ct) *(f32x4*)(SCo + (size_t)(u * 256 + wave * 32 + 16 * rt + r) * 32 + 16 * ct + 4 * q) = acc[rt][ct];
}

constexpr int RK = 336;
constexpr int SA_QTG = 0, SA_KT = SA_QTG + 128 * 336, SA_KD = SA_KT + 128 * 336, SA_VT = SA_KD + 128 * TS, SA_AB = SA_VT + 64 * RK, SA_SB = SA_AB + 64 * TS, SA_TOT = SA_SB + 64 * RS, SA_DL = SA_TOT + 2048, SA_END = SA_DL + 512;
static_assert(SA_END <= LDSCTL_OFF, "scan A images vs LDS");
typedef short v4i16_t __attribute__((ext_vector_type(4)));
__device__ __forceinline__ v4i16_t tr4(const LAS unsigned char* base, int pitch, int row0, int col0, int r) {
    return __builtin_amdgcn_ds_read_tr16_b64_v4i16((LAS v4i16_t*)(base + (row0 + (r >> 2)) * pitch + (col0 + 4 * (r & 3)) * 2)); }
__device__ __forceinline__ bf16x8_t trfrag(const LAS unsigned char* base, int pitch, int col0, int ch0, int r, int q) {
    const v4i16_t lo = tr4(base, pitch, ch0 + 8 * q, col0, r), hi = tr4(base, pitch, ch0 + 8 * q + 4, col0, r);
    return (bf16x8_t){lo[0], lo[1], lo[2], lo[3], hi[0], hi[1], hi[2], hi[3]}; }
__device__ __forceinline__ void scanA_mfma(KArgs a, int l, LAS unsigned char* lds) {
    a = fresh_args(a);
    const int tid = opaque_tid(), lane = tid & 63, w = __builtin_amdgcn_readfirstlane(tid >> 6), r = lane & 15, q = lane >> 4;
    const bf16_t* P = (const bf16_t*)(a->ws + WS_BIG); bf16_t* O = (bf16_t*)(a->ws + WS_O);
    const int c = tid & 127, sb = __builtin_amdgcn_readfirstlane(tid >> 7);
    const int vtok = tid >> 3, v8 = (tid & 7) * 8;
    LAS float* TOT = (LAS float*)(lds + SA_TOT); LAS float* DL = (LAS float*)(lds + SA_DL);
    const int kbase = (sb == 0) ? 0 : (sb == 1 ? 16 : (sb == 2 ? 48 : 96));
    for (int it = blockIdx.x; it < 256; it += gridDim.x) {
        const int vh = it & 1, dir = (it >> 1) & 1, h = (it >> 2) & 3, b = it >> 4;
        __syncthreads();
        for (int i = tid; i < (SA_TOT - SA_AB) / 4; i += NTHR) ((LAS unsigned*)(lds + SA_AB))[i] = 0u;
        f32x4 Sacc[4];
#pragma unroll
        for (int i = 0; i < 4; ++i) Sacc[i] = (f32x4){0.f, 0.f, 0.f, 0.f};
        u32x4 qst[2], fst[2], vraw;
#define SA_LOAD(n) do { _Pragma("unroll") for (int k = 0; k < 2; ++k) { const int pi = tid + 512 * k; const bf16_t* pr = P + (size_t)(b * LPB + pos_of_step((n) * 64 + (pi >> 4), dir, false)) * LDP + h * 128 + 8 * (pi & 15); \
                qst[k] = *(const u32x4*)pr; fst[k] = *(const u32x4*)(pr + (1 + dir) * 512); } \
            vraw = *(const u32x4*)(P + (size_t)(b * LPB + pos_of_step((n) * 64 + vtok, dir, false)) * LDP + 1536 + h * 128 + vh * 64 + v8); } while (0)
#define SA_STAGE() do { _Pragma("unroll") for (int k = 0; k < 2; ++k) { const int pi = tid + 512 * k; LAS unsigned char* sp_ = lds + SA_KT + (pi >> 4) * RK + (pi & 15) * 16; \
                *(LAS u32x4*)sp_ = qst[k]; *(LAS u32x4*)(sp_ + 64 * RK) = fst[k]; } } while (0)
        SA_LOAD(0);
        SA_STAGE();
        lds_barrier();
        for (int n = 0; n < NCHUNK; ++n) {
            float cp[16], sp[16], kk[16], qv[16], fv[16]; float run = 1.f;
            unsigned short qraw[16], fraw[16];
#pragma unroll
            for (int g4 = 0; g4 < 4; ++g4) { const v4i16_t qq = tr4(lds + SA_KT, RK, sb * 16 + 4 * g4, c & ~15, lane & 15), ff = tr4(lds + SA_KT + 64 * RK, RK, sb * 16 + 4 * g4, c & ~15, lane & 15);
#pragma unroll
                for (int j = 0; j < 4; ++j) { qraw[4 * g4 + j] = (unsigned short)qq[j]; fraw[4 * g4 + j] = (unsigned short)ff[j]; } }
#pragma unroll
            for (int tt = 0; tt < 16; tt += 2) { const float k0 = bf2f(fraw[tt]), k1 = bf2f(fraw[tt + 1]);
                const float f0 = fmaxf(1.0f - k0, 1e-30f), f1 = fmaxf(1.0f - k1, 1e-30f);
                run *= f0; cp[tt] = run; kk[tt] = k0; fv[tt] = f0; qv[tt] = bf2f(qraw[tt]); run *= f1; cp[tt + 1] = run; kk[tt + 1] = k1; fv[tt + 1] = f1; qv[tt + 1] = bf2f(qraw[tt + 1]); }
            { float suf = 1.f;
#pragma unroll
                for (int tt = 15; tt >= 0; --tt) { sp[tt] = suf; suf *= fv[tt]; } }
            TOT[sb * 128 + c] = run;
            *(LAS u32x4*)(lds + SA_VT + vtok * RK + v8 * 2) = vraw;
            lds_barrier();
            const float t0 = TOT[c], t1 = TOT[128 + c], t2 = TOT[256 + c], t3 = TOT[384 + c];
            const float egref = (sb >= 1 ? t0 : 1.f) * (sb >= 2 ? t1 : 1.f) * (sb >= 3 ? t2 : 1.f);
            const float ekd = (sb <= 0 ? t1 : 1.f) * (sb <= 1 ? t2 : 1.f) * (sb <= 2 ? t3 : 1.f);
            const float f1 = 1.0f, f2 = (sb == 0 ? t1 : (sb == 1 ? t2 : 1.f)), f3 = (sb == 0 ? t1 * t2 : 1.f);
            if (sb == 0) DL[c] = (t0 * t1) * (t2 * t3);
            if (n + 1 < NCHUNK) SA_LOAD(n + 1);
            { unsigned qtp[8], qgp[8], kop[8], bap[8], b2p[8], b3p[8], kdp[8]; const float rrun = fminf(__builtin_amdgcn_rcpf(run), 5.5e34f);
#pragma unroll
                for (int tp = 0; tp < 8; ++tp) { const int t0 = 2 * tp;
                    const f32x2c_t cpv = {cp[t0], cp[t0 + 1]}, kkv = {kk[t0], kk[t0 + 1]}, spv = {sp[t0], sp[t0 + 1]}, qvv = {qv[t0], qv[t0 + 1]};
                    const f32x2c_t icp = spv * rrun;
                    const f32x2c_t qt = qvv * cpv, qg = qt * egref, kown = kkv * icp, base = kkv * spv, kd = base * ekd;
                    qtp[tp] = cvt_pk_bf16(qt[0], qt[1]); qgp[tp] = cvt_pk_bf16(qg[0], qg[1]); kop[tp] = cvt_pk_bf16(kown[0], kown[1]); kdp[tp] = cvt_pk_bf16(kd[0], kd[1]);
                    if (sb <= 2) bap[tp] = cvt_pk_bf16(base[0], base[1]);
                    if (sb <= 1) { const f32x2c_t b2 = base * f2; b2p[tp] = cvt_pk_bf16(b2[0], b2[1]); }
                    if (sb == 0) { const f32x2c_t b3 = base * f3; b3p[tp] = cvt_pk_bf16(b3[0], b3[1]); }
                }
#define ST16(addr_, x_) do { LAS u32x4* p_ = (LAS u32x4*)(addr_); p_[0] = (u32x4){x_[0], x_[1], x_[2], x_[3]}; p_[1] = (u32x4){x_[4], x_[5], x_[6], x_[7]}; } while (0)
                LAS unsigned char* rq = lds + SA_QTG + c * 336; LAS unsigned char* rk = lds + SA_KT + c * 336;
                ST16(rq + sb * 32, qtp); ST16(rq + 128 + sb * 32, qgp); ST16(rk + (kbase + sb * 16) * 2, kop);
                if (sb == 0) { ST16(rk + 16 * 2, bap); ST16(rk + 48 * 2, b2p); ST16(rk + 96 * 2, b3p); }
                if (sb == 1) { ST16(rk + (48 + 16) * 2, bap); ST16(rk + (96 + 16) * 2, b2p); }
                if (sb == 2) { ST16(rk + (96 + 32) * 2, bap); }
                ST16(lds + SA_KD + c * TS + sb * 32, kdp);
#undef ST16
            }
            lds_barrier();
            for (int ti = w; ti < 10; ti += 8) {
                const int bi = ti < 1 ? 0 : (ti < 3 ? 1 : (ti < 6 ? 2 : 3)), bj = ti - (bi * (bi + 1)) / 2;
                const int kb = bi == 0 ? 0 : (bi == 1 ? 16 : (bi == 2 ? 48 : 96));
                f32x4 acc = (f32x4){0.f, 0.f, 0.f, 0.f};
#pragma unroll
                for (int ks = 0; ks < 4; ++ks) acc = MFMA16(trfrag(lds + SA_KT, 336, kb + bj * 16, ks * 32, r, q), trfrag(lds + SA_QTG, 336, bi * 16, ks * 32, r, q), acc);
#pragma unroll
                for (int jj = 0; jj < 4; ++jj) if (bi == bj && 4 * q + jj > r) acc[jj] = 0.f;
                u32x2 aw; aw.x = cvt_pk_bf16(acc[0], acc[1]); aw.y = cvt_pk_bf16(acc[2], acc[3]);
                *(LAS u32x2*)(lds + SA_AB + (bi * 16 + r) * TS + (bj * 16 + 4 * q) * 2) = aw;
            }
            const int tb = w >> 1, vb0 = 2 * (w & 1);
            f32x4 oacc[2] = {(f32x4){0.f, 0.f, 0.f, 0.f}, (f32x4){0.f, 0.f, 0.f, 0.f}};
#pragma unroll
            for (int ks = 0; ks < 4; ++ks) { const bf16x8_t af = trfrag(lds + SA_QTG, 336, 64 + tb * 16, ks * 32, r, q);
#pragma unroll
                for (int u = 0; u < 2; ++u) oacc[u] = MFMA16(ldfrag(lds + SA_SB, RS, (vb0 + u) * 16 + r, ks * 32 + q * 8), af, oacc[u]); }
            lds_barrier();
            for (int ks = 0; ks <= (tb >> 1); ++ks) { const bf16x8_t af = ldfrag(lds + SA_AB, TS, tb * 16 + r, ks * 32 + q * 8);
#pragma unroll
                for (int u = 0; u < 2; ++u) oacc[u] = MFMA16(trfrag(lds + SA_VT, RK, (vb0 + u) * 16, ks * 32, r, q), af, oacc[u]); }
            { const int row = b * LPB + pos_of_step(n * 64 + tb * 16 + r, dir, false);
                bf16_t* op = O + ((size_t)dir * T + row) * 512 + h * 128 + vh * 64 + vb0 * 16 + 4 * q;
#pragma unroll
                for (int u = 0; u < 2; ++u) { u32x2 ow; ow.x = cvt_pk_bf16(oacc[u][0], oacc[u][1]); ow.y = cvt_pk_bf16(oacc[u][2], oacc[u][3]); *(u32x2*)(op + 16 * u) = ow; } }
            { const int kh = w >> 2, vq = w & 3;
                const bf16x8_t vf0 = trfrag(lds + SA_VT, RK, vq * 16, 0, r, q), vf1 = trfrag(lds + SA_VT, RK, vq * 16, 32, r, q);
#pragma unroll
                for (int kt = 0; kt < 4; ++kt) { const f32x4 dl = *(const LAS f32x4*)(DL + kh * 64 + kt * 16 + 4 * q);
                    f32x4 s = Sacc[kt] * dl;
                    s = MFMA16(ldfrag(lds + SA_KD, TS, kh * 64 + kt * 16 + r, q * 8), vf0, s); s = MFMA16(ldfrag(lds + SA_KD, TS, kh * 64 + kt * 16 + r, 32 + q * 8), vf1, s);
                    Sacc[kt] = s;
                    u32x2 pk; pk.x = cvt_pk_bf16(s[0], s[1]); pk.y = cvt_pk_bf16(s[2], s[3]);
                    *(LAS u32x2*)(lds + SA_SB + (vq * 16 + r) * RS + (kh * 64 + kt * 16 + 4 * q) * 2) = pk; } }
            if (n + 1 < NCHUNK) SA_STAGE();
            lds_barrier();
        }
#undef SA_LOAD
#undef SA_STAGE
    }
}


constexpr int SB_Q = 0, SB_K = SB_Q + 64 * RS, SB_KW = SB_K + 64 * RS, SB_VT = SB_KW + 128 * TS, SB_AB = SB_VT + 64 * RK, SB_CB = SB_AB + 64 * TS, SB_DENP = SB_CB + 64 * RS,
              SB_NP = SB_DENP + 4096, SB_N = SB_NP + 2048, SB_QN = SB_N + 512, SB_AS = SB_QN + 256, SB_MS = SB_AS + 256, SB_IN = SB_MS + 256, SB_EN = SB_IN + 256, SB_WS = SB_EN + 256, SB_DC = SB_WS + 256, SB_END = SB_DC + 16;
static_assert(SB_END <= 131072, "scan B images vs LDS");
__device__ __forceinline__ void scanB_mfma(KArgs a, int l, LAS unsigned char* lds) {
    a = fresh_args(a);
    const int tid = opaque_tid(), lane = tid & 63, w = __builtin_amdgcn_readfirstlane(tid >> 6), r = lane & 15, q = lane >> 4;
    const bf16_t* P = (const bf16_t*)(a->ws + WS_BIG); bf16_t* O = (bf16_t*)(a->ws + WS_O); const float* SC = (const float*)(a->ws + WS_SC);
    const int c = tid & 127, sb = __builtin_amdgcn_readfirstlane(tid >> 7);
    const int stok = tid >> 3, sp = tid & 7;
    LAS float* DENP = (LAS float*)(lds + SB_DENP); LAS float* NP = (LAS float*)(lds + SB_NP); LAS float* NV = (LAS float*)(lds + SB_N); LAS float* QN = (LAS float*)(lds + SB_QN);
    LAS float* AS = (LAS float*)(lds + SB_AS); LAS float* MS = (LAS float*)(lds + SB_MS); LAS float* IN = (LAS float*)(lds + SB_IN); LAS float* EN = (LAS float*)(lds + SB_EN); LAS float* WS = (LAS float*)(lds + SB_WS); LAS float* DC = (LAS float*)(lds + SB_DC);
    constexpr float KSCALE = 0.08838834764831845f;
    for (int it = blockIdx.x; it < 256; it += gridDim.x) {
        const int vh = it & 1, dir = (it >> 1) & 1, h = (it >> 2) & 3, b = it >> 4;
        const float bi = a->in[I_MGB][l * 16 + dir * 4 + h], bfg = a->in[I_MGB][l * 16 + (2 + dir) * 4 + h];
        __syncthreads();
        for (int i = tid; i < (SB_N + 512 - SB_AB) / 4; i += NTHR) ((LAS unsigned*)(lds + SB_AB))[i] = 0u;
        f32x4 Cacc[4];
#pragma unroll
        for (int i = 0; i < 4; ++i) Cacc[i] = (f32x4){0.f, 0.f, 0.f, 0.f};
        float m_run = 0.f;
        u32x4 qraw[2], kraw[2], vraw;
#define SB_LOAD(n) do { const bf16_t* pr = P + (size_t)(b * LPB + pos_of_step((n) * 64 + stok, dir, true)) * LDP + h * 128; \
            qraw[0] = *(const u32x4*)(pr + sp * 16); qraw[1] = *(const u32x4*)(pr + sp * 16 + 8); kraw[0] = *(const u32x4*)(pr + 512 + sp * 16); kraw[1] = *(const u32x4*)(pr + 512 + sp * 16 + 8); \
            vraw = *(const u32x4*)(pr + 1024 + vh * 64 + sp * 8); \
            if (w == 0) { const size_t srow = (size_t)(b * LPB + pos_of_step((n) * 64 + lane, dir, true)); igpre = SC[srow * 32 + dir * 4 + h]; fgpre = SC[srow * 32 + (2 + dir) * 4 + h]; } } while (0)
        float igpre = 0.f, fgpre = 0.f;
        SB_LOAD(0);
        for (int n = 0; n < NCHUNK; ++n) {
            *(LAS u32x4*)(lds + SB_Q + stok * RS + sp * 32) = qraw[0]; *(LAS u32x4*)(lds + SB_Q + stok * RS + sp * 32 + 16) = qraw[1];
            *(LAS u32x4*)(lds + SB_K + stok * RS + sp * 32) = kraw[0]; *(LAS u32x4*)(lds + SB_K + stok * RS + sp * 32 + 16) = kraw[1];
            *(LAS u32x4*)(lds + SB_VT + stok * RK + sp * 16) = vraw;
            if (w == 0) {
                const float ig = igpre + bi, fg = fgpre + bfg;
                float bb = fminf(fg, 0.f) - log1pf(__expf(-fabsf(fg)));
                bb = wave_scan_add(bb);
                const float av = ig - bb; float pm = av;
                pm = wave_scan_max(pm);
                const float M = fmaxf(pm, m_run), M63 = lane63(M), bb63 = lane63(bb);
                AS[lane] = av; MS[lane] = M; IN[lane] = __expf(m_run - M); EN[lane] = __expf(-(bb + M)); WS[lane] = __expf(av - M63) * KSCALE;
                if (lane == 0) DC[0] = __expf(m_run - M63);
                m_run = bb63 + M63;
            }
            lds_barrier();
            if (n + 1 < NCHUNK) SB_LOAD(n + 1);
            { float np = 0.f; unsigned kwp[8];
#pragma unroll
                for (int g4 = 0; g4 < 4; ++g4) { const v4i16_t kq = tr4(lds + SB_K, RS, sb * 16 + 4 * g4, c & ~15, lane & 15); const f32x4 wv = *(const LAS f32x4*)(WS + sb * 16 + 4 * g4);
                    const float k0 = bf2f((unsigned short)kq[0]) * wv[0], k1 = bf2f((unsigned short)kq[1]) * wv[1], k2 = bf2f((unsigned short)kq[2]) * wv[2], k3 = bf2f((unsigned short)kq[3]) * wv[3];
                    np += (k0 + k1) + (k2 + k3); kwp[2 * g4] = cvt_pk_bf16(k0, k1); kwp[2 * g4 + 1] = cvt_pk_bf16(k2, k3); }
                LAS u32x4* pkw = (LAS u32x4*)(lds + SB_KW + c * TS + sb * 32);
                pkw[0] = (u32x4){kwp[0], kwp[1], kwp[2], kwp[3]}; pkw[1] = (u32x4){kwp[4], kwp[5], kwp[6], kwp[7]};
                NP[sb * 128 + c] = np; }
            { const u32x4 q0 = *(const LAS u32x4*)(lds + SB_Q + stok * RS + sp * 32), q1 = *(const LAS u32x4*)(lds + SB_Q + stok * RS + sp * 32 + 16); float s = 0.f;
#pragma unroll
                for (int j = 0; j < 4; ++j) { const f32x4 n0 = *(const LAS f32x4*)(NV + sp * 16 + 4 * j);
                    const unsigned u0 = j < 2 ? q0[2 * j] : q1[2 * j - 4], u1 = j < 2 ? q0[2 * j + 1] : q1[2 * j - 3];
                    s += __uint_as_float(u0 << 16) * n0[0] + __uint_as_float(u0 & 0xffff0000u) * n0[1] + __uint_as_float(u1 << 16) * n0[2] + __uint_as_float(u1 & 0xffff0000u) * n0[3]; }
                s = red8(s);
                if (sp == 0) QN[stok] = s; }
            for (int ti = w; ti < 10; ti += 8) {
                const int tbi = ti < 1 ? 0 : (ti < 3 ? 1 : (ti < 6 ? 2 : 3)), tbj = ti - (tbi * (tbi + 1)) / 2;
                f32x4 acc = (f32x4){0.f, 0.f, 0.f, 0.f};
#pragma unroll
                for (int ks = 0; ks < 4; ++ks) acc = MFMA16(ldfrag(lds + SB_K, RS, tbj * 16 + r, ks * 32 + q * 8), ldfrag(lds + SB_Q, RS, tbi * 16 + r, ks * 32 + q * 8), acc);
                const f32x4 as4 = *(const LAS f32x4*)(AS + tbj * 16 + 4 * q); const float mt = MS[tbi * 16 + r];
#pragma unroll
                for (int jj = 0; jj < 4; ++jj) { acc[jj] *= KSCALE * __expf(as4[jj] - mt); if (tbi == tbj && 4 * q + jj > r) acc[jj] = 0.f; }
                u32x2 aw; aw.x = cvt_pk_bf16(acc[0], acc[1]); aw.y = cvt_pk_bf16(acc[2], acc[3]);
                *(LAS u32x2*)(lds + SB_AB + (tbi * 16 + r) * TS + (tbj * 16 + 4 * q) * 2) = aw;
                DENP[(tbi * 16 + r) * 16 + tbj * 4 + q] = (acc[0] + acc[1]) + (acc[2] + acc[3]);
            }
            const int tb = w >> 1, vb0 = 2 * (w & 1);
            f32x4 oacc[2] = {(f32x4){0.f, 0.f, 0.f, 0.f}, (f32x4){0.f, 0.f, 0.f, 0.f}};
#pragma unroll
            for (int ks = 0; ks < 4; ++ks) { const bf16x8_t af = ldfrag(lds + SB_Q, RS, tb * 16 + r, ks * 32 + q * 8);
#pragma unroll
                for (int u = 0; u < 2; ++u) oacc[u] = MFMA16(ldfrag(lds + SB_CB, RS, (vb0 + u) * 16 + r, ks * 32 + q * 8), af, oacc[u]); }
            lds_barrier();
            { const int t1 = tb * 16 + r; const float inr = IN[t1]; oacc[0] *= inr; oacc[1] *= inr;
                for (int ks = 0; ks <= (tb >> 1); ++ks) { const bf16x8_t af = ldfrag(lds + SB_AB, TS, tb * 16 + r, ks * 32 + q * 8);
#pragma unroll
                    for (int u = 0; u < 2; ++u) oacc[u] = MFMA16(trfrag(lds + SB_VT, RK, (vb0 + u) * 16, ks * 32, r, q), af, oacc[u]); }
                const f32x4 dp0 = *(const LAS f32x4*)(DENP + t1 * 16), dp1 = *(const LAS f32x4*)(DENP + t1 * 16 + 4), dp2 = *(const LAS f32x4*)(DENP + t1 * 16 + 8), dp3 = *(const LAS f32x4*)(DENP + t1 * 16 + 12);
                const f32x4 dps = (dp0 + dp1) + (dp2 + dp3);
                const float den = (dps[0] + dps[1]) + (dps[2] + dps[3]) + inr * QN[t1]; const float dn = 1.0f / fmaxf(fabsf(den), EN[t1]);
                const int row = b * LPB + pos_of_step(n * 64 + t1, dir, true);
                bf16_t* op = O + ((size_t)dir * T + row) * 512 + h * 128 + vh * 64 + vb0 * 16 + 4 * q;
#pragma unroll
                for (int u = 0; u < 2; ++u) { u32x2 ow; ow.x = cvt_pk_bf16(oacc[u][0] * dn, oacc[u][1] * dn); ow.y = cvt_pk_bf16(oacc[u][2] * dn, oacc[u][3] * dn); *(u32x2*)(op + 16 * u) = ow; } }
            { const int kh = w >> 2, vq = w & 3; const float dc = DC[0];
                const bf16x8_t vf0 = trfrag(lds + SB_VT, RK, vq * 16, 0, r, q), vf1 = trfrag(lds + SB_VT, RK, vq * 16, 32, r, q);
#pragma unroll
                for (int kt = 0; kt < 4; ++kt) { f32x4 s = Cacc[kt] * dc;
                    s = MFMA16(ldfrag(lds + SB_KW, TS, kh * 64 + kt * 16 + r, q * 8), vf0, s); s = MFMA16(ldfrag(lds + SB_KW, TS, kh * 64 + kt * 16 + r, 32 + q * 8), vf1, s);
                    Cacc[kt] = s;
                    u32x2 pk; pk.x = cvt_pk_bf16(s[0], s[1]); pk.y = cvt_pk_bf16(s[2], s[3]);
                    *(LAS u32x2*)(lds + SB_CB + (vq * 16 + r) * RS + (kh * 64 + kt * 16 + 4 * q) * 2) = pk; }
                if (tid < 128) NV[tid] = dc * NV[tid] + ((NP[tid] + NP[128 + tid]) + (NP[256 + tid] + NP[384 + tid])); }
            lds_barrier();
        }
#undef SB_LOAD
    }
}


__device__ __forceinline__ void prepC_phase(KArgs a, int l, LAS unsigned char* lds) {
    a = fresh_args(a);
    const int tid = opaque_tid(), lane = tid & 63, wave = __builtin_amdgcn_readfirstlane(tid >> 6), G = gridDim.x;
    const bf16_t* P = (const bf16_t*)(a->ws + WS_BIG); bf16_t* QP = (bf16_t*)(a->ws + WS_YS);
    LAS float* CW = (LAS float*)lds;
    { const float* cw = a->in[I_CONVW] + (size_t)l * 3 * 1536; for (int i = tid; i < 3 * 1536; i += NTHR) CW[i] = cw[i]; }
    __syncthreads();
    const int gw = blockIdx.x * NWAVES + wave, NGW = G * NWAVES;
    u32x4 nx[3][3];
#define PC_LOAD(r_) do { const int b_ = (r_) / LPB, p_ = (r_) - b_ * LPB; const bool ic_ = p_ < CTX; const int lp_ = ic_ ? p_ : p_ - CTX, Ls_ = ic_ ? CTX : SEQ; \
        const bf16_t* pr_ = P + (size_t)(r_) * LDP + lane * 8; const u32x4 z4_ = (u32x4){0u, 0u, 0u, 0u}; \
        _Pragma("unroll") for (int part_ = 0; part_ < 3; ++part_) { nx[part_][1] = *(const u32x4*)(pr_ + part_ * 512); nx[part_][0] = lp_ > 0 ? *(const u32x4*)(pr_ + part_ * 512 - LDP) : z4_; nx[part_][2] = lp_ < Ls_ - 1 ? *(const u32x4*)(pr_ + part_ * 512 + LDP) : z4_; } } while (0)
    if (gw < T) PC_LOAD(gw);
    for (int row = gw; row < T; row += NGW) {
        u32x4 cx[3][3];
#pragma unroll
        for (int i_ = 0; i_ < 3; ++i_)
#pragma unroll
            for (int j_ = 0; j_ < 3; ++j_) cx[i_][j_] = nx[i_][j_];
        if (row + NGW < T) PC_LOAD(row + NGW);
#pragma unroll
        for (int part = 0; part < 3; ++part) {
            const u32x4 x0 = cx[part][0], x1 = cx[part][1], x2 = cx[part][2];
            float y[8];
#pragma unroll
            for (int g4 = 0; g4 < 2; ++g4) { const f32x4 w0 = *(const LAS f32x4*)(CW + part * 512 + lane * 8 + 4 * g4), w1 = *(const LAS f32x4*)(CW + 1536 + part * 512 + lane * 8 + 4 * g4), w2 = *(const LAS f32x4*)(CW + 3072 + part * 512 + lane * 8 + 4 * g4);
#pragma unroll
                for (int h2 = 0; h2 < 2; ++h2) { const unsigned u0 = x0[2 * g4 + h2], u1 = x1[2 * g4 + h2], u2 = x2[2 * g4 + h2];
                    const float lo = __uint_as_float(u0 << 16) * w0[2 * h2] + __uint_as_float(u1 << 16) * w1[2 * h2] + __uint_as_float(u2 << 16) * w2[2 * h2];
                    const float hi = __uint_as_float(u0 & 0xffff0000u) * w0[2 * h2 + 1] + __uint_as_float(u1 & 0xffff0000u) * w1[2 * h2 + 1] + __uint_as_float(u2 & 0xffff0000u) * w2[2 * h2 + 1];
                    float s0, s1; sigm2(lo, hi, s0, s1); y[4 * g4 + 2 * h2] = lo * s0; y[4 * g4 + 2 * h2 + 1] = hi * s1; } }
            if (part < 2) { float ss = 0.f;
#pragma unroll
                for (int j = 0; j < 8; ++j) ss += y[j] * y[j];
                ss = red16(ss);
                const float rn = (part == 0 ? 0.08838834764831845f : 1.0f) / sqrtf(ss + L2_EPS);
#pragma unroll
                for (int j = 0; j < 8; ++j) y[j] *= rn; }
            u32x4 o; o.x = cvt_pk_bf16(y[0], y[1]); o.y = cvt_pk_bf16(y[2], y[3]); o.z = cvt_pk_bf16(y[4], y[5]); o.w = cvt_pk_bf16(y[6], y[7]);
            *(u32x4*)(QP + (size_t)row * 1536 + part * 512 + lane * 8) = o;
        }
    }
#undef PC_LOAD
}

constexpr int SC_Q = 0, SC_K = SC_Q + 64 * RS, SC_P0N = 0, SC_P0T = 64 * TS, SC_W = 0, SC_KT = SC_K + 64 * RS, SC_VT = SC_KT + 128 * TS, SC_QKM = SC_VT + 64 * TS,
              SC_A = SC_QKM + 64 * TS, SC_AT = SC_A + 64 * TS, SC_TB = SC_A, SC_TBG = SC_AT, SC_TX = SC_AT + 64 * TS, SC_TY = SC_TX + 64 * TS, SC_VN2 = SC_TX, SC_VNT = SC_TY, SC_SB = SC_TY + 64 * TS,
              SC_BG = SC_SB + 64 * RS, SC_KGS = SC_BG + 256, SC_EG = SC_KGS + 256, SC_GAM = SC_EG + 256, SC_BT = SC_GAM + 256, SC_GL = SC_BT + 256, SC_END = SC_GL + 16;
static_assert(SC_END <= LDSCTL_OFF && 2 * 64 * TS <= 64 * RS + 64 * RS && 64 * RS <= 2 * 64 * RS, "scan C images vs LDS");
__device__ __forceinline__ f32x4 ld_bf16x4_lds(const LAS unsigned char* p) { const u32x2 wv = *(const LAS u32x2*)p; return (f32x4){__uint_as_float(wv.x << 16), __uint_as_float(wv.x & 0xffff0000u), __uint_as_float(wv.y << 16), __uint_as_float(wv.y & 0xffff0000u)}; }
__device__ __forceinline__ f32x4 tile64(const LAS unsigned char* lds, int xi, int yi, int bx, int by, int lts, f32x4 acc) {
#pragma unroll
    for (int ks = 0; ks < 2; ++ks) acc = MFMA16(*(const LAS bf16x8_t*)(lds + xi + bx * 16 * TS + ks * 64 + lts), *(const LAS bf16x8_t*)(lds + yi + by * 16 * TS + ks * 64 + lts), acc);
    return acc;
}
__device__ __forceinline__ void st4(LAS unsigned char* lds, int img, int bx, int by, int ltt, f32x4 v) {
    u32x2 pk; pk.x = cvt_pk_bf16(v[0], v[1]); pk.y = cvt_pk_bf16(v[2], v[3]); *(LAS u32x2*)(lds + img + by * 16 * TS + bx * 32 + ltt) = pk;
}
constexpr int TC_ITEMS = NB * 4 * 2 * NCHUNK; constexpr size_t TQ_ITEM = 16384;
static_assert((size_t)TC_ITEMS * TQ_ITEM <= (size_t)2 * T * 512 * 2 && TC_ITEMS % 2 == 0, "TQ fits the O region");
constexpr int TQ_Q = 0, TQ_K = TQ_Q + 64 * RS, TQ_P0N = 0, TQ_P0T = 64 * TS, TQ_A = TQ_K + 64 * RS, TQ_AT = TQ_A + 64 * TS, TQ_TB = TQ_A, TQ_TX = TQ_AT + 64 * TS, TQ_TY = TQ_TX + 64 * TS, TQ_QKM = TQ_TY + 64 * TS,
              TQ_GAM = TQ_QKM + 64 * TS, TQ_BT = TQ_GAM + 256, TQ_SUB = TQ_BT + 256;
static_assert(2 * TQ_SUB <= LDSCTL_OFF && 2 * 64 * TS <= 2 * 64 * RS, "two transform pipelines vs LDS");
__device__ __forceinline__ void tcC_phase(KArgs a, int l, LAS unsigned char* lds0) {
    a = fresh_args(a);
    const int tid = opaque_tid(), w = __builtin_amdgcn_readfirstlane(tid >> 6), sub = w >> 2, w4 = w & 3;
    const bf16_t* QP = (const bf16_t*)(a->ws + WS_YS); unsigned char* TQ = a->ws + WS_O; const float* SC = (const float*)(a->ws + WS_SC);
    LAS unsigned char* lds = lds0 + sub * TQ_SUB;
    LAS float* GAM = (LAS float*)(lds + TQ_GAM); LAS float* BT = (LAS float*)(lds + TQ_BT);
    u32x4 rq[4], rk[4]; float gpre = 0.f, bpre = 0.f;
#define TC_LOAD(item) do { const int n_ = (item) % NCHUNK, rest_ = (item) / NCHUNK, dir_ = rest_ & 1, h_ = (rest_ >> 1) & 3, b_ = rest_ >> 3; \
        const bf16_t* pr = QP + (size_t)(b_ * LPB + pos_of_step(n_ * 64 + stok, dir_, false)) * 1536 + h_ * 128 + sp * 32; \
        _Pragma("unroll") for (int j_ = 0; j_ < 4; ++j_) { rq[j_] = *(const u32x4*)(pr + 8 * j_); rk[j_] = *(const u32x4*)(pr + 512 + 8 * j_); } \
        if (w4 == 0) { const size_t row = (size_t)(b_ * LPB + pos_of_step(n_ * 64 + (tid & 63), dir_, false)); gpre = SC[row * 32 + 16 + dir_ * 4 + h_]; bpre = SC[row * 32 + 16 + (2 + dir_) * 4 + h_]; } } while (0)
    { const int stok = (tid & 255) >> 2, sp = tid & 3; if (2 * (int)blockIdx.x + sub < TC_ITEMS) TC_LOAD(2 * (int)blockIdx.x + sub); }
    __syncthreads();
    for (int pr_ = blockIdx.x; 2 * pr_ < TC_ITEMS; pr_ += gridDim.x) {
        const int it = 2 * pr_ + sub;
        const int rest = it / NCHUNK, dir = rest & 1, h = (rest >> 1) & 3;
        const float nalog = -__expf(a->in[I_ALOG][l * 8 + dir * 4 + h]), dtb = a->in[I_DTB][l * 8 + dir * 4 + h];
        int oz = 0; asm volatile("" : "+v"(oz));
        const int t2 = tid + oz, lane = t2 & 63, r = lane & 15, q = lane >> 4, stok = (t2 & 255) >> 2, sp = t2 & 3;
        const int lrs = r * RS + q * 16 + oz, lts = r * TS + q * 16 + oz, ltt = r * TS + 8 * q + oz;
        { const int sto = stok * RS + sp * 64 + oz;
#pragma unroll
            for (int j = 0; j < 4; ++j) { *(LAS u32x4*)(lds + TQ_Q + 16 * j + sto) = rq[j]; *(LAS u32x4*)(lds + TQ_K + 16 * j + sto) = rk[j]; } }
        if (w4 == 0) {
            const float ap = gpre + dtb;
            float gm = nalog * (fmaxf(ap, 0.f) + log1pf(__expf(-fabsf(ap))));
            gm = wave_scan_add(gm);
            GAM[lane] = gm; BT[lane] = sigm(bpre);
        }
        lds_barrier();
        if (2 * (pr_ + (int)gridDim.x) < TC_ITEMS) TC_LOAD(2 * (pr_ + (int)gridDim.x) + sub);
        { const int by = w4; bf16x8_t fyk[4], fyq[4];
#pragma unroll
            for (int ks = 0; ks < 4; ++ks) { fyk[ks] = *(const LAS bf16x8_t*)(lds + TQ_K + by * 16 * RS + ks * 64 + lrs); fyq[ks] = *(const LAS bf16x8_t*)(lds + TQ_Q + by * 16 * RS + ks * 64 + lrs); }
            const int n_ = by * 16 + r; const float gn = GAM[n_], bn = BT[n_];
#pragma unroll
            for (int bx = 0; bx < 4; ++bx) { const int m0 = bx * 16 + 4 * q;
                f32x4 akk = (f32x4){0.f, 0.f, 0.f, 0.f}, aqk = (f32x4){0.f, 0.f, 0.f, 0.f};
#pragma unroll
                for (int ks = 0; ks < 4; ++ks) { const bf16x8_t fk = *(const LAS bf16x8_t*)(lds + TQ_K + bx * 16 * RS + ks * 64 + lrs); akk = MFMA16(fk, fyk[ks], akk); aqk = MFMA16(fk, fyq[ks], aqk); }
                const f32x4 gmv = *(const LAS f32x4*)(GAM + m0); f32x4 vq, va, v1;
#pragma unroll
                for (int jj = 0; jj < 4; ++jj) { const int m_ = m0 + jj; const float dec = __expf(-fabsf(gn - gmv[jj]));
                    vq[jj] = (m_ <= n_) ? aqk[jj] * dec : 0.f;
                    va[jj] = (m_ < n_) ? akk[jj] * dec * bn : 0.f;
                    v1[jj] = (m_ == n_ ? 1.0f : 0.f) - va[jj]; }
                st4(lds, TQ_QKM, bx, by, ltt, vq); st4(lds, TQ_A, bx, by, ltt, va); st4(lds, TQ_TX, bx, by, ltt, v1); }
        }
        lds_barrier();
#pragma unroll 1
        for (int rd = 1; rd <= 6; ++rd) {
            const int pn = (rd & 1) ? TQ_A : TQ_P0N, dn = (rd & 1) ? TQ_P0N : TQ_A, tsrc = (rd & 1) ? TQ_TY : TQ_TX, tdst = (rd & 1) ? TQ_TX : TQ_TY;
            { const int by = w4; bf16x8_t ypn[2], yts[2];
#pragma unroll
                for (int ks = 0; ks < 2; ++ks) { ypn[ks] = *(const LAS bf16x8_t*)(lds + pn + by * 16 * TS + ks * 64 + lts); yts[ks] = *(const LAS bf16x8_t*)(lds + tsrc + by * 16 * TS + ks * 64 + lts); }
                f32x4 rpn[4], rt[4];
#pragma unroll
                for (int bx = 0; bx < 4; ++bx) { rpn[bx] = (f32x4){0.f, 0.f, 0.f, 0.f}; rt[bx] = ld_bf16x4_lds(lds + tsrc + by * 16 * TS + bx * 32 + ltt);
#pragma unroll
                    for (int ks = 0; ks < 2; ++ks) { const bf16x8_t xpc = trfrag(lds + pn, TS, 16 * bx, 32 * ks, r, q);
                        rpn[bx] = MFMA16(xpc, ypn[ks], rpn[bx]);
                        rt[bx] = MFMA16(xpc, yts[ks], rt[bx]); } }
#pragma unroll
                for (int bx = 0; bx < 4; ++bx) {
                    if (rd < 6) st4(lds, dn, bx, by, ltt, rpn[bx]);
                    if (rd > 1) { if (rd < 6) st4(lds, tdst, bx, by, ltt, rt[bx]);
                        else { const f32x4 bs = *(const LAS f32x4*)(BT + bx * 16 + 4 * q); st4(lds, TQ_TB, bx, by, ltt, rt[bx] * bs); } } }
            }
            lds_barrier();
        }
        { unsigned char* dst = TQ + (size_t)it * TQ_ITEM + stok * 128 + sp * 32;
#pragma unroll
            for (int j = 0; j < 2; ++j) { *(u32x4*)(dst + 16 * j) = *(const LAS u32x4*)(lds + TQ_TB + stok * TS + sp * 32 + 16 * j + oz); *(u32x4*)(dst + 8192 + 16 * j) = *(const LAS u32x4*)(lds + TQ_QKM + stok * TS + sp * 32 + 16 * j + oz); } }
        lds_barrier();
    }
#undef TC_LOAD
}

constexpr int S3_Q = 0, S3_W = 0, S3_K = S3_Q + 64 * RS, S3_KT = S3_K + 64 * RS, S3_KTG = S3_KT + 128 * TS, S3_VT = S3_KTG + 128 * TS, S3_QKM = S3_VT + 64 * RK, S3_TB = S3_QKM + 64 * TS,
              S3_VNT = S3_TB + 64 * TS, S3_VN2 = S3_VNT + 64 * TS, S3_SB = S3_VN2 + 64 * TS, S3_EG = S3_SB + 64 * RS, S3_KGS = S3_EG + 256, S3_GL = S3_KGS + 256, S3_END = S3_GL + 16;
static_assert(S3_END <= LDSCTL_OFF, "scan C images vs LDS");
__device__ __forceinline__ void scanC_mfma(KArgs a, int l, LAS unsigned char* lds) {
    a = fresh_args(a);
    const int tid = opaque_tid(), w = __builtin_amdgcn_readfirstlane(tid >> 6);
    const bf16_t* QP = (const bf16_t*)(a->ws + WS_YS); const unsigned char* TQ = a->ws + WS_O; bf16_t* OP = (bf16_t*)(a->ws + WS_BIG); const float* SC = (const float*)(a->ws + WS_SC);
    LAS float* KGS = (LAS float*)(lds + S3_KGS); LAS float* EG = (LAS float*)(lds + S3_EG); LAS float* GL = (LAS float*)(lds + S3_GL);
    for (int it = blockIdx.x; it < 256; it += gridDim.x) {
        const int vh = it & 1, dir = (it >> 1) & 1, h = (it >> 2) & 3, b = it >> 4;
        const float nalog = -__expf(a->in[I_ALOG][l * 8 + dir * 4 + h]), dtb = a->in[I_DTB][l * 8 + dir * 4 + h];
        const unsigned char* tqb = TQ + (size_t)(((b * 4 + h) * 2 + dir) * NCHUNK) * TQ_ITEM;
        __syncthreads();
        for (int i = tid; i < 64 * RS / 4; i += NTHR) ((LAS unsigned*)(lds + S3_SB))[i] = 0u;
        __syncthreads();
        f32x4 Sacc[4];
#pragma unroll
        for (int i = 0; i < 4; ++i) Sacc[i] = (f32x4){0.f, 0.f, 0.f, 0.f};
        u32x4 rq[2], rk[2], rv, rtb, rqk; float gpre = 0.f;
#define SC_LOAD(n) do { const bf16_t* pr = QP + (size_t)(b * LPB + pos_of_step((n) * 64 + stok, dir, false)) * 1536 + h * 128; \
            rq[0] = *(const u32x4*)(pr + sp * 16); rq[1] = *(const u32x4*)(pr + sp * 16 + 8); rk[0] = *(const u32x4*)(pr + 512 + sp * 16); rk[1] = *(const u32x4*)(pr + 512 + sp * 16 + 8); rv = *(const u32x4*)(pr + 1024 + vh * 64 + sp * 8); \
            rtb = *(const u32x4*)(tqb + (size_t)(n) * TQ_ITEM + stok * 128 + sp * 16); rqk = *(const u32x4*)(tqb + (size_t)(n) * TQ_ITEM + 8192 + stok * 128 + sp * 16); \
            if (w == 0) { const size_t row = (size_t)(b * LPB + pos_of_step((n) * 64 + (tid & 63), dir, false)); gpre = SC[row * 32 + 16 + dir * 4 + h]; } } while (0)
        { const int stok = tid >> 3, sp = tid & 7; SC_LOAD(0); }
        for (int n = 0; n < NCHUNK; ++n) {
            int oz = 0; asm volatile("" : "+v"(oz));
            const int t2 = tid + oz, lane = t2 & 63, r = lane & 15, q = lane >> 4, c = t2 & 127, sb = w >> 1, stok = t2 >> 3, sp = t2 & 7;
            const int lrs = r * RS + q * 16 + oz, lts = r * TS + q * 16 + oz, ltt = r * TS + 8 * q + oz, lrt = r * RS + 8 * q + oz;
            { const int sto = stok * RS + sp * 32 + oz, tso = stok * TS + sp * 16 + oz;
                *(LAS u32x4*)(lds + S3_Q + sto) = rq[0]; *(LAS u32x4*)(lds + S3_Q + 16 + sto) = rq[1]; *(LAS u32x4*)(lds + S3_K + sto) = rk[0]; *(LAS u32x4*)(lds + S3_K + 16 + sto) = rk[1];
                *(LAS u32x4*)(lds + S3_TB + tso) = rtb; *(LAS u32x4*)(lds + S3_QKM + tso) = rqk;
                *(LAS u32x4*)(lds + S3_VT + stok * RK + sp * 16 + oz) = rv; }
            if (w == 0) {
                const float ap = gpre + dtb;
                float gm = nalog * (fmaxf(ap, 0.f) + log1pf(__expf(-fabsf(ap))));
                gm = wave_scan_add(gm);
                const float g63 = lane63(gm);
                EG[lane] = __expf(gm); KGS[lane] = __expf(g63 - gm);
                if (lane == 0) GL[0] = __expf(g63);
            }
            lds_barrier();
            if (n + 1 < NCHUNK) SC_LOAD(n + 1);
            { unsigned p0[8], p1[8];
#pragma unroll
                for (int g4 = 0; g4 < 4; ++g4) { const v4i16_t kq = tr4(lds + S3_K + oz, RS, sb * 16 + 4 * g4, c & ~15, r); const f32x4 eg4 = *(const LAS f32x4*)(EG + sb * 16 + 4 * g4);
                    const unsigned h0 = (unsigned short)kq[0], h1 = (unsigned short)kq[1], h2 = (unsigned short)kq[2], h3 = (unsigned short)kq[3];
                    p0[2 * g4] = h0 | (h1 << 16); p0[2 * g4 + 1] = h2 | (h3 << 16);
                    p1[2 * g4] = cvt_pk_bf16(__uint_as_float(h0 << 16) * eg4[0], __uint_as_float(h1 << 16) * eg4[1]); p1[2 * g4 + 1] = cvt_pk_bf16(__uint_as_float(h2 << 16) * eg4[2], __uint_as_float(h3 << 16) * eg4[3]); }
                LAS u32x4* d0 = (LAS u32x4*)(lds + S3_KT + c * TS + sb * 32 + oz); d0[0] = (u32x4){p0[0], p0[1], p0[2], p0[3]}; d0[1] = (u32x4){p0[4], p0[5], p0[6], p0[7]};
                LAS u32x4* d1 = (LAS u32x4*)(lds + S3_KTG + c * TS + sb * 32 + oz); d1[0] = (u32x4){p1[0], p1[1], p1[2], p1[3]}; d1[1] = (u32x4){p1[4], p1[5], p1[6], p1[7]}; }
            const int tb = w >> 1, vb0 = 2 * (w & 1);
            f32x4 oacc[2] = {(f32x4){0.f, 0.f, 0.f, 0.f}, (f32x4){0.f, 0.f, 0.f, 0.f}};
#pragma unroll
            for (int ks = 0; ks < 4; ++ks) { const bf16x8_t af = *(const LAS bf16x8_t*)(lds + S3_Q + tb * 16 * RS + ks * 64 + lrs);
#pragma unroll
                for (int u = 0; u < 2; ++u) oacc[u] = MFMA16(*(const LAS bf16x8_t*)(lds + S3_SB + (vb0 + u) * 16 * RS + ks * 64 + lrs), af, oacc[u]); }
            lds_barrier();
            f32x4 uacc[2];
#pragma unroll
            for (int u = 0; u < 2; ++u) uacc[u] = (f32x4){0.f, 0.f, 0.f, 0.f};
#pragma unroll
            for (int ks = 0; ks < 2; ++ks) { const bf16x8_t xf = *(const LAS bf16x8_t*)(lds + S3_TB + tb * 16 * TS + ks * 64 + lts);
#pragma unroll
                for (int u = 0; u < 2; ++u) uacc[u] = MFMA16(xf, trfrag(lds + S3_VT + oz, RK, (vb0 + u) * 16, ks * 32, r, q), uacc[u]); }
            { const int by = w & 3; bf16x8_t ytb[2], xkt[4][2];
#pragma unroll
                for (int ks = 0; ks < 2; ++ks) { ytb[ks] = *(const LAS bf16x8_t*)(lds + S3_TB + by * 16 * TS + ks * 64 + lts);
#pragma unroll
                    for (int jx = 0; jx < 4; ++jx) xkt[jx][ks] = *(const LAS bf16x8_t*)(lds + S3_KTG + ((w >> 2) + 2 * jx) * 16 * TS + ks * 64 + lts); }
#pragma unroll
                for (int jx = 0; jx < 4; ++jx) { const int kb = (w >> 2) + 2 * jx; f32x4 wv = (f32x4){0.f, 0.f, 0.f, 0.f};
#pragma unroll
                    for (int ks = 0; ks < 2; ++ks) wv = MFMA16(xkt[jx][ks], ytb[ks], wv);
                    u32x2 pk; pk.x = cvt_pk_bf16(wv[0], wv[1]); pk.y = cvt_pk_bf16(wv[2], wv[3]); *(LAS u32x2*)(lds + S3_W + by * 16 * RS + kb * 32 + lrt) = pk; } }
            lds_barrier();
            { const f32x4 kg = *(const LAS f32x4*)(KGS + tb * 16 + 4 * q);
                f32x4 ws[2] = {(f32x4){0.f, 0.f, 0.f, 0.f}, (f32x4){0.f, 0.f, 0.f, 0.f}};
#pragma unroll
                for (int ks = 0; ks < 4; ++ks) { const bf16x8_t xf = *(const LAS bf16x8_t*)(lds + S3_W + tb * 16 * RS + ks * 64 + lrs);
#pragma unroll
                    for (int u = 0; u < 2; ++u) ws[u] = MFMA16(xf, *(const LAS bf16x8_t*)(lds + S3_SB + (vb0 + u) * 16 * RS + ks * 64 + lrs), ws[u]); }
#pragma unroll
                for (int u = 0; u < 2; ++u) { const f32x4 vn = uacc[u] - ws[u]; st4(lds, S3_VNT, tb, vb0 + u, ltt, vn); st4(lds, S3_VN2, tb, vb0 + u, ltt, vn * kg); } }
            lds_barrier();
            { const float egt = EG[tb * 16 + r];
#pragma unroll
                for (int u = 0; u < 2; ++u) oacc[u] *= egt;
#pragma unroll
                for (int ks = 0; ks < 2; ++ks) { const bf16x8_t xf = *(const LAS bf16x8_t*)(lds + S3_QKM + tb * 16 * TS + ks * 64 + lts);
#pragma unroll
                    for (int u = 0; u < 2; ++u) oacc[u] = MFMA16(*(const LAS bf16x8_t*)(lds + S3_VNT + (vb0 + u) * 16 * TS + ks * 64 + lts), xf, oacc[u]); }
                const int row = b * LPB + pos_of_step(n * 64 + tb * 16 + r, dir, false);
                bf16_t* op = OP + (size_t)row * LDP + dir * 512 + h * 128 + vh * 64 + vb0 * 16 + 4 * q;
#pragma unroll
                for (int u = 0; u < 2; ++u) { u32x2 ow; ow.x = cvt_pk_bf16(oacc[u][0], oacc[u][1]); ow.y = cvt_pk_bf16(oacc[u][2], oacc[u][3]); *(u32x2*)(op + 16 * u) = ow; } }
            { const int kh = w >> 2, vq = w & 3; const float gl = GL[0];
                bf16x8_t yv[2];
#pragma unroll
                for (int ks = 0; ks < 2; ++ks) yv[ks] = *(const LAS bf16x8_t*)(lds + S3_VN2 + vq * 16 * TS + ks * 64 + lts);
#pragma unroll
                for (int kt = 0; kt < 4; ++kt) { f32x4 s = Sacc[kt] * gl;
#pragma unroll
                    for (int ks = 0; ks < 2; ++ks) s = MFMA16(*(const LAS bf16x8_t*)(lds + S3_KT + (kh * 4 + kt) * 16 * TS + ks * 64 + lts), yv[ks], s);
                    Sacc[kt] = s;
                    u32x2 pk; pk.x = cvt_pk_bf16(s[0], s[1]); pk.y = cvt_pk_bf16(s[2], s[3]);
                    *(LAS u32x2*)(lds + S3_SB + vq * 16 * RS + (kh * 64 + kt * 16) * 2 + lrt) = pk; } }
            lds_barrier();
        }
#undef SC_LOAD
    }
}

__device__ __forceinline__ void finalize_phase(KArgs a, int l, int mx, LAS unsigned char* lds) {
    a = fresh_args(a);
    const int tid = opaque_tid(), lane = tid & 63, wave = __builtin_amdgcn_readfirstlane(tid >> 6), G = gridDim.x;
    const bf16_t* P = (const bf16_t*)(a->ws + WS_BIG); const bf16_t* O = (const bf16_t*)(a->ws + WS_O); bf16_t* YS = (bf16_t*)(a->ws + WS_YS);
    const int gate_off = (mx == 0) ? 2048 : 1536, c8 = lane * 8;
    const float* gn = a->in[I_MIXN] + (size_t)(l * 3 + mx) * 512 + c8;
    const f32x4 g0 = *(const f32x4*)gn, g1 = *(const f32x4*)(gn + 4);
    const int gw = blockIdx.x * NWAVES + wave, NGW = G * NWAVES;
    for (int row = gw; row < T; row += NGW) {
        const u32x4 of = (mx == 2) ? *(const u32x4*)(P + (size_t)row * LDP + c8) : *(const u32x4*)(O + (size_t)row * 512 + c8);
        const u32x4 ob = (mx == 2) ? *(const u32x4*)(P + (size_t)row * LDP + 512 + c8) : *(const u32x4*)(O + ((size_t)T + row) * 512 + c8), gt = *(const u32x4*)(P + (size_t)row * LDP + gate_off + c8);
        float o[8], g[8];
#pragma unroll
        for (int j = 0; j < 4; ++j) { o[2 * j] = __uint_as_float(of[j] << 16) + __uint_as_float(ob[j] << 16); o[2 * j + 1] = __uint_as_float(of[j] & 0xffff0000u) + __uint_as_float(ob[j] & 0xffff0000u);
            g[2 * j] = __uint_as_float(gt[j] << 16); g[2 * j + 1] = __uint_as_float(gt[j] & 0xffff0000u); }
        float ss = 0.f;
#pragma unroll
        for (int j = 0; j < 8; ++j) ss += o[j] * o[j];
        ss = red16(ss);
        const float r = 1.0f / sqrtf(ss * (1.0f / 128.0f) + RMS_EPS);
        float y[8];
#pragma unroll
        for (int j = 0; j < 8; j += 2) { float s0, s1; sigm2(g[j], g[j + 1], s0, s1); const float a0 = (mx == 1) ? s0 : g[j] * s0, a1 = (mx == 1) ? s1 : g[j + 1] * s1;
            y[j] = o[j] * r * (j < 4 ? g0[j & 3] : g1[j & 3]) * a0; y[j + 1] = o[j + 1] * r * (j + 1 < 4 ? g0[(j + 1) & 3] : g1[(j + 1) & 3]) * a1; }
        u32x4 w; w.x = cvt_pk_bf16(y[0], y[1]); w.y = cvt_pk_bf16(y[2], y[3]); w.z = cvt_pk_bf16(y[4], y[5]); w.w = cvt_pk_bf16(y[6], y[7]);
        *(u32x4*)(YS + (size_t)row * LDYS + mx * 512 + c8) = w;
    }
}

#ifdef NO_SCANS
#define SCAN_CALL(x)
#else
#define SCAN_CALL(x) x
#endif
#ifdef NO_ROWS
#define ROW_CALL(x)
#else
#define ROW_CALL(x) x
#endif
#ifndef SITES
#define SITES 0xff
#endif
#define GEMM_SITE(i) if ((SITES >> (i)) & 1)
#ifndef MK_ONE_LAUNCH
#define MK_ONE_LAUNCH 1
#endif
constexpr int PH_TOTAL = 2 + 2 * (16 + 3 + 1) + 2 * (16 + 1 + 4 + 1);

__global__ void __launch_bounds__(NTHR, 2) mk_fwd(Args a_by_value) {
    (void)a_by_value; KArgs a = (KArgs)__builtin_amdgcn_kernarg_segment_ptr();
    extern __shared__ __attribute__((aligned(16))) unsigned char lds_raw[];
    LAS unsigned char* lds = (LAS unsigned char*)lds_raw;
    const int tid = opaque_tid(), G = gridDim.x;
    for (int u = tid; u < (LDS_BYTES - LDSCTL_OFF) / 4; u += NTHR) ((LAS unsigned*)(lds + LDSCTL_OFF))[u] = 0u;
    __syncthreads();
    volatile LAS unsigned* MISC = (volatile LAS unsigned*)(lds + LDSCTL_OFF + 320);
    unsigned* ctl = (unsigned*)(a->ws + WS_CTL);
    const int lo = a->ph_lo, hi = a->ph_hi;
    XcdBarrier bar; bar.bar = ctl + CW_BAR; bar.x = 0; bar.st = nullptr;
    if (hi - lo > 1) bar = xcd_barrier_post(ctl + CW_BAR, MISC + 8);
    int ph = 0;
#define RUN (ph >= lo && ph < hi)
#define NEXT() do { if (RUN && ph + 1 < hi) xcd_barrier(bar); ++ph; } while (0)
    bf16_t* H = (bf16_t*)(a->ws + WS_H); bf16_t* YS = (bf16_t*)(a->ws + WS_YS); bf16_t* BIG = (bf16_t*)(a->ws + WS_BIG);
    float* XS = (float*)(a->ws + WS_XS); float* SC = (float*)(a->ws + WS_SC); const float* MOD = (const float*)(a->ws + WS_MOD);

    if (RUN) { ROW_CALL(pro_a(a, lds)); }
    NEXT();
    if (RUN) { ROW_CALL(rowpass<0>(a, 0, lds)); }
    NEXT();
    for (int l = 0; l < DEPTH; ++l) {
        unsigned char* lw = a->ws + WS_W + (size_t)l * LW_BYTES;
        const bf16_t* WinT = (const bf16_t*)lw; const bf16_t* WbT = (const bf16_t*)(lw + LW_WB); const bf16_t* WoT = (const bf16_t*)(lw + LW_WO);
        if (RUN) { pg8::Gemm g{H, WinT + (size_t)4864 * D, D, D, nullptr}; pg8::StaticOrder S; S.init(T, 2048, G, (int)blockIdx.x); pg8::EpiP E{BIG, LDP, nullptr, -1, 0, 0, nullptr, 0, 0};
            { const int rr = (NTILE * 8) % G, first = rr, nw = G - first, tq_ = opaque_tid(), wv = __builtin_amdgcn_readfirstlane(tq_ >> 6), ln = tq_ & 63;
                if ((int)blockIdx.x >= first) { sc_stage_w(WinT + (size_t)4608 * D, lds, tq_); __syncthreads(); for (int u = (int)blockIdx.x - first; u < NTILE; u += nw) sc_unit(H, lds, SC, u, wv, ln); __syncthreads(); } }
            GEMM_SITE(2) pg8::gemm_phase<pg8::EpiP, pg8::StaticOrder, true, true>(lds, g, S, E); }
        NEXT();
        if (RUN) { ROW_CALL(prepC_phase(a, l, lds)); }
        NEXT();
        if (RUN) { SCAN_CALL(tcC_phase(a, l, lds)); }
        NEXT();
        if (RUN) { SCAN_CALL(scanC_mfma(a, l, lds)); }
        NEXT();
        if (RUN) { ROW_CALL(finalize_phase(a, l, 2, lds)); }
        NEXT();
        if (RUN) { pg8::Gemm g{H, WinT, D, D, nullptr}; pg8::StaticOrder S; S.init(T, 2560, G, (int)blockIdx.x); pg8::EpiP E{BIG, LDP, nullptr, -1, 0, 0, (const float*)(a->ws + WS_OML) + l * 512, 2, 6};
            GEMM_SITE(0) pg8::gemm_phase<pg8::EpiP, pg8::StaticOrder, true, true>(lds, g, S, E); }
        NEXT();
        if (RUN) { SCAN_CALL(scanA_mfma(a, l, lds)); }
        NEXT();
        if (RUN) { ROW_CALL(finalize_phase(a, l, 0, lds)); }
        NEXT();
        if (RUN) { pg8::Gemm g{H, WinT + (size_t)2560 * D, D, D, nullptr}; pg8::StaticOrder S; S.init(T, 2048, G, (int)blockIdx.x); pg8::EpiP E{BIG, LDP, nullptr, -1, 0, 0, nullptr, 0, 0};
            GEMM_SITE(1) pg8::gemm_phase<pg8::EpiP, pg8::StaticOrder, true, true>(lds, g, S, E); }
        NEXT();
        if (RUN) { SCAN_CALL(scanB_mfma(a, l, lds)); }
        NEXT();
        if (RUN) { ROW_CALL(finalize_phase(a, l, 1, lds)); }
        NEXT();
        if (RUN) { pg8::Gemm g{H, WinT + (size_t)6912 * D, D, D, nullptr}; pg8::StaticOrder S; S.init(l == DEPTH - 1 ? NB * SEQ : T, 3072, G, (int)blockIdx.x); S.lat = (l == DEPTH - 1); pg8::EpiP E{BIG, LDMG, nullptr, -1, 1, 0, nullptr, 0, 0};
            GEMM_SITE(3) pg8::gemm_phase<pg8::EpiP, pg8::StaticOrder, true, true>(lds, g, S, E); }
        NEXT();
        const bool brsplit = (l != DEPTH - 1) && G == 256;
        if (RUN) { pg8::Gemm g{YS, WbT, LDYS, 1536, nullptr}; pg8::StaticOrder S; S.init(l == DEPTH - 1 ? NB * SEQ : T, 1024, G, (int)blockIdx.x); S.lat = (l == DEPTH - 1); pg8::EpiMixed E{BIG, H};
            if (brsplit) S.lim = 1024;
            GEMM_SITE(4) pg8::gemm_phase<pg8::EpiMixed, pg8::StaticOrder, true, true>(lds, g, S, E); }
        NEXT();
        if (RUN) { if (brsplit) {
                if ((int)blockIdx.x < 64) { pg8::Gemm g{YS, WbT, LDYS, 1536, nullptr}; pg8::StaticOrder S; S.init(T, 1024, G, (int)blockIdx.x); S.L0 = 1024; pg8::EpiMixed E{BIG, H};
                    GEMM_SITE(4) pg8::gemm_phase<pg8::EpiMixed, pg8::StaticOrder, true, true>(lds, g, S, E); }
                else { pg8::Gemm g{H, WoT, D, D, nullptr}; pg8::StaticOrder S; S.init(T, 1024, 192, (int)blockIdx.x - 64); S.L0 = 192; S.lim = 384; const float* lnid = (const float*)(a->ws + WS_LNID);
                    pg8::EpiRes E{XS, MOD + (size_t)l * 17 * 6144 + 2 * 1024, (const float*)(a->ws + (l ? WS_STAT : WS_ZSTAT)), l ? a->in[I_LNG] + (size_t)(l * 2 - 1) * D : lnid, l ? a->in[I_LNB] + (size_t)(l * 2 - 1) * D : lnid + 1024, a->in[I_X], a->in[I_CTX], ALPHA, l == 0};
                    GEMM_SITE(5) pg8::gemm_phase<pg8::EpiRes, pg8::StaticOrder, true, true>(lds, g, S, E); } } }
        NEXT();
        if (RUN) { pg8::Gemm g{H, WoT, D, D, nullptr}; pg8::StaticOrder S; S.init(l == DEPTH - 1 ? NB * SEQ : T, 1024, G, (int)blockIdx.x); S.lat = (l == DEPTH - 1); const float* lnid = (const float*)(a->ws + WS_LNID);
            if (brsplit) { S.gap0 = 192; S.gaplen = 192; S.lim = 1088 - 192; }
            pg8::EpiRes E{XS, MOD + (size_t)l * 17 * 6144 + 2 * 1024, (const float*)(a->ws + (l ? WS_STAT : WS_ZSTAT)), l ? a->in[I_LNG] + (size_t)(l * 2 - 1) * D : lnid, l ? a->in[I_LNB] + (size_t)(l * 2 - 1) * D : lnid + 1024, a->in[I_X], a->in[I_CTX], ALPHA, l == 0};
            GEMM_SITE(5) pg8::gemm_phase<pg8::EpiRes, pg8::StaticOrder, true, true>(lds, g, S, E); }
        NEXT();
        const bool moe = (l & 1) != 0; const int ns = moe ? 2 : 1;
        const int dlim = (NTILE * (D / 256) / G) * G, nleft = NTILE * (D / 256) - dlim;
        if (RUN) { ROW_CALL(rowpass<1>(a, l, lds)); if (moe) { __syncthreads(); ROW_CALL(conv_moe(a, l >> 1, lds)); } }
        NEXT();
        if (moe) { if (RUN) moe_fill(a, l >> 1, l == DEPTH - 1); NEXT(); }
        for (int s = 0; s < ns; ++s) {
            const unsigned char* fw = moe ? a->ws + WS_YS : a->ws + WS_WFFN + (size_t)(l >> 1) * FFNW_BYTES;
            const int* perm = moe ? (const int*)(a->ws + WS_PERM) + (size_t)s * TP : (const int*)(a->ws + WS_PERMID);
            const float* permw = moe ? (const float*)(a->ws + WS_PERMW) + (size_t)s * TP : nullptr;
            if (RUN) { int ts[9]; if (moe) moe_tile_starts(a, l >> 1, s, ts); else {
#pragma unroll
                    for (int e = 0; e < 9; ++e) ts[e] = e ? NTILE : 0; }
                pg8::Gemm g{H, (const bf16_t*)fw, D, D, perm}; pg8::MoeOrder S; S.init2(ts[8], 2 * FFN / 256, G, (int)blockIdx.x);
                S.ts1 = ts[1]; S.ts2 = ts[2]; S.ts3 = ts[3]; S.ts4 = ts[4]; S.ts5 = ts[5]; S.ts6 = ts[6]; S.ts7 = ts[7]; S.estride = FFNW_BYTES;
                pg8::EpiSwiglu E{BIG, FFN};
                GEMM_SITE(6) pg8::gemm_phase<pg8::EpiSwiglu, pg8::MoeOrder, true, true, true>(lds, g, S, E); }
            NEXT();
            if (RUN) { int ts[9]; if (moe) moe_tile_starts(a, l >> 1, s, ts); else {
#pragma unroll
                    for (int e = 0; e < 9; ++e) ts[e] = e ? NTILE : 0; }
                pg8::Gemm g{BIG, (const bf16_t*)(fw + FFNW_WD), FFN, FFN, nullptr}; pg8::MoeOrder S; S.init2(ts[8], D / 256, G, (int)blockIdx.x);
                S.ts1 = ts[1]; S.ts2 = ts[2]; S.ts3 = ts[3]; S.ts4 = ts[4]; S.ts5 = ts[5]; S.ts6 = ts[6]; S.ts7 = ts[7]; S.estride = FFNW_BYTES;
                const float* lnid = (const float*)(a->ws + WS_LNID);
                pg8::EpiScatter E{XS, MOD + (size_t)l * 17 * 6144 + 5 * 1024, perm, permw, (const float*)(a->ws + (s == 0 ? WS_STAT : WS_ZSTAT)), s == 0 ? a->in[I_LNG] + (size_t)(l * 2) * D : lnid, s == 0 ? a->in[I_LNB] + (size_t)(l * 2) * D : lnid + 1024, s == 0 ? ALPHA : 1.0f};
                if (!moe && nleft > 0) S.lim = dlim;
                GEMM_SITE(7) pg8::gemm_phase<pg8::EpiScatter, pg8::MoeOrder, true, true, false>(lds, g, S, E); }
            NEXT();
        }
        if (!moe && nleft > 0) {
            if (RUN) {
                if ((int)blockIdx.x < nleft) {
                    const unsigned char* fw = a->ws + WS_WFFN + (size_t)(l >> 1) * FFNW_BYTES;
                    pg8::Gemm g{BIG, (const bf16_t*)(fw + FFNW_WD), FFN, FFN, nullptr}; pg8::MoeOrder S; S.init2(NTILE, D / 256, G, (int)blockIdx.x); S.L0 = dlim;
                    S.ts1 = NTILE; S.ts2 = NTILE; S.ts3 = NTILE; S.ts4 = NTILE; S.ts5 = NTILE; S.ts6 = NTILE; S.ts7 = NTILE; S.estride = FFNW_BYTES;
                    pg8::EpiScatter E{XS, MOD + (size_t)l * 17 * 6144 + 5 * 1024, (const int*)(a->ws + WS_PERMID), nullptr, (const float*)(a->ws + WS_STAT), a->in[I_LNG] + (size_t)(l * 2) * D, a->in[I_LNB] + (size_t)(l * 2) * D, ALPHA};
                    GEMM_SITE(7) pg8::gemm_phase<pg8::EpiScatter, pg8::MoeOrder, true, true, false>(lds, g, S, E);
                } else { ROW_CALL(rowpass<2>(a, l, lds, 1, nleft, dlim)); } }
            NEXT();
            if (RUN) { ROW_CALL(rowpass<2>(a, l, lds, 2, 0, dlim)); }
            NEXT();
        } else {
        if (RUN) { ROW_CALL(rowpass<2>(a, l, lds)); }
        NEXT();
        }
    }
#undef RUN
#undef NEXT
}
}

extern "C" void kernel_launch(void* const* d_in, const int* in_sizes, int n_in, void* d_out, int out_size, void* d_ws, size_t ws_size, hipStream_t stream) {
    using namespace mk;
    static int grid = 0;
    if (grid == 0) {
        if (n_in != 24 || in_sizes[0] != NB * SEQ * D || out_size != NB * SEQ * D || ws_size < WS_END) {
            fprintf(stderr, "kernel_launch: unexpected shapes or workspace (n_in %d, in0 %d, out %d, ws %zu, need %zu); nothing launched\n", n_in, n_in > 0 ? in_sizes[0] : -1, out_size, ws_size, (size_t)WS_END); grid = -1; return; }
        int dev = 0, cus = 0, per_cu = 0;
        if (hipGetDevice(&dev) != hipSuccess || hipDeviceGetAttribute(&cus, hipDeviceAttributeMultiprocessorCount, dev) != hipSuccess) { grid = -1; return; }
        if (hipFuncSetAttribute((const void*)mk_fwd, hipFuncAttributeMaxDynamicSharedMemorySize, LDS_BYTES) != hipSuccess) { fprintf(stderr, "kernel_launch: hipFuncSetAttribute failed\n"); grid = -1; return; }
        if (hipOccupancyMaxActiveBlocksPerMultiprocessor(&per_cu, (const void*)mk_fwd, NTHR, LDS_BYTES) != hipSuccess || per_cu < 1) { fprintf(stderr, "kernel_launch: occupancy query reports %d\n", per_cu); }
        (void)hipGetLastError();
        grid = cus;
    }
    if (grid < 0) return;
    if (hipMemsetAsync((char*)d_ws + WS_CTL, 0, CTL_ZERO_BYTES, stream) != hipSuccess) return;
    Args a{};
    for (int i = 0; i < 24; ++i) a.in[i] = (const float*)d_in[i];
    a.out = (float*)d_out; a.ws = (unsigned char*)d_ws;
#if MK_ONE_LAUNCH
    a.ph_lo = 0; a.ph_hi = PH_TOTAL;
    hipLaunchKernelGGL(mk_fwd, dim3(grid), dim3(NTHR), LDS_BYTES, stream, a);
#else
    for (int p = 0; p < PH_TOTAL; ++p) { a.ph_lo = p; a.ph_hi = p + 1; hipLaunchKernelGGL(mk_fwd, dim3(grid), dim3(NTHR), LDS_BYTES, stream, a); }
#endif
}
```
